# Optimizing an MI355X kernel written in HIP

```python
import math
import jax, jax.numpy as jnp
from jax import lax
import numpy as np

D_MODEL = 2048
BATCH = 16
SEQ = 2048
DEPTH = 4

N_MIXERS = 4
N_SWA = (DEPTH + 3) // N_MIXERS
N_RWKV = (DEPTH + 2) // N_MIXERS
N_MLSTM = (DEPTH + 1) // N_MIXERS
N_FOX = DEPTH // N_MIXERS

SWA_HEAD_DIM = 64
SWA_HEADS = D_MODEL // SWA_HEAD_DIM
SWA_KV_HEADS = SWA_HEADS // 8
SWA_GROUP = SWA_HEADS // SWA_KV_HEADS
SWA_WIDTH = SWA_HEADS * SWA_HEAD_DIM
SWA_KV_WIDTH = SWA_KV_HEADS * SWA_HEAD_DIM
SWA_IN = 2 * SWA_WIDTH + 2 * SWA_KV_WIDTH
SWA_WINDOW = 128
SWA_BLOCK = 128
REL_BUCKETS = 32
REL_MAX_DIST = 128
RWKV_HEAD_DIM = 64
RWKV_HEADS = D_MODEL // RWKV_HEAD_DIM
RWKV_DECAY_LORA = 96
RWKV_AAA_LORA = 96
RWKV_N_MIX = 6
MLSTM_HEADS = 8
MLSTM_V_DIM = D_MODEL // MLSTM_HEADS
MLSTM_QK_DIM = MLSTM_V_DIM // 2
MLSTM_QK_WIDTH = MLSTM_HEADS * MLSTM_QK_DIM
MLSTM_V_WIDTH = MLSTM_HEADS * MLSTM_V_DIM
MLSTM_IN = 2 * MLSTM_QK_WIDTH + 3 * MLSTM_V_WIDTH + 2 * MLSTM_HEADS
MLSTM_CHUNK = 128
FOX_HEAD_DIM = 64
FOX_HEADS = D_MODEL // FOX_HEAD_DIM
FOX_WIDTH = FOX_HEADS * FOX_HEAD_DIM
FOX_IN = 4 * FOX_WIDTH + FOX_HEADS
FOX_BLOCK = 128

RMS_EPS = 1e-6
GN_EPS = 64e-5

kernel_name = "hybrid_interleaved_swa_rwkv7_mlstm_fox"


def rms_norm(x, g):
    xf = x.astype(jnp.float32)
    y = xf * lax.rsqrt(jnp.mean(xf * xf, axis=-1, keepdims=True) + RMS_EPS)
    return (y * g.astype(jnp.float32)).astype(x.dtype)


def t5_bucket(dist):
    max_exact = REL_BUCKETS // 2
    d_f = jnp.maximum(dist, 1).astype(jnp.float32)
    large = max_exact + (jnp.log(d_f / max_exact) / math.log(REL_MAX_DIST / max_exact)
                         * (REL_BUCKETS - max_exact)).astype(jnp.int32)
    large = jnp.minimum(large, REL_BUCKETS - 1)
    return jnp.where(dist < max_exact, dist, large)


def swa_sink_mixer(h, w_in, q_gain, k_gain, sinks, rel_table, w_out):
    bsz, seq, _ = h.shape
    L = SWA_BLOCK
    nb = seq // L
    q, k, v, gate = jnp.split(h @ w_in, [SWA_WIDTH, SWA_WIDTH + SWA_KV_WIDTH,
                                         SWA_WIDTH + 2 * SWA_KV_WIDTH], axis=-1)
    q = rms_norm(q.reshape(bsz, seq, SWA_KV_HEADS, SWA_GROUP, SWA_HEAD_DIM), q_gain)
    k = rms_norm(k.reshape(bsz, seq, SWA_KV_HEADS, SWA_HEAD_DIM), k_gain)
    v = v.reshape(bsz, seq, SWA_KV_HEADS, SWA_HEAD_DIM)
    pad = ((0, 0), (L, 0), (0, 0), (0, 0))
    k_pad = jnp.pad(k, pad)
    v_pad = jnp.pad(v, pad)
    qi = jnp.arange(L)[:, None]
    kj = jnp.arange(2 * L)[None, :]
    dist = qi + L - kj
    in_band = (dist >= 0) & (dist < SWA_WINDOW)
    bias = rel_table.astype(jnp.float32)[t5_bucket(jnp.maximum(dist, 0))]
    bias = bias.transpose(2, 0, 1).reshape(SWA_KV_HEADS, SWA_GROUP, L, 2 * L)
    sink = sinks.astype(jnp.float32).reshape(SWA_KV_HEADS, SWA_GROUP, 1, 1)
    scale = SWA_HEAD_DIM ** -0.5
    q_blocks = q.reshape(bsz, nb, L, SWA_KV_HEADS, SWA_GROUP, SWA_HEAD_DIM).transpose(1, 0, 2, 3, 4, 5)

    def one_block(args):
        j, qj = args
        start = j * L
        kb = lax.dynamic_slice_in_dim(k_pad, start, 2 * L, axis=1)
        vb = lax.dynamic_slice_in_dim(v_pad, start, 2 * L, axis=1)
        s = jnp.einsum('bqhgd,bkhd->bhgqk', qj, kb).astype(jnp.float32) * scale + bias
        valid = in_band & (start - L + kj >= 0)
        s = jnp.where(valid, s, -jnp.inf)
        m = jnp.maximum(jnp.max(s, axis=-1, keepdims=True), sink)
        p = jnp.exp(s - m)
        p = p / (jnp.sum(p, axis=-1, keepdims=True) + jnp.exp(sink - m))
        return jnp.einsum('bhgqk,bkhd->bqhgd', p.astype(vb.dtype), vb)

    o = lax.map(one_block, (jnp.arange(nb), q_blocks))
    o = o.transpose(1, 0, 2, 3, 4, 5).reshape(bsz, seq, SWA_WIDTH)
    return (o * jax.nn.silu(gate)) @ w_out


def rwkv7_mixer(h, mix, w_in, w0, w_lora1, w_lora2, a0, a_lora1, a_lora2,
                k_k, k_a, r_k, gn_w, gn_b, w_out):
    bsz, seq, d = h.shape
    H, N = RWKV_HEADS, RWKV_HEAD_DIM
    f32 = jnp.float32
    xx = jnp.pad(h, ((0, 0), (1, 0), (0, 0)))[:, :-1] - h
    xm = h[None] + xx[None] * mix[:, None, None, :]
    r, k, v, g = jnp.einsum('cbsd,cde->cbse', xm[:4], w_in)
    w_pre = (w0 + jnp.tanh(xm[4] @ w_lora1) @ w_lora2).astype(f32)
    log_w = -jnp.exp(-jax.nn.softplus(-w_pre) - 0.5)
    a = jax.nn.sigmoid((a0 + (xm[5] @ a_lora1) @ a_lora2).astype(f32))

    def heads(t):
        return t.astype(f32).reshape(bsz, seq, H, N)

    r, k, v, a, log_w = heads(r), heads(k), heads(v), heads(a), heads(log_w)
    kk = k * k_k.astype(f32).reshape(H, N)
    kk = kk / jnp.maximum(jnp.sqrt(jnp.sum(kk * kk, axis=-1, keepdims=True)), 1e-12)
    k = k * (1.0 + (a - 1.0) * k_a.astype(f32).reshape(H, N))

    def step(state, inp):
        r_t, w_t, k_t, v_t, kk_t, a_t = inp
        sa = jnp.einsum('bhvk,bhk->bhv', state, -kk_t)
        state = (state * w_t[:, :, None, :]
                 + sa[..., None] * (kk_t * a_t)[:, :, None, :]
                 + v_t[..., None] * k_t[:, :, None, :])
        return state, jnp.einsum('bhvk,bhk->bhv', state, r_t)

    def tm(t):
        return t.transpose(1, 0, 2, 3)

    state0 = jnp.zeros((bsz, H, N, N), f32)
    _, y = lax.scan(step, state0, (tm(r), tm(jnp.exp(log_w)), tm(k), tm(v), tm(kk), tm(a)))
    y = tm(y)
    mu = jnp.mean(y, axis=-1, keepdims=True)
    var = jnp.mean(jnp.square(y - mu), axis=-1, keepdims=True)
    y = ((y - mu) * lax.rsqrt(var + GN_EPS)).reshape(bsz, seq, d) * gn_w + gn_b
    bonus = jnp.sum(r * k * r_k.astype(f32), axis=-1, keepdims=True) * v
    y = y + bonus.reshape(bsz, seq, d)
    return (y.astype(h.dtype) * jax.nn.silu(g)) @ w_out


def mlstm_mixer(h, w_in, b_i, b_f, h_gain, w_out):
    bsz, seq, _ = h.shape
    H, dk, dv, L = MLSTM_HEADS, MLSTM_QK_DIM, MLSTM_V_DIM, MLSTM_CHUNK
    nc = seq // L
    f32 = jnp.float32
    s1 = MLSTM_QK_WIDTH
    s2 = s1 + MLSTM_QK_WIDTH
    s3 = s2 + MLSTM_V_WIDTH
    s4 = s3 + MLSTM_V_WIDTH
    s5 = s4 + MLSTM_V_WIDTH
    s6 = s5 + H
    q, k, v, o_pre, gate, i_pre, f_pre = jnp.split(h @ w_in, [s1, s2, s3, s4, s5, s6], axis=-1)
    q = q.astype(f32).reshape(bsz, seq, H, dk) * dk ** -0.5
    k = k.astype(f32).reshape(bsz, seq, H, dk)
    v = v.astype(f32).reshape(bsz, seq, H, dv)
    i_log = (i_pre + b_i).astype(f32)
    f_log = jax.nn.log_sigmoid((f_pre + b_f).astype(f32))

    def chunks(t):
        t = t.reshape((bsz, nc, L) + t.shape[2:])
        return jnp.moveaxis(t, (1, 3), (0, 2))

    tri = jnp.tril(jnp.ones((L, L), dtype=bool))

    def chunk_step(carry, inp):
        C, n, m = carry
        qc, kc, vc, ic, fc = inp
        b = jnp.cumsum(fc, axis=-1)
        g = b[..., -1]
        dmat = jnp.where(tri, b[..., :, None] - b[..., None, :] + ic[..., None, :], -jnp.inf)
        inter = b + m[..., None]
        m_t = jnp.maximum(inter, jnp.max(dmat, axis=-1))
        w_intra = jnp.exp(dmat - m_t[..., None])
        w_inter = jnp.exp(inter - m_t)
        sw = jnp.einsum('bhtd,bhsd->bhts', qc, kc) * w_intra
        num = (w_inter[..., None] * jnp.einsum('bhvk,bhtk->bhtv', C, qc)
               + jnp.einsum('bhts,bhsv->bhtv', sw, vc))
        den = w_inter * jnp.einsum('bhk,bhtk->bht', n, qc) + jnp.sum(sw, axis=-1)
        h_t = num / jnp.maximum(jnp.abs(den), jnp.exp(-m_t))[..., None]
        decay_s = g[..., None] - b + ic
        m_new = jnp.maximum(g + m, jnp.max(decay_s, axis=-1))
        ws = jnp.exp(decay_s - m_new[..., None])
        carry_scale = jnp.exp(g + m - m_new)
        C = carry_scale[..., None, None] * C + jnp.einsum('bhs,bhsv,bhsk->bhvk', ws, vc, kc)
        n = carry_scale[..., None] * n + jnp.einsum('bhs,bhsk->bhk', ws, kc)
        return (C, n, m_new), h_t

    carry0 = (jnp.zeros((bsz, H, dv, dk), f32), jnp.zeros((bsz, H, dk), f32), jnp.zeros((bsz, H), f32))
    _, hs = lax.scan(chunk_step, carry0, (chunks(q), chunks(k), chunks(v), chunks(i_log), chunks(f_log)))
    hs = jnp.moveaxis(hs, (0, 2), (1, 3)).reshape(bsz, seq, H, dv)
    hs = rms_norm(hs, h_gain).reshape(bsz, seq, MLSTM_V_WIDTH).astype(h.dtype)
    return (hs * jax.nn.sigmoid(o_pre) * jax.nn.silu(gate)) @ w_out


def fox_mixer(h, w_in, b_f, q_gain, k_gain, w_out):
    bsz, seq, _ = h.shape
    H, dh, L = FOX_HEADS, FOX_HEAD_DIM, FOX_BLOCK
    nb = seq // L
    W = FOX_WIDTH
    q, k, v, gate, f_pre = jnp.split(h @ w_in, [W, 2 * W, 3 * W, 4 * W], axis=-1)
    q = rms_norm(q.reshape(bsz, seq, H, dh), q_gain)
    k = rms_norm(k.reshape(bsz, seq, H, dh), k_gain)
    v = v.reshape(bsz, seq, H, dh)
    log_f = jax.nn.log_sigmoid((f_pre + b_f).astype(jnp.float32))
    F = jnp.cumsum(log_f, axis=1).transpose(0, 2, 1)
    q_blocks = q.reshape(bsz, nb, L, H, dh).transpose(1, 0, 2, 3, 4)
    F_blocks = F.reshape(bsz, H, nb, L).transpose(2, 0, 1, 3)
    key_pos = jnp.arange(seq)
    scale = dh ** -0.5

    def one_block(args):
        j, qj, Fj = args
        s = (jnp.einsum('bqhd,bkhd->bhqk', qj, k).astype(jnp.float32) * scale
             + (Fj[..., :, None] - F[:, :, None, :]))
        q_pos = j * L + jnp.arange(L)
        s = jnp.where(key_pos[None, :] <= q_pos[:, None], s, -jnp.inf)
        p = jax.nn.softmax(s, axis=-1)
        return jnp.einsum('bhqk,bkhd->bqhd', p.astype(v.dtype), v)

    o = lax.map(one_block, (jnp.arange(nb), q_blocks, F_blocks))
    o = o.transpose(1, 0, 2, 3, 4).reshape(bsz, seq, W)
    return (o * jax.nn.silu(gate)) @ w_out


def setup_inputs(seed: int = 0) -> dict:
    key = jax.random.key(seed)
    keys = jax.random.split(key, 48)
    counter = [0]

    def next_key():
        kk = keys[counter[0]]
        counter[0] += 1
        return kk

    def nrm(shape, scale):
        return jax.random.normal(next_key(), shape, jnp.float32) * scale

    def gain(shape):
        return 1.0 + nrm(shape, 0.05)

    D = D_MODEL
    return {
        "x": nrm((BATCH, SEQ, D), 1.0),
        "rel_bias": nrm((REL_BUCKETS, SWA_HEADS), 0.2),
        "swa_norm": gain((N_SWA, D)),
        "swa_w_in": nrm((N_SWA, D, SWA_IN), D ** -0.5),
        "swa_q_gain": gain((N_SWA, SWA_HEAD_DIM)),
        "swa_k_gain": gain((N_SWA, SWA_HEAD_DIM)),
        "swa_sinks": nrm((N_SWA, SWA_HEADS), 0.5),
        "swa_w_out": nrm((N_SWA, SWA_WIDTH, D), SWA_WIDTH ** -0.5),
        "rwkv_norm": gain((N_RWKV, D)),
        "rwkv_mix": jax.random.uniform(next_key(), (N_RWKV, RWKV_N_MIX, D), jnp.float32),
        "rwkv_w_in": nrm((N_RWKV, 4, D, D), D ** -0.5),
        "rwkv_w0": -2.0 + nrm((N_RWKV, D), 1.0),
        "rwkv_w_lora1": nrm((N_RWKV, D, RWKV_DECAY_LORA), D ** -0.5),
        "rwkv_w_lora2": nrm((N_RWKV, RWKV_DECAY_LORA, D), 0.5 * RWKV_DECAY_LORA ** -0.5),
        "rwkv_a0": nrm((N_RWKV, D), 0.1),
        "rwkv_a_lora1": nrm((N_RWKV, D, RWKV_AAA_LORA), D ** -0.5),
        "rwkv_a_lora2": nrm((N_RWKV, RWKV_AAA_LORA, D), 0.5 * RWKV_AAA_LORA ** -0.5),
        "rwkv_k_k": 0.85 + nrm((N_RWKV, D), 0.05),
        "rwkv_k_a": 1.0 + nrm((N_RWKV, D), 0.05),
        "rwkv_r_k": nrm((N_RWKV, RWKV_HEADS, RWKV_HEAD_DIM), 0.1),
        "rwkv_gn_w": gain((N_RWKV, D)),
        "rwkv_gn_b": nrm((N_RWKV, D), 0.02),
        "rwkv_w_out": nrm((N_RWKV, D, D), D ** -0.5),
        "mlstm_norm": gain((N_MLSTM, D)),
        "mlstm_w_in": nrm((N_MLSTM, D, MLSTM_IN), D ** -0.5),
        "mlstm_b_i": nrm((N_MLSTM, MLSTM_HEADS), 0.1),
        "mlstm_b_f": 3.0 + nrm((N_MLSTM, MLSTM_HEADS), 0.5),
        "mlstm_h_gain": gain((N_MLSTM, MLSTM_HEADS, MLSTM_V_DIM)),
        "mlstm_w_out": nrm((N_MLSTM, MLSTM_V_WIDTH, D), MLSTM_V_WIDTH ** -0.5),
        "fox_norm": gain((N_FOX, D)),
        "fox_w_in": nrm((N_FOX, D, FOX_IN), D ** -0.5),
        "fox_b_f": 3.0 + nrm((N_FOX, FOX_HEADS), 0.5),
        "fox_q_gain": gain((N_FOX, FOX_HEAD_DIM)),
        "fox_k_gain": gain((N_FOX, FOX_HEAD_DIM)),
        "fox_w_out": nrm((N_FOX, FOX_WIDTH, D), FOX_WIDTH ** -0.5),
    }


def reference(x, rel_bias, swa_norm, swa_w_in, swa_q_gain, swa_k_gain, swa_sinks, swa_w_out,
              rwkv_norm, rwkv_mix, rwkv_w_in, rwkv_w0, rwkv_w_lora1, rwkv_w_lora2, rwkv_a0,
              rwkv_a_lora1, rwkv_a_lora2, rwkv_k_k, rwkv_k_a, rwkv_r_k, rwkv_gn_w, rwkv_gn_b,
              rwkv_w_out, mlstm_norm, mlstm_w_in, mlstm_b_i, mlstm_b_f, mlstm_h_gain, mlstm_w_out,
              fox_norm, fox_w_in, fox_b_f, fox_q_gain, fox_k_gain, fox_w_out):
    for layer in range(DEPTH):
        kind, idx = layer % N_MIXERS, layer // N_MIXERS
        if kind == 0:
            x = x + swa_sink_mixer(rms_norm(x, swa_norm[idx]), swa_w_in[idx], swa_q_gain[idx],
                                   swa_k_gain[idx], swa_sinks[idx], rel_bias, swa_w_out[idx])
        elif kind == 1:
            x = x + rwkv7_mixer(rms_norm(x, rwkv_norm[idx]), rwkv_mix[idx], rwkv_w_in[idx],
                                rwkv_w0[idx], rwkv_w_lora1[idx], rwkv_w_lora2[idx], rwkv_a0[idx],
                                rwkv_a_lora1[idx], rwkv_a_lora2[idx], rwkv_k_k[idx], rwkv_k_a[idx],
                                rwkv_r_k[idx], rwkv_gn_w[idx], rwkv_gn_b[idx], rwkv_w_out[idx])
        elif kind == 2:
            x = x + mlstm_mixer(rms_norm(x, mlstm_norm[idx]), mlstm_w_in[idx], mlstm_b_i[idx],
                                mlstm_b_f[idx], mlstm_h_gain[idx], mlstm_w_out[idx])
        else:
            x = x + fox_mixer(rms_norm(x, fox_norm[idx]), fox_w_in[idx], fox_b_f[idx],
                              fox_q_gain[idx], fox_k_gain[idx], fox_w_out[idx])
    return x
```

```cpp
#include <hip/hip_runtime.h>
#include <cstdio>
#include <cstdint>
__device__ __forceinline__ int fresh_lane() { int l; asm volatile("v_mbcnt_lo_u32_b32 %0, -1, 0\n\tv_mbcnt_hi_u32_b32 %0, -1, %0" : "=v"(l)); return l; }
namespace pg8 {
#define PG8_LAS __attribute__((address_space(3)))
typedef unsigned short bf16_t;
typedef short bf16x8 __attribute__((ext_vector_type(8)));
typedef float f32x4 __attribute__((ext_vector_type(4)));
typedef unsigned u32x4 __attribute__((ext_vector_type(4)));
constexpr int BM = 256, BK = 64, HALF = 128, HTB = HALF * BK * 2  , STAGE_BYTES = 8 * HTB, NXCD = 8, WGM = 8;

__host__ __device__ __forceinline__ int lds_byte(int r, int c) { const int st = (r >> 4) * 2 + (c >> 5), rr = r & 15, cc = c & 31, ob = rr * 64 + cc * 2; return st * 1024 + (ob ^ (((ob >> 9) & 1) << 5)); }
__host__ __device__ __forceinline__ void stage_rc(int b, int& R, int& C) { const int st = b / 1024, sb = b % 1024, swz = sb ^ (((sb >> 9) & 1) << 5); R = (st >> 1) * 16 + swz / 64; C = (st & 1) * 32 + (swz % 64) / 2; }
__host__ __device__ __forceinline__ int perm32(int rho) { const int n = rho >> 4, i = rho & 15; return 8 * (i >> 2) + 4 * n + (i & 3); }

struct Unit { int pm, pn; };
struct Gemm { const bf16_t* A; const bf16_t* Bt; int M, N, K; };

struct StaticOrder {
    int nM, nN, nwg, G, c;
    __host__ __device__ void init(int M, int N, int G_, int c_) { nM = M / BM; nN = N / BM; nwg = nM * nN; G = G_; c = c_; }
    __host__ __device__ bool next(int i, Unit& u) const {
        const long L = (long)i * G + c; if (L >= nwg) return false;
        int wgid = (int)L; { const int q = nwg / NXCD, r = nwg % NXCD, xcd = wgid % NXCD, off = wgid / NXCD; wgid = (xcd < r ? xcd * (q + 1) : r * (q + 1) + (xcd - r) * q) + off; }
        const int nig = WGM * nN, gid = wgid / nig, fm = gid * WGM, gsz = (nM - fm) < WGM ? (nM - fm) : WGM;
        u.pm = fm + ((wgid % nig) % gsz); u.pn = (wgid % nig) / gsz; return true;
    }
    __device__ __forceinline__ void a_ready(const Unit&) const {}
    __device__ __forceinline__ void done(const Unit&) const {}
};
__device__ __forceinline__ unsigned cvt_pk_bf16(float lo, float hi) { unsigned r; asm volatile("v_cvt_pk_bf16_f32 %0, %1, %2" : "=v"(r) : "v"(lo), "v"(hi)); return r; }
struct EpiStore {
    static constexpr bool PERM = true, AFTER_DRAIN = false;
    bf16_t* O; int ldc; int n_main; float* X;
    __device__ __forceinline__ void operator()(const f32x4 (&acc)[2][2][4][2], const Unit& u, int wr, int wc, int fr, int fq) const {
        const int row0 = u.pm * BM + wr * 64 + fr;
        if (u.pn < n_main) {
            const int col0 = u.pn * BM + wc * 32 + 8 * fq;
#pragma unroll
            for (int ai = 0; ai < 2; ++ai)
#pragma unroll
                for (int m = 0; m < 4; ++m) { bf16_t* rowp = O + (size_t)(row0 + ai * HALF + m * 16) * ldc + col0;
#pragma unroll
                    for (int bj = 0; bj < 2; ++bj) { const f32x4 v0 = acc[ai][bj][m][0], v1 = acc[ai][bj][m][1];
                        u32x4 w; w.x = cvt_pk_bf16(v0[0], v0[1]); w.y = cvt_pk_bf16(v0[2], v0[3]); w.z = cvt_pk_bf16(v1[0], v1[1]); w.w = cvt_pk_bf16(v1[2], v1[3]);
                        *(u32x4*)(rowp + bj * HALF) = w; } }
        } else if (wc == 0) {
#pragma unroll
            for (int ai = 0; ai < 2; ++ai)
#pragma unroll
                for (int m = 0; m < 4; ++m) { float* rp = X + (size_t)(row0 + ai * HALF + m * 16) * 32 + 8 * fq;
                    *(f32x4*)rp = acc[ai][0][m][0]; *(f32x4*)(rp + 4) = acc[ai][0][m][1]; }
        }
    }
};
template <int SEL> struct EpiLora1 {
    static constexpr bool PERM = true, AFTER_DRAIN = false;
    bf16_t* O;
    __device__ __forceinline__ void operator()(const f32x4 (&acc)[2][2][4][2], const Unit& u, int wr, int wc, int fr, int fq) const {
        const int row0 = u.pm * BM + wr * 64 + fr, col0 = SEL * HALF + wc * 32 + 8 * fq;
#pragma unroll
        for (int ai = 0; ai < 2; ++ai)
#pragma unroll
            for (int m = 0; m < 4; ++m) { bf16_t* rowp = O + (size_t)(row0 + ai * HALF + m * 16) * 256 + col0;
                f32x4 v0 = acc[ai][SEL][m][0], v1 = acc[ai][SEL][m][1];
                if (SEL == 0) {
#pragma unroll
                    for (int j = 0; j < 4; ++j) { v0[j] = tanhf(v0[j]); v1[j] = tanhf(v1[j]); } }
                u32x4 w; w.x = cvt_pk_bf16(v0[0], v0[1]); w.y = cvt_pk_bf16(v0[2], v0[3]); w.z = cvt_pk_bf16(v1[0], v1[1]); w.w = cvt_pk_bf16(v1[2], v1[3]);
                *(u32x4*)rowp = w; }
    }
};
struct EpiLora2 {
    static constexpr bool PERM = true, AFTER_DRAIN = false;
    bf16_t* LW; bf16_t* AA; const float* w0; const float* a0;
    __device__ __forceinline__ void operator()(const f32x4 (&acc)[2][2][4][2], const Unit& u, int wr, int wc, int fr, int fq) const {
        const int row0 = u.pm * BM + wr * 64 + fr;
        const bool isw = u.pn < 8;
        const int col0 = (isw ? u.pn : u.pn - 8) * BM + wc * 32 + 8 * fq;
        const float* bsrc = isw ? w0 : a0; bf16_t* dst = isw ? LW : AA;
#pragma unroll
        for (int ai = 0; ai < 2; ++ai)
#pragma unroll
            for (int m = 0; m < 4; ++m) { bf16_t* rowp = dst + (size_t)(row0 + ai * HALF + m * 16) * 2048 + col0;
#pragma unroll
                for (int bj = 0; bj < 2; ++bj) { f32x4 v0 = acc[ai][bj][m][0] + *(const f32x4*)(bsrc + col0 + bj * HALF), v1 = acc[ai][bj][m][1] + *(const f32x4*)(bsrc + col0 + bj * HALF + 4);
                    if (isw) {
#pragma unroll
                        for (int j = 0; j < 4; ++j) { const float a = -v0[j], b = -v1[j];
                            const float spa = a > 15.f ? a : __logf(1.0f + __expf(a)), spb = b > 15.f ? b : __logf(1.0f + __expf(b));
                            v0[j] = -__expf(-spa - 0.5f); v1[j] = -__expf(-spb - 0.5f); }
                    } else {
#pragma unroll
                        for (int j = 0; j < 4; ++j) { v0[j] = __builtin_amdgcn_rcpf(1.0f + __expf(-v0[j])); v1[j] = __builtin_amdgcn_rcpf(1.0f + __expf(-v1[j])); }
                    }
                    u32x4 w; w.x = cvt_pk_bf16(v0[0], v0[1]); w.y = cvt_pk_bf16(v0[2], v0[3]); w.z = cvt_pk_bf16(v1[0], v1[1]); w.w = cvt_pk_bf16(v1[2], v1[3]);
                    *(u32x4*)(rowp + bj * HALF) = w; }
                asm volatile("" ::: "memory"); }
    }
};
struct EpiResid {
    static constexpr bool PERM = false, AFTER_DRAIN = false;
    const float* R; float* O; int ldc; float amp;
    __device__ __forceinline__ void operator()(const f32x4 (&acc)[2][2][4][2], const Unit& u, int wr, int wc, int fr, int fq) const {
        const int row0 = u.pm * BM + wr * 64 + fr, col0 = u.pn * BM + wc * 32 + 4 * fq;
#pragma unroll
        for (int ai = 0; ai < 2; ++ai)
#pragma unroll
            for (int m = 0; m < 4; ++m) { const size_t off = (size_t)(row0 + ai * HALF + m * 16) * ldc + col0;
#pragma unroll
                for (int bj = 0; bj < 2; ++bj)
#pragma unroll
                    for (int n = 0; n < 2; ++n) { const f32x4 r = *(const f32x4*)(R + off + bj * HALF + n * 16); *(f32x4*)(O + off + bj * HALF + n * 16) = r + amp * acc[ai][bj][m][n]; } }
    }
};
template <class Epi, class Sched, bool ALIGN_EPI = false, bool SP2 = false>
__device__ __forceinline__ void gemm_phase(PG8_LAS unsigned char* lds, const Gemm g, const Sched& S, const Epi& E, const int wid) {
    const int lane = fresh_lane(), tid = wid * 64 + lane, wr = wid >> 2, wc = wid & 3, fr = lane & 15, fq = lane >> 4;
    const int K = g.K, nt = K / BK;
    unsigned voffA[2], voffB[2];
#pragma unroll
    for (int i = 0; i < 2; ++i) { int R, C; stage_rc(tid * 16 + i * 8192, R, C); const int Rb = Epi::PERM ? ((R & ~31) + perm32(R & 31)) : R;
        voffA[i] = (unsigned)(R * K + C) * 2u; voffB[i] = (unsigned)(Rb * K + C) * 2u; }
    const size_t kstep = (size_t)(BK * 2);
    const size_t hstep = (size_t)HALF * K * 2;
    const size_t tstep = 2 * hstep;
    const unsigned ldsw = (unsigned)wid * 1024u;
    const int aoff = lds_byte(wr * 64 + fr, fq * 8), boff = lds_byte(wc * 32 + fr, fq * 8);
#define PG8_SA(b, h) (((b) * 2 + (h)) * HTB)
#define PG8_SB(b, h) ((4 + (b) * 2 + (h)) * HTB)
#define PG8_STAGE(bufoff, gbase, voff) do { _Pragma("unroll") for (int _i = 0; _i < 2; ++_i) \
        __builtin_amdgcn_global_load_lds((const unsigned*)((const char*)(gbase) + (voff)[_i]), (PG8_LAS unsigned*)(lds + (bufoff) + ldsw + _i * 8192), 16, 0, 0); } while (0)
#define PG8_LDA(dst, b, h) do { _Pragma("unroll") for (int m = 0; m < 4; ++m) _Pragma("unroll") for (int k = 0; k < 2; ++k) dst[m][k] = *(const PG8_LAS bf16x8*)(lds + PG8_SA(b, h) + aoff + m * 2048 + k * 1024); } while (0)
#define PG8_LDB(dst, b, h) do { _Pragma("unroll") for (int n = 0; n < 2; ++n) _Pragma("unroll") for (int k = 0; k < 2; ++k) dst[n][k] = *(const PG8_LAS bf16x8*)(lds + PG8_SB(b, h) + boff + n * 2048 + k * 1024); } while (0)
#define PG8_MMA(ai, bj, At, Bt) do { __builtin_amdgcn_s_setprio(1); _Pragma("unroll") for (int m = 0; m < 4; ++m) _Pragma("unroll") for (int n = 0; n < 2; ++n) _Pragma("unroll") for (int k = 0; k < 2; ++k) \
        acc[ai][bj][m][n] = __builtin_amdgcn_mfma_f32_16x16x32_bf16(Bt[n][k], At[m][k], acc[ai][bj][m][n], 0, 0, 0); __builtin_amdgcn_s_setprio(0); } while (0)
#define PG8_WAIT_V(n) asm volatile("s_waitcnt vmcnt(" #n ")" ::: "memory")
#define PG8_WAIT_L(n) asm volatile("s_waitcnt lgkmcnt(" #n ")" ::: "memory")
#define PG8_BAR __builtin_amdgcn_s_barrier()
#define PG8_SCHED __builtin_amdgcn_sched_barrier(0)
    Unit cur, nxt; int ui = 0;
    if (!S.next(0, cur)) return;
    f32x4 acc[2][2][4][2];
#pragma unroll
    for (int a = 0; a < 2; ++a)
#pragma unroll
        for (int b = 0; b < 2; ++b)
#pragma unroll
            for (int m = 0; m < 4; ++m)
#pragma unroll
                for (int n = 0; n < 2; ++n) acc[a][b][m][n] = (f32x4){0.f, 0.f, 0.f, 0.f};
    bf16x8 At[4][2], B0[2][2], B1[2][2];
    const char* cA = (const char*)g.A + (size_t)cur.pm * tstep; const char* cB = (const char*)g.Bt + (size_t)cur.pn * tstep;
    S.a_ready(cur);
    if constexpr (SP2) {
        PG8_STAGE(PG8_SB(0, 0), cB, voffB); PG8_STAGE(PG8_SB(0, 1), cB + hstep, voffB); PG8_STAGE(PG8_SA(0, 0), cA, voffA); PG8_STAGE(PG8_SA(0, 1), cA + hstep, voffA);
        if (wr == 1) PG8_BAR;
        PG8_WAIT_V(2); PG8_BAR;
        PG8_STAGE(PG8_SB(1, 0), cB + kstep, voffB); PG8_STAGE(PG8_SA(1, 0), cA + kstep, voffA); PG8_STAGE(PG8_SB(1, 1), cB + hstep + kstep, voffB);
        PG8_WAIT_V(6); PG8_BAR;
    } else {
        PG8_STAGE(PG8_SB(0, 0), cB, voffB); PG8_STAGE(PG8_SA(0, 0), cA, voffA); PG8_STAGE(PG8_SB(0, 1), cB + hstep, voffB); PG8_STAGE(PG8_SA(0, 1), cA + hstep, voffA);
        if (wr == 1) PG8_BAR;
        PG8_WAIT_V(4); PG8_BAR;
        PG8_STAGE(PG8_SB(1, 0), cB + kstep, voffB); PG8_STAGE(PG8_SA(1, 0), cA + kstep, voffA); PG8_STAGE(PG8_SB(1, 1), cB + hstep + kstep, voffB);
        PG8_WAIT_V(6); PG8_BAR;
    }
    for (;;) {
        const bool has_next = S.next(ui + 1, nxt);
        const char* nA = has_next ? (const char*)g.A + (size_t)nxt.pm * tstep : cA; const char* nB = has_next ? (const char*)g.Bt + (size_t)nxt.pn * tstep : cB;
        for (int t = 0; t < nt; t += 2) {
            const bool last = (t == nt - 2);
            const char* a1 = cA + (size_t)(t + 1) * kstep;
            const char* a2 = last ? nA : cA + (size_t)(t + 2) * kstep; const char* b2 = last ? nB : cB + (size_t)(t + 2) * kstep;
            const char* a3 = a2 + kstep; const char* b3 = b2 + kstep;
            if (last && has_next) S.a_ready(nxt);
            if constexpr (SP2) {
            PG8_LDB(B0, 0, 0); PG8_LDB(B1, 0, 1); PG8_SCHED; PG8_LDA(At, 0, 0); PG8_STAGE(PG8_SA(1, 1), a1 + hstep, voffA);
            PG8_WAIT_V(8); PG8_WAIT_L(0); PG8_BAR; PG8_MMA(0, 0, At, B0); PG8_MMA(0, 1, At, B1); PG8_BAR; PG8_SCHED;
            PG8_LDA(At, 0, 1); PG8_STAGE(PG8_SB(0, 0), b2, voffB); PG8_STAGE(PG8_SB(0, 1), b2 + hstep, voffB); PG8_STAGE(PG8_SA(0, 0), a2, voffA);
            PG8_WAIT_V(8); PG8_WAIT_L(0); PG8_BAR; PG8_MMA(1, 0, At, B0); PG8_MMA(1, 1, At, B1); PG8_BAR; PG8_SCHED;
            PG8_LDB(B0, 1, 0); PG8_LDB(B1, 1, 1); PG8_SCHED; PG8_LDA(At, 1, 0); PG8_STAGE(PG8_SA(0, 1), a2 + hstep, voffA);
            PG8_WAIT_V(8); PG8_WAIT_L(0); PG8_BAR; PG8_MMA(0, 0, At, B0); PG8_MMA(0, 1, At, B1); PG8_BAR; PG8_SCHED;
            PG8_LDA(At, 1, 1); PG8_STAGE(PG8_SB(1, 0), b3, voffB); PG8_STAGE(PG8_SB(1, 1), b3 + hstep, voffB); PG8_STAGE(PG8_SA(1, 0), a3, voffA);
            PG8_WAIT_V(8); PG8_WAIT_L(0); PG8_BAR; PG8_MMA(1, 0, At, B0); PG8_MMA(1, 1, At, B1); PG8_BAR; PG8_SCHED;
            } else {
            PG8_LDB(B0, 0, 0); PG8_SCHED; PG8_LDA(At, 0, 0); PG8_STAGE(PG8_SA(1, 1), a1 + hstep, voffA);
            PG8_WAIT_L(8); PG8_BAR; PG8_WAIT_L(0); PG8_MMA(0, 0, At, B0); PG8_BAR; PG8_SCHED;
            PG8_LDB(B1, 0, 1); PG8_STAGE(PG8_SB(0, 0), b2, voffB);
            PG8_BAR; PG8_WAIT_L(0); PG8_MMA(0, 1, At, B1); PG8_BAR;
            PG8_LDA(At, 0, 1); PG8_STAGE(PG8_SA(0, 0), a2, voffA);
            PG8_BAR; PG8_WAIT_L(0); PG8_MMA(1, 0, At, B0); PG8_BAR; PG8_SCHED;
            PG8_STAGE(PG8_SB(0, 1), b2 + hstep, voffB);
            PG8_WAIT_V(6); PG8_BAR; PG8_MMA(1, 1, At, B1); PG8_BAR;
            PG8_LDB(B0, 1, 0); PG8_SCHED; PG8_LDA(At, 1, 0); PG8_STAGE(PG8_SA(0, 1), a2 + hstep, voffA);
            PG8_WAIT_L(8); PG8_BAR; PG8_WAIT_L(0); PG8_MMA(0, 0, At, B0); PG8_BAR; PG8_SCHED;
            PG8_LDB(B1, 1, 1); PG8_STAGE(PG8_SB(1, 0), b3, voffB);
            PG8_BAR; PG8_WAIT_L(0); PG8_MMA(0, 1, At, B1); PG8_BAR;
            PG8_LDA(At, 1, 1); PG8_STAGE(PG8_SA(1, 0), a3, voffA);
            PG8_BAR; PG8_WAIT_L(0); PG8_MMA(1, 0, At, B0); PG8_BAR; PG8_SCHED;
            PG8_STAGE(PG8_SB(1, 1), b3 + hstep, voffB);
            PG8_WAIT_V(6); PG8_BAR; PG8_MMA(1, 1, At, B1); PG8_BAR;
            }
        }
        if constexpr (ALIGN_EPI) { if (wr == 0) PG8_BAR; }
        if constexpr (!Epi::AFTER_DRAIN) { E(acc, cur, wr, wc, fr, fq); S.done(cur); }
        if (!has_next) break;
#pragma unroll
        for (int a = 0; a < 2; ++a)
#pragma unroll
            for (int b = 0; b < 2; ++b)
#pragma unroll
                for (int m = 0; m < 4; ++m)
#pragma unroll
                    for (int n = 0; n < 2; ++n) acc[a][b][m][n] = (f32x4){0.f, 0.f, 0.f, 0.f};
        cur = nxt; cA = nA; cB = nB; ++ui;
        if constexpr (ALIGN_EPI) { if (wr == 1) PG8_BAR; }
    }
    PG8_WAIT_V(0);
    if constexpr (!ALIGN_EPI) { if (wr == 0) PG8_BAR; }
    PG8_BAR;
    if constexpr (Epi::AFTER_DRAIN) { E.fused(acc, cur, wr, wc, fr, fq, lds, wid, lane); S.done(cur); }
#undef PG8_SA
#undef PG8_SB
#undef PG8_STAGE
#undef PG8_LDA
#undef PG8_LDB
#undef PG8_MMA
#undef PG8_WAIT_V
#undef PG8_WAIT_L
#undef PG8_BAR
#undef PG8_SCHED
}
}

#define GAS __attribute__((address_space(1)))
#define LAS __attribute__((address_space(3)))
typedef unsigned short bf16;
typedef unsigned v4u __attribute__((ext_vector_type(4)));
typedef float f32x4 __attribute__((ext_vector_type(4)));
typedef short bf16x8 __attribute__((ext_vector_type(8)));
typedef GAS unsigned gu32;
typedef GAS unsigned long long gu64;
#define RLX_AGENT __ATOMIC_RELAXED, __HIP_MEMORY_SCOPE_AGENT
#define LDS_WAIT() asm volatile("s_waitcnt lgkmcnt(0)" ::: "memory")
#define VM_WAIT() asm volatile("s_waitcnt vmcnt(0)" ::: "memory")
__device__ __forceinline__ unsigned long long rt() { return __builtin_amdgcn_s_memrealtime(); }
__device__ __forceinline__ unsigned f2bf(float f) { unsigned u = __builtin_bit_cast(unsigned, f); return (u + 0x7fffu + ((u >> 16) & 1u)) >> 16; }
__device__ __forceinline__ unsigned pk2(float lo, float hi) { return f2bf(lo) | (f2bf(hi) << 16); }
#define XB_TMO      128
#define XB_XCNT(j)  (256  + 64 * (j))
#define XB_XSUB(j)  (1280 + 64 * (j))
#define XB_XGEN(j)  (2304 + 64 * (j))
#define XB_TOP      3328
#define XB_TOPGEN   3392
#define XCD_BAR_WORDS 3456
#define XB_SPIN_CAP (1u << 18)

__device__ __forceinline__ unsigned xb_ld(unsigned* p)              { return __hip_atomic_load(p, __ATOMIC_RELAXED, __HIP_MEMORY_SCOPE_AGENT); }
__device__ __forceinline__ unsigned xb_add(unsigned* p, unsigned v) { return __hip_atomic_fetch_add(p, v, __ATOMIC_RELAXED, __HIP_MEMORY_SCOPE_AGENT); }
__device__ __forceinline__ unsigned xb_xcc_id() { return (unsigned)__builtin_amdgcn_s_getreg((3 << 11) | 20) & 0xFu; }
#define XB_SPIN(cond, bar) do { unsigned _sp = 0; while (cond) { __builtin_amdgcn_s_sleep(1); \
    if ((++_sp & 255u) == 0u) { if (xb_ld(&(bar)[XB_TMO])) break; if (_sp > XB_SPIN_CAP) { atomicAdd(&(bar)[XB_TMO], 1u); break; } } } } while (0)

struct XcdBarrier {
    unsigned* bar; unsigned x;
    volatile LAS unsigned* st;
};

__device__ __forceinline__ XcdBarrier xcd_barrier_post(unsigned* bar, volatile LAS unsigned* st) {
    XcdBarrier b; b.bar = bar; b.x = xb_xcc_id(); b.st = st;
    if (threadIdx.x == 0) (void)xb_add(&bar[XB_XCNT(b.x)], 1u);
    return b;
}
__device__ __forceinline__ void xcd_barrier_complete(unsigned* bar, unsigned x, unsigned& nloc, unsigned& nx) {
    const unsigned G = gridDim.x * gridDim.y * gridDim.z;
    unsigned sum, cnt, mine, sp = 0u;
    for (;;) {
        sum = 0u; cnt = 0u; mine = 0u;
#pragma unroll
        for (unsigned j = 0; j < 16; ++j) { const unsigned c = xb_ld(&bar[XB_XCNT(j)]); sum += c; cnt += (c > 0u) ? 1u : 0u; mine = (j == x) ? c : mine; }
        if (sum == G) break;
        __builtin_amdgcn_s_sleep(1);
        if ((++sp & 255u) == 0u) { if (xb_ld(&bar[XB_TMO])) break; if (sp > XB_SPIN_CAP) { atomicAdd(&bar[XB_TMO], 1u); break; } }
    }
    nloc = mine > 0u ? mine : 1u; nx = cnt > 0u ? cnt : 1u;
}

__device__ __forceinline__ void xcd_barrier(const XcdBarrier& b, const int wave_sgpr) {
    const bool xb_t0 = (wave_sgpr == 0) && (fresh_lane() == 0);
    asm volatile("s_waitcnt vmcnt(0)" ::: "memory");
    __syncthreads();
    if (xb_t0) {
        unsigned* bar = b.bar;
        __builtin_amdgcn_s_waitcnt(0);
        unsigned nloc = b.st[0], nx = b.st[1];
        if (nloc == 0u) { xcd_barrier_complete(bar, b.x, nloc, nx); b.st[0] = nloc; b.st[1] = nx; }
        const unsigned old = xb_add(&bar[XB_XSUB(b.x)], 1u);
        const unsigned gen = old / nloc;
        if (old + 1u == (gen + 1u) * nloc) {
            __builtin_amdgcn_fence(__ATOMIC_RELEASE, "agent");
            asm volatile("s_waitcnt vmcnt(0)" ::: "memory");
            const unsigned og = xb_add(&bar[XB_TOP], 1u);
            const unsigned tg = og / nx;
            if (og + 1u == (tg + 1u) * nx) xb_add(&bar[XB_TOPGEN], 1u);
            else XB_SPIN(xb_ld(&bar[XB_TOPGEN]) == tg, bar);
            __builtin_amdgcn_fence(__ATOMIC_ACQUIRE, "agent");
            xb_add(&bar[XB_XGEN(b.x)], 1u);
            asm volatile("s_waitcnt vmcnt(0)" ::: "memory");
        } else {
            XB_SPIN(xb_ld(&bar[XB_XGEN(b.x)]) == gen, bar);
            __builtin_amdgcn_fence(__ATOMIC_ACQUIRE, "agent");
            asm volatile("s_waitcnt vmcnt(0)" ::: "memory");
        }
    }
    __syncthreads();
}

constexpr int NWAVES = 8;
constexpr int BATCH = 16, SEQ = 2048, DM = 2048, MROWS = BATCH * SEQ;
constexpr float RMS_EPS = 1e-6f, GN_EPS = 64e-5f, LOG2E = 1.4426950408889634f;
constexpr int P0 = 4608;
constexpr int P2 = 8192;
constexpr int P3 = 8192;
constexpr size_t MiB = 1u << 20;
constexpr size_t WS_CTL = 0, CTL_ZERO_BYTES = 1 * MiB;
constexpr size_t WS_W = 1 * MiB;
constexpr size_t WS_S0 = 48 * MiB, SLOT = 128 * MiB;
#define WS_SLOT(i) (WS_S0 + (size_t)(i) * SLOT)
constexpr size_t WS_SMALL = WS_S0 + 7 * SLOT;
constexpr size_t WS_L1 = WS_SMALL;
constexpr size_t WS_GX = WS_SMALL + 16 * MiB;
constexpr size_t WS_F = WS_SMALL + 20 * MiB;
constexpr size_t WS_END = WS_SMALL + 24 * MiB;
constexpr int CW_TMO = 0;
constexpr int CW_BAR = 4096;
constexpr size_t W0_IN = 0, W0_OUT = (size_t)4608 * 2048;
constexpr size_t W1_IN = 0, W1_LA = (size_t)4 * 2048 * 2048, W1_LB = W1_LA + (size_t)256 * 2048, W1_L2 = W1_LB + (size_t)256 * 2048, W1_OUT = W1_L2 + (size_t)4096 * 256;
constexpr size_t W2_IN = 0, W2_OUT = (size_t)8448 * 2048;
static_assert((W1_OUT + (size_t)2048 * 2048) * 2 <= 47 * MiB && (W2_OUT + (size_t)2048 * 2048) * 2 <= 47 * MiB, "weight region");
constexpr int RING_BYTES = 131072;
constexpr int MISC_OFF = RING_BYTES;
constexpr int LDS_BYTES = 147456;

struct Frame {
    LAS unsigned char* lds;
    int tid, lane, wave, vcu, G;
};
__device__ __forceinline__ float wave_sum(float v) {
#pragma unroll
    for (int o = 1; o < 64; o <<= 1) v += __shfl_xor(v, o);
    return v;
}
__device__ __forceinline__ float bf2f(unsigned short b) { return __builtin_bit_cast(float, (unsigned)b << 16); }
__device__ __forceinline__ float bflo(unsigned w) { return __builtin_bit_cast(float, w << 16); }
__device__ __forceinline__ float bfhi(unsigned w) { return __builtin_bit_cast(float, w & 0xffff0000u); }
__device__ __forceinline__ unsigned pkbf(float lo, float hi) { return pg8::cvt_pk_bf16(lo, hi); }
__device__ __forceinline__ float siluf(float x) { return x / (1.0f + __expf(-x)); }
__device__ __forceinline__ float sigmf(float x) { return 1.0f / (1.0f + __expf(-x)); }
__device__ __forceinline__ float logsigf(float z) { return fminf(z, 0.f) - log1pf(__expf(-fabsf(z))); }

__device__ __forceinline__ void transpose_item(const float* W, int ldw, int n0w, int K, int N, bf16* WT, int row_off, LAS float* scr, int item, int lane) {
    const int nblk = N / 32, kb = item / nblk, nb = item % nblk, k0 = 64 * kb, n0 = 32 * nb;
#pragma unroll 8
    for (int i = 0; i < 32; ++i) { const int kk = 2 * i + (lane >> 5); scr[kk * 33 + (lane & 31)] = W[(size_t)(k0 + kk) * ldw + n0w + n0 + (lane & 31)]; }
    LDS_WAIT(); asm volatile("" ::: "memory");
    const int c = lane & 7;
#pragma unroll
    for (int j = 0; j < 4; ++j) { const int n = (lane >> 3) + 8 * j; const LAS float* s = scr + (8 * c) * 33 + n;
        v4u o; o.x = pkbf(s[0 * 33], s[1 * 33]); o.y = pkbf(s[2 * 33], s[3 * 33]); o.z = pkbf(s[4 * 33], s[5 * 33]); o.w = pkbf(s[6 * 33], s[7 * 33]);
        *(GAS v4u*)(WT + (size_t)(row_off + n0 + n) * K + k0 + 8 * c) = o; }
    LDS_WAIT(); asm volatile("" ::: "memory");
}
__device__ __forceinline__ void convert_matrix(Frame& F, const float* W, int ldw, int n0w, int K, int N, bf16* WT, int row_off) {
    LAS float* scr = (LAS float*)(F.lds + F.wave * 16384);
    const int gw = F.vcu * NWAVES + F.wave, NGW = F.G * NWAVES, nitems = (K / 64) * (N / 32);
    for (int it = gw; it < nitems; it += NGW) transpose_item(W, ldw, n0w, K, N, WT, row_off, scr, it, F.lane);
}
__device__ __forceinline__ void zero_rows(Frame& F, bf16* WT, int K, int r0, int r1) {
    const size_t n16 = (size_t)(r1 - r0) * K / 8; GAS v4u* p = (GAS v4u*)(WT + (size_t)r0 * K);
    for (size_t i = (size_t)blockIdx.x * 512 + F.tid; i < n16; i += (size_t)F.G * 512) p[i] = (v4u){0u, 0u, 0u, 0u};
}
__device__ __forceinline__ void convert_cols_small(Frame& F, const float* W, int ldw, int n0w, int K, int N, bf16* WT, int row_off) {
    const int total = K * N;
    for (int i = blockIdx.x * 512 + F.tid; i < total; i += F.G * 512) { const int n = i / K, k = i % K; WT[(size_t)(row_off + n) * K + k] = (bf16)f2bf(W[(size_t)k * ldw + n0w + n]); }
}

__device__ __forceinline__ void phase_norm(Frame& F, const float* x, const float* gain, bf16* out) {
    const int gw = F.vcu * NWAVES + F.wave, NGW = F.G * NWAVES;
    f32x4 g[8];
#pragma unroll
    for (int j = 0; j < 8; ++j) g[j] = *(const f32x4*)(gain + (F.lane + 64 * j) * 4);
    for (int m = gw; m < MROWS; m += NGW) {
        const GAS f32x4* xr = (const GAS f32x4*)(x + (size_t)m * DM) + F.lane;
        f32x4 v[8]; float s = 0.f;
#pragma unroll
        for (int j = 0; j < 8; ++j) { v[j] = xr[64 * j]; s += (v[j].x * v[j].x + v[j].y * v[j].y) + (v[j].z * v[j].z + v[j].w * v[j].w); }
        const float rstd = 1.0f / sqrtf(wave_sum(s) * (1.0f / DM) + RMS_EPS);
        GAS unsigned long long* o8 = (GAS unsigned long long*)(out + (size_t)m * DM) + F.lane;
#pragma unroll
        for (int j = 0; j < 8; ++j) { const f32x4 y = v[j] * rstd * g[j]; o8[64 * j] = (unsigned long long)pkbf(y.x, y.y) | ((unsigned long long)pkbf(y.z, y.w) << 32); }
    }
}

typedef float f32x16 __attribute__((ext_vector_type(16)));
typedef short v4i16_t __attribute__((ext_vector_type(4)));
typedef unsigned u32x4 __attribute__((ext_vector_type(4)));
typedef unsigned u32x2 __attribute__((ext_vector_type(2)));
__device__ __forceinline__ int crow(int r, int hi) { return (r & 3) + 8 * (r >> 2) + 4 * hi; }
__device__ __forceinline__ bf16x8 mk8(v4i16_t lo, v4i16_t hi) { return (bf16x8){lo[0], lo[1], lo[2], lo[3], hi[0], hi[1], hi[2], hi[3]}; }
__device__ __forceinline__ v4i16_t ldtr(const LAS unsigned char* p) { return __builtin_amdgcn_ds_read_tr16_b64_v4i16((LAS v4i16_t*)p); }
__device__ __forceinline__ bf16x8 pack8(float a0, float a1, float a2, float a3, float a4, float a5, float a6, float a7) {
    u32x4 w; w.x = pkbf(a0, a1); w.y = pkbf(a2, a3); w.z = pkbf(a4, a5); w.w = pkbf(a6, a7); return __builtin_bit_cast(bf16x8, w); }
__device__ __forceinline__ int t5_bucket(int d) {
    if (d < 16) return d;
    int b = 15; b += (d >= 16); b += (d >= 19); b += (d >= 21); b += (d >= 24); b += (d >= 27); b += (d >= 31); b += (d >= 35); b += (d >= 40);
    b += (d >= 46); b += (d >= 52); b += (d >= 59); b += (d >= 67); b += (d >= 77); b += (d >= 87); b += (d >= 99); b += (d >= 113); return b;
}

__device__ __forceinline__ void phase_swa(Frame& F, const bf16* proj, const float* q_gain, const float* k_gain, const float* sinks, const float* rel, bf16* og) {
    LAS unsigned char* KS = F.lds;
    LAS unsigned char* VS = F.lds + 36864;
    LAS float* BT = (LAS float*)(F.lds + 36864 + 32768) + F.wave * 128;
    const int lane = F.lane, r32 = lane & 31, hi = lane >> 5, wave = F.wave, tid = F.tid;
    const int g16 = lane >> 4, q4 = (lane & 15) >> 2, p4 = lane & 3;
    for (int u = F.vcu; u < 1024; u += F.G) {
        const int b = u >> 6, kvh = (u >> 4) & 3, j = u & 15;
        const size_t rowbase = (size_t)b * SEQ;
        const int head = kvh * 8 + wave;
        __syncthreads();
#pragma unroll
        for (int i = 0; i < 4; ++i) {
            const int s = (tid >> 3) + 64 * i, ch = tid & 7, t = j * 128 - 128 + s;
            u32x4 kv = {0u, 0u, 0u, 0u}, vv = {0u, 0u, 0u, 0u};
            if (t >= 0) { const bf16* rp = proj + (rowbase + t) * P0 + kvh * 64 + ch * 8; kv = *(const GAS u32x4*)(rp + 2048); vv = *(const GAS u32x4*)(rp + 2304); }
            float kf[8] = {bflo(kv.x), bfhi(kv.x), bflo(kv.y), bfhi(kv.y), bflo(kv.z), bfhi(kv.z), bflo(kv.w), bfhi(kv.w)};
            float ss = 0.f;
#pragma unroll
            for (int e = 0; e < 8; ++e) ss += kf[e] * kf[e];
            ss += __shfl_xor(ss, 1); ss += __shfl_xor(ss, 2); ss += __shfl_xor(ss, 4);
            const float rstd = 1.0f / sqrtf(ss * (1.0f / 64.0f) + RMS_EPS);
            const f32x4 g0 = *(const f32x4*)(k_gain + ch * 8), g1 = *(const f32x4*)(k_gain + ch * 8 + 4);
            u32x4 ko; ko.x = pkbf(kf[0] * rstd * g0.x, kf[1] * rstd * g0.y); ko.y = pkbf(kf[2] * rstd * g0.z, kf[3] * rstd * g0.w);
            ko.z = pkbf(kf[4] * rstd * g1.x, kf[5] * rstd * g1.y); ko.w = pkbf(kf[6] * rstd * g1.z, kf[7] * rstd * g1.w);
            *(LAS u32x4*)(KS + s * 144 + ch * 16) = ko;
            *(LAS u32x4*)(VS + (ch >> 2) * 16384 + s * 64 + (ch & 3) * 16) = vv;
        }
        for (int dd = lane; dd < 128; dd += 64) BT[dd] = rel[t5_bucket(dd) * 32 + head] * LOG2E;
        const float sink2 = sinks[head] * LOG2E;
        __syncthreads();
        const int ktmin = (j == 0) ? 4 : 0;
        for (int qs = 0; qs < 4; ++qs) {
            const size_t qrow = rowbase + j * 128 + qs * 32 + r32;
            const bf16* qp = proj + qrow * P0 + head * 64 + hi * 8;
            u32x4 qraw[4]; float ss = 0.f;
#pragma unroll
            for (int s4 = 0; s4 < 4; ++s4) { qraw[s4] = *(const GAS u32x4*)(qp + s4 * 16);
#pragma unroll
                for (int e = 0; e < 4; ++e) { const float a = bflo(qraw[s4][e]), c = bfhi(qraw[s4][e]); ss += a * a + c * c; } }
            ss += __shfl_xor(ss, 32);
            const float qsc = (0.125f * LOG2E) / sqrtf(ss * (1.0f / 64.0f) + RMS_EPS);
            bf16x8 qfr[4];
#pragma unroll
            for (int s4 = 0; s4 < 4; ++s4) { const f32x4 g0 = *(const f32x4*)(q_gain + s4 * 16 + hi * 8), g1 = *(const f32x4*)(q_gain + s4 * 16 + hi * 8 + 4);
                qfr[s4] = pack8(bflo(qraw[s4].x) * qsc * g0.x, bfhi(qraw[s4].x) * qsc * g0.y, bflo(qraw[s4].y) * qsc * g0.z, bfhi(qraw[s4].y) * qsc * g0.w,
                                bflo(qraw[s4].z) * qsc * g1.x, bfhi(qraw[s4].z) * qsc * g1.y, bflo(qraw[s4].w) * qsc * g1.z, bfhi(qraw[s4].w) * qsc * g1.w); }
            f32x16 S[5];
#pragma unroll
            for (int tt = 0; tt < 5; ++tt) {
                const int kt = qs + tt;
                if (kt >= ktmin) {
                    f32x16 acc;
#pragma unroll
                    for (int r = 0; r < 16; ++r) acc[r] = 0.f;
                    const LAS unsigned char* kp = KS + (32 * kt + r32) * 144 + hi * 16;
#pragma unroll
                    for (int s4 = 0; s4 < 4; ++s4) acc = __builtin_amdgcn_mfma_f32_32x32x16_bf16(*(const LAS bf16x8*)(kp + s4 * 32), qfr[s4], acc, 0, 0, 0);
#pragma unroll
                    for (int r = 0; r < 16; ++r) { const int c = crow(r, hi); const int dist = r32 + 128 - 32 * tt - c;
                        const bool valid = (tt == 0) ? (c > r32) : ((tt == 4) ? (c <= r32) : true);
                        const float bsv = BT[dist & 127];
                        acc[r] = valid ? acc[r] + bsv : -INFINITY; }
                    S[tt] = acc;
                } else {
#pragma unroll
                    for (int r = 0; r < 16; ++r) S[tt][r] = -INFINITY;
                }
            }
            float mx = sink2;
#pragma unroll
            for (int tt = 0; tt < 5; ++tt)
#pragma unroll
                for (int r = 0; r < 16; ++r) mx = fmaxf(mx, S[tt][r]);
            mx = fmaxf(mx, __shfl_xor(mx, 32));
            float l = 0.f;
#pragma unroll
            for (int tt = 0; tt < 5; ++tt)
#pragma unroll
                for (int r = 0; r < 16; ++r) { const float p = __builtin_amdgcn_exp2f(S[tt][r] - mx); S[tt][r] = p; l += p; }
            l += __shfl_xor(l, 32); l += __builtin_amdgcn_exp2f(sink2 - mx);
            const float rl = 1.0f / l;
            f32x16 O[2];
#pragma unroll
            for (int r = 0; r < 16; ++r) { O[0][r] = 0.f; O[1][r] = 0.f; }
#pragma unroll
            for (int tt = 0; tt < 5; ++tt) {
                const int kt = qs + tt;
                if (kt >= ktmin) {
#pragma unroll
                    for (int s2 = 0; s2 < 2; ++s2) {
                        const bf16x8 pf = pack8(S[tt][8 * s2 + 0], S[tt][8 * s2 + 1], S[tt][8 * s2 + 2], S[tt][8 * s2 + 3], S[tt][8 * s2 + 4], S[tt][8 * s2 + 5], S[tt][8 * s2 + 6], S[tt][8 * s2 + 7]);
#pragma unroll
                        for (int db = 0; db < 2; ++db) {
                            const LAS unsigned char* va = VS + db * 16384 + (32 * kt + 16 * s2 + 4 * (g16 >> 1) + q4) * 64 + (g16 & 1) * 32 + p4 * 8;
                            const v4i16_t lo = ldtr(va), hh = ldtr(va + 512);
                            O[db] = __builtin_amdgcn_mfma_f32_32x32x16_bf16(mk8(lo, hh), pf, O[db], 0, 0, 0);
                        }
                    }
                }
            }
#pragma unroll
            for (int db = 0; db < 2; ++db)
#pragma unroll
                for (int g4 = 0; g4 < 4; ++g4) { const int d0 = db * 32 + 8 * g4 + 4 * hi;
                    const u32x2 gv = *(const GAS u32x2*)(proj + qrow * P0 + 2560 + head * 64 + d0);
                    const float o0 = O[db][4 * g4 + 0] * rl * siluf(bflo(gv.x)), o1 = O[db][4 * g4 + 1] * rl * siluf(bfhi(gv.x));
                    const float o2 = O[db][4 * g4 + 2] * rl * siluf(bflo(gv.y)), o3 = O[db][4 * g4 + 3] * rl * siluf(bfhi(gv.y));
                    u32x2 w; w.x = pkbf(o0, o1); w.y = pkbf(o2, o3);
                    *(GAS u32x2*)(og + qrow * 2048 + head * 64 + d0) = w; }
        }
    }
}

__device__ __forceinline__ void phase_mix_from_x(Frame& F, const float* x, const float* gain, const float* mixA, const float* mixB, bf16* hout, bf16* xa, bf16* xb) {
    const int gw = F.vcu * NWAVES + F.wave, NGW = F.G * NWAVES;
    for (int run = gw; run < MROWS / 8; run += NGW) {
        const int m0 = run * 8;
        f32x4 prev[8];
        if ((m0 & (SEQ - 1)) == 0) {
#pragma unroll
            for (int j = 0; j < 8; ++j) prev[j] = (f32x4){0.f, 0.f, 0.f, 0.f};
        } else {
            const GAS f32x4* xr = (const GAS f32x4*)(x + (size_t)(m0 - 1) * DM) + F.lane; float s = 0.f;
#pragma unroll
            for (int j = 0; j < 8; ++j) { prev[j] = xr[64 * j]; s += (prev[j].x * prev[j].x + prev[j].y * prev[j].y) + (prev[j].z * prev[j].z + prev[j].w * prev[j].w); }
            const float rstd = 1.0f / sqrtf(wave_sum(s) * (1.0f / DM) + RMS_EPS);
#pragma unroll
            for (int j = 0; j < 8; ++j) prev[j] = prev[j] * rstd * *(const f32x4*)(gain + (F.lane + 64 * j) * 4);
        }
        for (int r = 0; r < 8; ++r) {
            const size_t m = (size_t)(m0 + r);
            const GAS f32x4* xr = (const GAS f32x4*)(x + m * DM) + F.lane;
            f32x4 v[8]; float s = 0.f;
#pragma unroll
            for (int j = 0; j < 8; ++j) { v[j] = xr[64 * j]; s += (v[j].x * v[j].x + v[j].y * v[j].y) + (v[j].z * v[j].z + v[j].w * v[j].w); }
            const float rstd = 1.0f / sqrtf(wave_sum(s) * (1.0f / DM) + RMS_EPS);
            GAS unsigned long long* oh = (GAS unsigned long long*)(hout + m * DM) + F.lane;
            GAS unsigned long long* oa = (GAS unsigned long long*)(xa + m * DM) + F.lane;
            GAS unsigned long long* ob = (GAS unsigned long long*)(xb + m * DM) + F.lane;
#pragma unroll
            for (int j = 0; j < 8; ++j) {
                const int c = (F.lane + 64 * j) * 4;
                const f32x4 hcur = v[j] * rstd * *(const f32x4*)(gain + c);
                const f32x4 d = prev[j] - hcur;
                const f32x4 ya = hcur + d * *(const f32x4*)(mixA + c), yb = hcur + d * *(const f32x4*)(mixB + c);
                oh[64 * j] = (unsigned long long)pkbf(hcur.x, hcur.y) | ((unsigned long long)pkbf(hcur.z, hcur.w) << 32);
                oa[64 * j] = (unsigned long long)pkbf(ya.x, ya.y) | ((unsigned long long)pkbf(ya.z, ya.w) << 32);
                ob[64 * j] = (unsigned long long)pkbf(yb.x, yb.y) | ((unsigned long long)pkbf(yb.z, yb.w) << 32);
                prev[j] = hcur;
            }
        }
    }
}
__device__ __forceinline__ void phase_mix_from_h(Frame& F, const bf16* h, const float* mixA, bf16* xa, const float* mixB, bf16* xb) {
    const int gw = F.vcu * NWAVES + F.wave, NGW = F.G * NWAVES;
    for (int run = gw; run < MROWS / 8; run += NGW) {
        const int m0 = run * 8;
        u32x4 prev[4];
        if ((m0 & (SEQ - 1)) == 0) {
#pragma unroll
            for (int j = 0; j < 4; ++j) prev[j] = (u32x4){0u, 0u, 0u, 0u};
        } else {
            const GAS u32x4* hr = (const GAS u32x4*)(h + (size_t)(m0 - 1) * DM) + F.lane;
#pragma unroll
            for (int j = 0; j < 4; ++j) prev[j] = hr[64 * j];
        }
        for (int r = 0; r < 8; ++r) {
            const size_t m = (size_t)(m0 + r);
            const GAS u32x4* hr = (const GAS u32x4*)(h + m * DM) + F.lane;
            u32x4 cur[4];
#pragma unroll
            for (int j = 0; j < 4; ++j) cur[j] = hr[64 * j];
#pragma unroll
            for (int j = 0; j < 4; ++j) {
                const int c = (F.lane + 64 * j) * 8;
                const f32x4 ma0 = *(const f32x4*)(mixA + c), ma1 = *(const f32x4*)(mixA + c + 4);
                float hc[8], hp[8];
#pragma unroll
                for (int e = 0; e < 4; ++e) { hc[2 * e] = bflo(cur[j][e]); hc[2 * e + 1] = bfhi(cur[j][e]); hp[2 * e] = bflo(prev[j][e]); hp[2 * e + 1] = bfhi(prev[j][e]); }
                const float ma[8] = {ma0.x, ma0.y, ma0.z, ma0.w, ma1.x, ma1.y, ma1.z, ma1.w};
                u32x4 o;
#pragma unroll
                for (int e = 0; e < 4; ++e) o[e] = pkbf(hc[2 * e] + (hp[2 * e] - hc[2 * e]) * ma[2 * e], hc[2 * e + 1] + (hp[2 * e + 1] - hc[2 * e + 1]) * ma[2 * e + 1]);
                *((GAS u32x4*)(xa + m * DM) + F.lane + 64 * j) = o;
                if (xb) {
                    const f32x4 mb0 = *(const f32x4*)(mixB + c), mb1 = *(const f32x4*)(mixB + c + 4);
                    const float mb[8] = {mb0.x, mb0.y, mb0.z, mb0.w, mb1.x, mb1.y, mb1.z, mb1.w};
#pragma unroll
                    for (int e = 0; e < 4; ++e) o[e] = pkbf(hc[2 * e] + (hp[2 * e] - hc[2 * e]) * mb[2 * e], hc[2 * e + 1] + (hp[2 * e + 1] - hc[2 * e + 1]) * mb[2 * e + 1]);
                    *((GAS u32x4*)(xb + m * DM) + F.lane + 64 * j) = o;
                }
            }
#pragma unroll
            for (int j = 0; j < 4; ++j) prev[j] = cur[j];
        }
    }
}
__device__ __forceinline__ void convert_lora2(Frame& F, const float* wl2, const float* al2, bf16* WT) {
    const int total = 4096 * 256;
    for (int i = blockIdx.x * 512 + F.tid; i < total; i += F.G * 512) {
        const int k = i >> 12, n = i & 4095;
        float v = 0.f;
        if (n < 2048) { if (k < 96) v = wl2[(size_t)k * 2048 + n]; } else { if (k >= 128 && k < 224) v = al2[(size_t)(k - 128) * 2048 + (n - 2048)]; }
        WT[(size_t)n * 256 + k] = (bf16)f2bf(v);
    }
}

constexpr int RW_T = 16;
constexpr int RW_OPB = 5 * RW_T * 64 * 4;
constexpr int RW_VBB = RW_T * 65 * 4 + 60;
constexpr int RW_VB = 4224;
constexpr int RW_YB = RW_T * 64 * 4;
constexpr int RW_SEQ_BYTES = 2 * RW_OPB + 3 * RW_VB + 2 * RW_YB;
static_assert(2 * RW_SEQ_BYTES <= RING_BYTES, "rwkv LDS");
template <int CTRL> __device__ __forceinline__ float dppmov(float v) { return __builtin_bit_cast(float, __builtin_amdgcn_mov_dpp(__builtin_bit_cast(int, v), CTRL, 0xf, 0xf, true)); }
__device__ __forceinline__ float red8(float v) {
    v += dppmov<0xB1>(v);
    v += dppmov<0x4E>(v);
    v += dppmov<0x141>(v);
    return v;
}
__device__ __forceinline__ void phase_rwkv(Frame& F, const bf16* Rb, const bf16* Kb, const bf16* Vb, const bf16* Gb, const bf16* LWb, const bf16* Ab,
                                           const float* k_k, const float* k_a, const float* r_k, const float* gn_w, const float* gn_b, bf16* out) {
    const int lane = F.lane, sq = F.wave >> 2, wq = F.wave & 3, tid4 = wq * 64 + lane;
    const int rp = tid4 >> 3, kg = tid4 & 7;
    LAS unsigned char* base = F.lds + sq * RW_SEQ_BYTES;
    constexpr int NB = SEQ / RW_T;
    for (int s0 = 2 * F.vcu; s0 < BATCH * 32; s0 += 2 * F.G) {
        const int seq = s0 + sq, b = seq >> 5, hd = seq & 31;
        const size_t rowbase = (size_t)b * SEQ; const int cb = hd * 64;
        const float kkc = k_k[cb + lane], kac = k_a[cb + lane], rkc = r_k[cb + lane], gw_ = gn_w[cb + lane], gb_ = gn_b[cb + lane];
        float st[2][8];
#pragma unroll
        for (int i = 0; i < 2; ++i)
#pragma unroll
            for (int e = 0; e < 8; ++e) st[i][e] = 0.f;
        __syncthreads();
        for (int it = 0; it < NB + 2; ++it) {
            if (it < NB) {
                LAS float* OP = (LAS float*)(base + (it & 1) * RW_OPB);
                LAS float* VB = (LAS float*)(base + 2 * RW_OPB + (it % 3) * RW_VB);
                unsigned short rr[4], kk_[4], vv[4], lw[4], aa[4];
#pragma unroll
                for (int i = 0; i < 4; ++i) { const size_t o = (rowbase + it * RW_T + 4 * wq + i) * DM + cb + lane;
                    rr[i] = Rb[o]; kk_[i] = Kb[o]; vv[i] = Vb[o]; lw[i] = LWb[o]; aa[i] = Ab[o]; }
#pragma unroll
                for (int i = 0; i < 4; ++i) { const int tl = 4 * wq + i;
                    const float r = bf2f(rr[i]), k = bf2f(kk_[i]), v = bf2f(vv[i]), w = __expf(bf2f(lw[i])), a = bf2f(aa[i]);
                    const float kkv = k * kkc; const float nrm = sqrtf(wave_sum(kkv * kkv)); const float kkn = kkv / fmaxf(nrm, 1e-12f);
                    const float kp = k * (1.0f + (a - 1.0f) * kac);
                    const float bon = wave_sum(r * kp * rkc);
                    OP[(0 * RW_T + tl) * 64 + lane] = w; OP[(1 * RW_T + tl) * 64 + lane] = -kkn; OP[(2 * RW_T + tl) * 64 + lane] = kkn * a;
                    OP[(3 * RW_T + tl) * 64 + lane] = kp; OP[(4 * RW_T + tl) * 64 + lane] = r;
                    VB[tl * 64 + lane] = v; if (lane == 0) VB[RW_T * 64 + tl] = bon; }
            }
            if (it >= 1 && it <= NB) {
                const int bi = it - 1;
                const LAS float* OP = (const LAS float*)(base + (bi & 1) * RW_OPB);
                const LAS float* VB = (const LAS float*)(base + 2 * RW_OPB + (bi % 3) * RW_VB);
                LAS float* YB = (LAS float*)(base + 2 * RW_OPB + 3 * RW_VB + (bi & 1) * RW_YB);
#pragma unroll 2
                for (int tl = 0; tl < RW_T; ++tl) {
                    const f32x4 w0 = *(const LAS f32x4*)(OP + (0 * RW_T + tl) * 64 + kg * 8), w1 = *(const LAS f32x4*)(OP + (0 * RW_T + tl) * 64 + kg * 8 + 4);
                    const f32x4 n0 = *(const LAS f32x4*)(OP + (1 * RW_T + tl) * 64 + kg * 8), n1 = *(const LAS f32x4*)(OP + (1 * RW_T + tl) * 64 + kg * 8 + 4);
                    const f32x4 b0 = *(const LAS f32x4*)(OP + (2 * RW_T + tl) * 64 + kg * 8), b1 = *(const LAS f32x4*)(OP + (2 * RW_T + tl) * 64 + kg * 8 + 4);
                    const f32x4 k0 = *(const LAS f32x4*)(OP + (3 * RW_T + tl) * 64 + kg * 8), k1 = *(const LAS f32x4*)(OP + (3 * RW_T + tl) * 64 + kg * 8 + 4);
                    const f32x4 r0 = *(const LAS f32x4*)(OP + (4 * RW_T + tl) * 64 + kg * 8), r1 = *(const LAS f32x4*)(OP + (4 * RW_T + tl) * 64 + kg * 8 + 4);
                    const float wv[8] = {w0.x, w0.y, w0.z, w0.w, w1.x, w1.y, w1.z, w1.w}, nv[8] = {n0.x, n0.y, n0.z, n0.w, n1.x, n1.y, n1.z, n1.w};
                    const float bv[8] = {b0.x, b0.y, b0.z, b0.w, b1.x, b1.y, b1.z, b1.w}, kv[8] = {k0.x, k0.y, k0.z, k0.w, k1.x, k1.y, k1.z, k1.w};
                    const float rv[8] = {r0.x, r0.y, r0.z, r0.w, r1.x, r1.y, r1.z, r1.w};
                    const float v0 = VB[tl * 64 + 2 * rp], v1 = VB[tl * 64 + 2 * rp + 1];
                    float sa0 = 0.f, sa1 = 0.f;
#pragma unroll
                    for (int e = 0; e < 8; ++e) { sa0 = fmaf(st[0][e], nv[e], sa0); sa1 = fmaf(st[1][e], nv[e], sa1); }
                    sa0 = red8(sa0); sa1 = red8(sa1);
                    float y0 = 0.f, y1 = 0.f;
#pragma unroll
                    for (int e = 0; e < 8; ++e) {
                        st[0][e] = fmaf(v0, kv[e], fmaf(sa0, bv[e], st[0][e] * wv[e]));
                        st[1][e] = fmaf(v1, kv[e], fmaf(sa1, bv[e], st[1][e] * wv[e]));
                        y0 = fmaf(st[0][e], rv[e], y0); y1 = fmaf(st[1][e], rv[e], y1); }
                    y0 = red8(y0); y1 = red8(y1);
                    if (kg == 0) { YB[tl * 64 + 2 * rp] = y0; YB[tl * 64 + 2 * rp + 1] = y1; }
                }
            }
            if (it >= 2) {
                const int bi = it - 2;
                const LAS float* VB = (const LAS float*)(base + 2 * RW_OPB + (bi % 3) * RW_VB);
                const LAS float* YB = (const LAS float*)(base + 2 * RW_OPB + 3 * RW_VB + (bi & 1) * RW_YB);
                unsigned short gg[4];
#pragma unroll
                for (int i = 0; i < 4; ++i) gg[i] = Gb[(rowbase + bi * RW_T + 4 * wq + i) * DM + cb + lane];
#pragma unroll
                for (int i = 0; i < 4; ++i) { const int tl = 4 * wq + i;
                    const float y = YB[tl * 64 + lane];
                    const float mu = wave_sum(y) * (1.0f / 64.0f); const float d = y - mu; const float var = wave_sum(d * d) * (1.0f / 64.0f);
                    float o = d * (1.0f / sqrtf(var + GN_EPS)) * gw_ + gb_ + VB[RW_T * 64 + tl] * VB[tl * 64 + lane];
                    o *= siluf(bf2f(gg[i]));
                    out[(rowbase + bi * RW_T + tl) * DM + cb + lane] = (bf16)f2bf(o); }
            }
            __syncthreads();
        }
    }
}

typedef float f32x4v __attribute__((ext_vector_type(4)));
__device__ __forceinline__ int sw_off(int row, int chunk) { return row * 256 + ((chunk ^ (row & 15)) << 4); }
constexpr int ML_QS = 0, ML_KS = 32768, ML_VS = 65536, ML_SW = 98304;
constexpr int ML_GA2 = MISC_OFF + 256, ML_GM2 = ML_GA2 + 512, ML_GBL = ML_GM2 + 512, ML_DEN = ML_GBL + 512, ML_NQ = ML_DEN + 512, ML_NV = ML_NQ + 512, ML_WSV = ML_NV + 512, ML_SC = ML_WSV + 512;
static_assert(ML_SC + 64 <= LDS_BYTES, "mlstm LDS");
__device__ __forceinline__ void phase_mlstm(Frame& F, const bf16* proj, const float* GXp, const float* b_i, const float* b_f, float* hs) {
    const int lane0 = F.lane, wave = F.wave;
    LAS unsigned char* L = F.lds;
#define ML_LANES() int lane = lane0; asm volatile("" : "+v"(lane)); const int tid = wave * 64 + lane, l15 = lane & 15, g = lane >> 4, q4 = l15 >> 2, p4 = lane & 3; (void)tid; (void)q4; (void)p4; (void)l15; (void)g
    LAS float* GA2 = (LAS float*)(L + ML_GA2); LAS float* GM2 = (LAS float*)(L + ML_GM2); LAS float* GBL = (LAS float*)(L + ML_GBL); LAS float* DEN = (LAS float*)(L + ML_DEN);
    LAS float* NQ = (LAS float*)(L + ML_NQ); LAS float* NV = (LAS float*)(L + ML_NV); LAS float* WSV = (LAS float*)(L + ML_WSV); LAS float* SC = (LAS float*)(L + ML_SC);
    constexpr float LOG2SC = -3.5f;
    for (int item = F.vcu; item < BATCH * 8 * 2; item += F.G) {
        const int b = item >> 4, h = (item >> 1) & 7, vh = item & 1;
        const size_t rowbase = (size_t)b * SEQ;
        const float bi = b_i[h], bfv = b_f[h];
        f32x4v st[8], nst;
#pragma unroll
        for (int kb = 0; kb < 8; ++kb) st[kb] = (f32x4v){0.f, 0.f, 0.f, 0.f};
        nst = (f32x4v){0.f, 0.f, 0.f, 0.f};
        __syncthreads();
        { ML_LANES(); if (tid < 128) NV[tid] = 0.f;
          if (tid == 0) { SC[0] = 0.f; SC[1] = 0.f; } }
        for (int c = 0; c < 16; ++c) {
            const int par = c & 1;
            const size_t row0 = rowbase + (size_t)c * 128;
            {
                ML_LANES();
                const bf16* qg = proj + row0 * P2 + h * 128;
                const bf16* vg = proj + row0 * P2 + 2048 + h * 256 + vh * 128;
#pragma unroll
                for (int i = 0; i < 4; ++i) { const int idx = tid + 512 * i, row = idx >> 4, ch = idx & 15;
                    const u32x4 qv = *(const GAS u32x4*)(qg + (size_t)row * P2 + ch * 8), kv = *(const GAS u32x4*)(qg + (size_t)row * P2 + 1024 + ch * 8), vv = *(const GAS u32x4*)(vg + (size_t)row * P2 + ch * 8);
                    const int o = sw_off(row, ch);
                    *(LAS u32x4*)(L + ML_QS + o) = qv; *(LAS u32x4*)(L + ML_KS + o) = kv; *(LAS u32x4*)(L + ML_VS + o) = vv; }
            }
            if (wave == 0) {
                ML_LANES();
                const int t0 = 2 * lane;
                const float i0 = GXp[(row0 + t0) * 32 + h] + bi, i1 = GXp[(row0 + t0 + 1) * 32 + h] + bi;
                const float f0 = logsigf(GXp[(row0 + t0) * 32 + 8 + h] + bfv), f1 = logsigf(GXp[(row0 + t0 + 1) * 32 + 8 + h] + bfv);
                const float pr = f0 + f1; float incl = pr;
#pragma unroll
                for (int o = 1; o < 64; o <<= 1) { const float y = __shfl_up(incl, o); if (lane >= o) incl += y; }
                const float excl = incl - pr, b0 = excl + f0, b1 = excl + pr;
                const float a0 = i0 - b0, a1 = i1 - b1;
                float im = fmaxf(a0, a1);
#pragma unroll
                for (int o = 1; o < 64; o <<= 1) { const float y = __shfl_up(im, o); if (lane >= o) im = fmaxf(im, y); }
                float exm = __shfl_up(im, 1); if (lane == 0) exm = -INFINITY;
                const float mprev = SC[par];
                const float M0 = fmaxf(mprev, fmaxf(exm, a0)), M1 = fmaxf(mprev, im);
                const float M127 = __shfl(M1, 63), g127 = __shfl(b1, 63);
                GA2[t0] = a0 * LOG2E; GA2[t0 + 1] = a1 * LOG2E; GM2[t0] = M0 * LOG2E; GM2[t0 + 1] = M1 * LOG2E;
                GBL[t0] = (b0 + M0) * LOG2E; GBL[t0 + 1] = (b1 + M1) * LOG2E; DEN[t0] = 0.f; DEN[t0 + 1] = 0.f;
                WSV[t0] = __builtin_amdgcn_exp2f((a0 - M127) * LOG2E); WSV[t0 + 1] = __builtin_amdgcn_exp2f((a1 - M127) * LOG2E);
                if (lane == 0) { SC[par ^ 1] = g127 + M127; SC[2] = M127 * LOG2E; }
            }
            __syncthreads();
            const float m2 = SC[par] * LOG2E, M2_127 = SC[2];
            {
            ML_LANES();
            for (int idx = wave; idx < 40; idx += 8) {
                int tb, bs; if (idx < 2) { tb = 0; bs = 0; } else if (idx < 4) { tb = 1; bs = 2; } else if (idx < 8) { tb = 2; bs = 4; } else if (idx < 12) { tb = 3; bs = 8; }
                else if (idx < 18) { tb = 4; bs = 12; } else if (idx < 24) { tb = 5; bs = 18; } else if (idx < 32) { tb = 6; bs = 24; } else { tb = 7; bs = 32; }
                const int sb = idx - bs;
                f32x4v acc = (f32x4v){0.f, 0.f, 0.f, 0.f};
                const int srow = 16 * sb + l15, trow = 16 * tb + l15;
#pragma unroll
                for (int ks = 0; ks < 4; ++ks) {
                    const bf16x8 af = *(const LAS bf16x8*)(L + ML_KS + sw_off(srow, 4 * ks + g)), bfr = *(const LAS bf16x8*)(L + ML_QS + sw_off(trow, 4 * ks + g));
                    acc = __builtin_amdgcn_mfma_f32_16x16x32_bf16(af, bfr, acc, 0, 0, 0); }
                const float M2t = GM2[trow]; const f32x4v a2 = *(const LAS f32x4v*)(GA2 + 16 * sb + 4 * g);
                float val[4];
#pragma unroll
                for (int r = 0; r < 4; ++r) { const int s = 16 * sb + 4 * g + r; const float w = (s <= trow) ? __builtin_amdgcn_exp2f(a2[r] - M2t + LOG2SC) : 0.f; val[r] = acc[r] * w; }
                float d = (val[0] + val[1]) + (val[2] + val[3]); d += __shfl_xor(d, 16); d += __shfl_xor(d, 32);
                if (g == 0) __hip_atomic_fetch_add(DEN + trow, d, __ATOMIC_RELAXED, __HIP_MEMORY_SCOPE_WORKGROUP);
                u32x2 pk; pk.x = pkbf(val[0], val[1]); pk.y = pkbf(val[2], val[3]);
                *(LAS u32x2*)(L + ML_SW + sw_off(trow, 2 * sb + (g >> 1)) + (g & 1) * 8) = pk;
            }
            {
                const int trow = 16 * wave + l15; float s = 0.f;
#pragma unroll
                for (int i = 0; i < 4; ++i) { const u32x4 qv = *(const LAS u32x4*)(L + ML_QS + sw_off(trow, 4 * g + i));
                    const f32x4v n0 = *(const LAS f32x4v*)(NV + 32 * g + 8 * i), n1 = *(const LAS f32x4v*)(NV + 32 * g + 8 * i + 4);
                    s += bflo(qv.x) * n0.x + bfhi(qv.x) * n0.y + bflo(qv.y) * n0.z + bfhi(qv.y) * n0.w + bflo(qv.z) * n1.x + bfhi(qv.z) * n1.y + bflo(qv.w) * n1.z + bfhi(qv.w) * n1.w; }
                s += __shfl_xor(s, 16); s += __shfl_xor(s, 32);
                if (g == 0) NQ[trow] = s;
            }
            }
            __syncthreads();
            f32x4v num[8];
            {
                ML_LANES();
                bf16x8 cf[4];
#pragma unroll
                for (int kp = 0; kp < 4; ++kp) cf[kp] = pack8(st[2 * kp][0], st[2 * kp][1], st[2 * kp][2], st[2 * kp][3], st[2 * kp + 1][0], st[2 * kp + 1][1], st[2 * kp + 1][2], st[2 * kp + 1][3]);
#pragma unroll
                for (int tb = 0; tb < 8; ++tb) {
                    const int trow = 16 * tb + l15; f32x4v acc = (f32x4v){0.f, 0.f, 0.f, 0.f};
#pragma unroll
                    for (int kp = 0; kp < 4; ++kp) {
                        const u32x2 lo = *(const LAS u32x2*)(L + ML_QS + sw_off(trow, 4 * kp + (g >> 1)) + (g & 1) * 8), hh = *(const LAS u32x2*)(L + ML_QS + sw_off(trow, 4 * kp + 2 + (g >> 1)) + (g & 1) * 8);
                        const u32x4 bw = {lo.x, lo.y, hh.x, hh.y};
                        acc = __builtin_amdgcn_mfma_f32_16x16x32_bf16(cf[kp], __builtin_bit_cast(bf16x8, bw), acc, 0, 0, 0); }
                    const float wi = __builtin_amdgcn_exp2f(m2 - GM2[trow] + LOG2SC);
                    num[tb] = acc * wi;
                    asm volatile("" ::: "memory");
                }
            }
            bf16x8 vfr[4];
            {
            ML_LANES();
#pragma unroll
            for (int sc = 0; sc < 4; ++sc) {
                const int rA = 32 * sc + 8 * g + q4, rB = rA + 4;
                const v4i16_t lo = ldtr(L + ML_VS + sw_off(rA, 2 * wave + (p4 >> 1)) + (p4 & 1) * 8), hh = ldtr(L + ML_VS + sw_off(rB, 2 * wave + (p4 >> 1)) + (p4 & 1) * 8);
                vfr[sc] = mk8(lo, hh);
#pragma unroll
                for (int tb = 0; tb < 8; ++tb) if (tb >= 2 * sc) {
                    const int trow = 16 * tb + l15;
                    const bf16x8 bfr = *(const LAS bf16x8*)(L + ML_SW + sw_off(trow, 4 * sc + g));
                    num[tb] = __builtin_amdgcn_mfma_f32_16x16x32_bf16(vfr[sc], bfr, num[tb], 0, 0, 0); }
                asm volatile("" ::: "memory");
            }
#pragma unroll
            for (int tb = 0; tb < 8; ++tb) {
                const int trow = 16 * tb + l15;
                const float den = __builtin_amdgcn_exp2f(m2 - GM2[trow] + LOG2SC) * NQ[trow] + DEN[trow];
                const float rd = 1.0f / fmaxf(fabsf(den), __builtin_amdgcn_exp2f(-GBL[trow]));
                *(GAS f32x4v*)(hs + (row0 + trow) * 2048 + h * 256 + vh * 128 + 16 * wave + 4 * g) = num[tb] * rd;
            }
            }
            {
                ML_LANES();
                const float cs = __builtin_amdgcn_exp2f(m2 - M2_127);
#pragma unroll
                for (int sc = 0; sc < 4; ++sc) {
                    const f32x4v wa = *(const LAS f32x4v*)(WSV + 32 * sc + 8 * g), wb = *(const LAS f32x4v*)(WSV + 32 * sc + 8 * g + 4);
                    const u32x4 vw = __builtin_bit_cast(u32x4, vfr[sc]);
                    vfr[sc] = pack8(bflo(vw.x) * wa.x, bfhi(vw.x) * wa.y, bflo(vw.y) * wa.z, bfhi(vw.y) * wa.w, bflo(vw.z) * wb.x, bfhi(vw.z) * wb.y, bflo(vw.w) * wb.z, bfhi(vw.w) * wb.w);
                }
#pragma unroll
                for (int kb = 0; kb < 8; ++kb) {
                    f32x4v acc = st[kb] * cs;
#pragma unroll
                    for (int sc = 0; sc < 4; ++sc) {
                        const int rA = 32 * sc + 8 * g + q4, rB = rA + 4;
                        const v4i16_t lo = ldtr(L + ML_KS + sw_off(rA, 2 * kb + (p4 >> 1)) + (p4 & 1) * 8), hh = ldtr(L + ML_KS + sw_off(rB, 2 * kb + (p4 >> 1)) + (p4 & 1) * 8);
                        acc = __builtin_amdgcn_mfma_f32_16x16x32_bf16(mk8(lo, hh), vfr[sc], acc, 0, 0, 0);
                    }
                    st[kb] = acc;
                    asm volatile("" ::: "memory");
                }
                f32x4v nacc = nst * cs;
#pragma unroll
                for (int sc = 0; sc < 4; ++sc) {
                    const int rA = 32 * sc + 8 * g + q4, rB = rA + 4;
                    const v4i16_t lo = ldtr(L + ML_KS + sw_off(rA, 2 * wave + (p4 >> 1)) + (p4 & 1) * 8), hh = ldtr(L + ML_KS + sw_off(rB, 2 * wave + (p4 >> 1)) + (p4 & 1) * 8);
                    const f32x4v wa = *(const LAS f32x4v*)(WSV + 32 * sc + 8 * g), wb = *(const LAS f32x4v*)(WSV + 32 * sc + 8 * g + 4);
                    nacc = __builtin_amdgcn_mfma_f32_16x16x32_bf16(mk8(lo, hh), pack8(wa.x, wa.y, wa.z, wa.w, wb.x, wb.y, wb.z, wb.w), nacc, 0, 0, 0);
                }
                nst = nacc;
                if (l15 == 0) *(LAS f32x4v*)(NV + 16 * wave + 4 * g) = nst;
            }
            __syncthreads();
        }
    }
}
#undef ML_LANES
__device__ __forceinline__ void phase_mlstm_post(Frame& F, const float* hs, const bf16* proj, const float* h_gain, bf16* out) {
    const int gw = F.vcu * NWAVES + F.wave, NGW = F.G * NWAVES;
    for (int m = gw; m < MROWS; m += NGW) {
        const GAS f32x4* xr = (const GAS f32x4*)(hs + (size_t)m * DM) + F.lane;
        const bf16* pr = proj + (size_t)m * P2;
        GAS unsigned long long* o8 = (GAS unsigned long long*)(out + (size_t)m * DM) + F.lane;
#pragma unroll
        for (int j = 0; j < 8; ++j) {
            const f32x4 v = xr[64 * j];
            const float ss = wave_sum((v.x * v.x + v.y * v.y) + (v.z * v.z + v.w * v.w));
            const float rstd = 1.0f / sqrtf(ss * (1.0f / 256.0f) + RMS_EPS);
            const int c = (F.lane + 64 * j) * 4;
            const f32x4 hg = *(const f32x4*)(h_gain + c);
            const u32x2 ov = *(const GAS u32x2*)(pr + 4096 + c), gv = *(const GAS u32x2*)(pr + 6144 + c);
            const float y0 = v.x * rstd * hg.x * sigmf(bflo(ov.x)) * siluf(bflo(gv.x)), y1 = v.y * rstd * hg.y * sigmf(bfhi(ov.x)) * siluf(bfhi(gv.x));
            const float y2 = v.z * rstd * hg.z * sigmf(bflo(ov.y)) * siluf(bflo(gv.y)), y3 = v.w * rstd * hg.w * sigmf(bfhi(ov.y)) * siluf(bfhi(gv.y));
            o8[64 * j] = (unsigned long long)pkbf(y0, y1) | ((unsigned long long)pkbf(y2, y3) << 32);
        }
    }
}

__device__ __forceinline__ void phase_fox_prep(Frame& F, bf16* proj, const float* GXp, const float* b_f, const float* q_gain, const float* k_gain, float* F2) {
    const int gw = F.vcu * NWAVES + F.wave, NGW = F.G * NWAVES, lane = F.lane;
    for (int task = gw; task < BATCH * 32; task += NGW) {
        const int b = task >> 5, h = task & 31; const float bf = b_f[h];
        const float* gp = GXp + ((size_t)b * SEQ + lane * 32) * 32 + h;
        float acc[32]; float run = 0.f;
#pragma unroll
        for (int i = 0; i < 32; ++i) { run += logsigf(gp[i * 32] + bf); acc[i] = run; }
        float incl = run;
#pragma unroll
        for (int o = 1; o < 64; o <<= 1) { const float y = __shfl_up(incl, o); if (lane >= o) incl += y; }
        const float excl = incl - run;
        float* op = F2 + (size_t)task * SEQ + lane * 32;
#pragma unroll
        for (int i = 0; i < 32; i += 4) *(GAS f32x4*)(op + i) = (f32x4){(acc[i] + excl) * LOG2E, (acc[i + 1] + excl) * LOG2E, (acc[i + 2] + excl) * LOG2E, (acc[i + 3] + excl) * LOG2E};
    }
    const f32x4 qg0 = *(const f32x4*)(q_gain + (lane & 7) * 8), qg1 = *(const f32x4*)(q_gain + (lane & 7) * 8 + 4);
    const f32x4 kg0 = *(const f32x4*)(k_gain + (lane & 7) * 8), kg1 = *(const f32x4*)(k_gain + (lane & 7) * 8 + 4);
    for (int m = gw; m < MROWS; m += NGW) {
#pragma unroll
        for (int part = 0; part < 2; ++part) {
            GAS u32x4* rp = (GAS u32x4*)(proj + (size_t)m * P3 + part * 2048) + lane;
            const f32x4 g0 = part ? kg0 : qg0, g1 = part ? kg1 : qg1; const float post = part ? 1.0f : 0.125f * LOG2E;
#pragma unroll
            for (int j = 0; j < 4; ++j) {
                const u32x4 w = rp[64 * j];
                float e[8] = {bflo(w.x), bfhi(w.x), bflo(w.y), bfhi(w.y), bflo(w.z), bfhi(w.z), bflo(w.w), bfhi(w.w)};
                float ss = 0.f;
#pragma unroll
                for (int i = 0; i < 8; ++i) ss += e[i] * e[i];
                ss += __shfl_xor(ss, 1); ss += __shfl_xor(ss, 2); ss += __shfl_xor(ss, 4);
                const float r = post / sqrtf(ss * (1.0f / 64.0f) + RMS_EPS);
                u32x4 o; o.x = pkbf(e[0] * r * g0.x, e[1] * r * g0.y); o.y = pkbf(e[2] * r * g0.z, e[3] * r * g0.w); o.z = pkbf(e[4] * r * g1.x, e[5] * r * g1.y); o.w = pkbf(e[6] * r * g1.z, e[7] * r * g1.w);
                rp[64 * j] = o;
            }
        }
    }
}
constexpr int FX_KS = 0, FX_VS = 9216, FX_FB = 9216 + 8192, FX_BUF = 9216 + 8192 + 256;
__device__ __forceinline__ void phase_fox_attn(Frame& F, const bf16* proj, const float* F2, bf16* og) {
    const int lane = F.lane, r32 = lane & 31, hi = lane >> 5, wave = F.wave, tid = F.tid;
    const int g16 = lane >> 4, q4 = (lane & 15) >> 2, p4 = lane & 3;
    LAS unsigned char* L = F.lds;
    const int srow = tid >> 3, sch = tid & 7;
    for (int bh = F.vcu; bh < BATCH * 32; bh += F.G) {
        const int b = bh >> 5, h = bh & 31;
        const size_t rowbase = (size_t)b * SEQ;
        const float* Fp = F2 + (size_t)bh * SEQ;
        const bf16* kbase = proj + rowbase * P3 + 2048 + h * 64 + sch * 8;
        for (int qb = 7; qb >= 0; --qb) {
            const int q0 = qb * 256, NT = 4 * (qb + 1);
            const size_t qrow = rowbase + q0 + wave * 32 + r32;
            bf16x8 qfr[4];
#pragma unroll
            for (int s4 = 0; s4 < 4; ++s4) qfr[s4] = *(const GAS bf16x8*)(proj + qrow * P3 + h * 64 + s4 * 16 + hi * 8);
            const float Fref = Fp[q0];
            const int qpos = q0 + wave * 32 + r32;
            float mrun = -1e30f, lsum = 0.f;
            f32x16 O[2];
#pragma unroll
            for (int r = 0; r < 16; ++r) { O[0][r] = 0.f; O[1][r] = 0.f; }
            __syncthreads();
            {
                const u32x4 kv = *(const GAS u32x4*)(kbase + (size_t)srow * P3), vv = *(const GAS u32x4*)(kbase + (size_t)srow * P3 + 2048);
                *(LAS u32x4*)(L + FX_KS + srow * 144 + sch * 16) = kv;
                *(LAS u32x4*)(L + FX_VS + (sch >> 2) * 4096 + srow * 64 + (sch & 3) * 16) = vv;
                if (tid < 64) *(LAS float*)(L + FX_FB + tid * 4) = Fref - Fp[tid];
            }
            __syncthreads();
            for (int t = 0; t < NT; ++t) {
                LAS unsigned char* cur = L + (t & 1) * FX_BUF; LAS unsigned char* nxt = L + ((t + 1) & 1) * FX_BUF;
                u32x4 kv = {0u, 0u, 0u, 0u}, vv = {0u, 0u, 0u, 0u}; float fb = 0.f;
                if (t + 1 < NT) { const size_t kr = (size_t)((t + 1) * 64 + srow) * P3; kv = *(const GAS u32x4*)(kbase + kr); vv = *(const GAS u32x4*)(kbase + kr + 2048); if (tid < 64) fb = Fref - Fp[(t + 1) * 64 + tid]; }
                const int k0 = t * 64;
                if (k0 <= q0 + wave * 32 + 31) {
                    f32x16 S[2];
#pragma unroll
                    for (int kb = 0; kb < 2; ++kb) {
                        f32x16 acc;
#pragma unroll
                        for (int r = 0; r < 16; ++r) acc[r] = 0.f;
                        const LAS unsigned char* kp = cur + FX_KS + (32 * kb + r32) * 144 + hi * 16;
#pragma unroll
                        for (int s4 = 0; s4 < 4; ++s4) acc = __builtin_amdgcn_mfma_f32_32x32x16_bf16(*(const LAS bf16x8*)(kp + s4 * 32), qfr[s4], acc, 0, 0, 0);
#pragma unroll
                        for (int g4 = 0; g4 < 4; ++g4) { const f32x4 fbv = *(const LAS f32x4*)(cur + FX_FB + (32 * kb + 8 * g4 + 4 * hi) * 4);
#pragma unroll
                            for (int e = 0; e < 4; ++e) { const int kpos = k0 + 32 * kb + 8 * g4 + 4 * hi + e; const float sv = acc[4 * g4 + e] + fbv[e]; acc[4 * g4 + e] = (kpos <= qpos) ? sv : -INFINITY; } }
                        S[kb] = acc;
                    }
                    float mx = mrun;
#pragma unroll
                    for (int r = 0; r < 16; ++r) mx = fmaxf(mx, fmaxf(S[0][r], S[1][r]));
                    mx = fmaxf(mx, __shfl_xor(mx, 32));
                    const float alpha = __builtin_amdgcn_exp2f(mrun - mx);
                    mrun = mx;
                    float ps = 0.f;
#pragma unroll
                    for (int r = 0; r < 16; ++r) { const float p0 = __builtin_amdgcn_exp2f(S[0][r] - mx), p1 = __builtin_amdgcn_exp2f(S[1][r] - mx); S[0][r] = p0; S[1][r] = p1; ps += p0 + p1; }
                    lsum = lsum * alpha + ps;
#pragma unroll
                    for (int r = 0; r < 16; ++r) { O[0][r] *= alpha; O[1][r] *= alpha; }
#pragma unroll
                    for (int kb = 0; kb < 2; ++kb)
#pragma unroll
                        for (int s2 = 0; s2 < 2; ++s2) {
                            const bf16x8 pf = pack8(S[kb][8 * s2 + 0], S[kb][8 * s2 + 1], S[kb][8 * s2 + 2], S[kb][8 * s2 + 3], S[kb][8 * s2 + 4], S[kb][8 * s2 + 5], S[kb][8 * s2 + 6], S[kb][8 * s2 + 7]);
#pragma unroll
                            for (int db = 0; db < 2; ++db) {
                                const LAS unsigned char* va = cur + FX_VS + db * 4096 + (32 * kb + 16 * s2 + 4 * (g16 >> 1) + q4) * 64 + (g16 & 1) * 32 + p4 * 8;
                                const v4i16_t lo = ldtr(va), hh = ldtr(va + 512);
                                O[db] = __builtin_amdgcn_mfma_f32_32x32x16_bf16(mk8(lo, hh), pf, O[db], 0, 0, 0);
                            }
                        }
                }
                if (t + 1 < NT) {
                    *(LAS u32x4*)(nxt + FX_KS + srow * 144 + sch * 16) = kv;
                    *(LAS u32x4*)(nxt + FX_VS + (sch >> 2) * 4096 + srow * 64 + (sch & 3) * 16) = vv;
                    if (tid < 64) *(LAS float*)(nxt + FX_FB + tid * 4) = fb;
                }
                __syncthreads();
            }
            lsum += __shfl_xor(lsum, 32);
            const float rl = 1.0f / lsum;
#pragma unroll
            for (int db = 0; db < 2; ++db)
#pragma unroll
                for (int g4 = 0; g4 < 4; ++g4) { const int d0 = db * 32 + 8 * g4 + 4 * hi;
                    const u32x2 gv = *(const GAS u32x2*)(proj + qrow * P3 + 6144 + h * 64 + d0);
                    const float o0 = O[db][4 * g4 + 0] * rl * siluf(bflo(gv.x)), o1 = O[db][4 * g4 + 1] * rl * siluf(bfhi(gv.x));
                    const float o2 = O[db][4 * g4 + 2] * rl * siluf(bflo(gv.y)), o3 = O[db][4 * g4 + 3] * rl * siluf(bfhi(gv.y));
                    u32x2 w; w.x = pkbf(o0, o1); w.y = pkbf(o2, o3);
                    *(GAS u32x2*)(og + qrow * 2048 + h * 64 + d0) = w; }
        }
    }
}

#ifndef MK_SINGLE
#define MK_SINGLE 0
#endif
#ifndef MK_LAYERS
#define MK_LAYERS 4
#endif
#ifndef MK_AMP
#define MK_AMP 1.0f
#endif
enum { I_X = 0, I_REL, I_SWA_NORM, I_SWA_WIN, I_SWA_QG, I_SWA_KG, I_SWA_SINK, I_SWA_WOUT,
       I_RW_NORM, I_RW_MIX, I_RW_WIN, I_RW_W0, I_RW_WL1, I_RW_WL2, I_RW_A0, I_RW_AL1, I_RW_AL2, I_RW_KK, I_RW_KA, I_RW_RK, I_RW_GNW, I_RW_GNB, I_RW_WOUT,
       I_ML_NORM, I_ML_WIN, I_ML_BI, I_ML_BF, I_ML_HG, I_ML_WOUT,
       I_FX_NORM, I_FX_WIN, I_FX_BF, I_FX_QG, I_FX_KG, I_FX_WOUT, N_IN };
struct Args { const float* in[N_IN]; float* out; unsigned char* ws; int ph_lo, ph_hi; };
constexpr int NPH_L0 = 4;
constexpr int NPH_L1 = 11;
constexpr int NPH_L2 = 5;
constexpr int NPH_L3 = 5;
constexpr int NPH = (MK_LAYERS >= 1 ? NPH_L0 : 0) + (MK_LAYERS >= 2 ? NPH_L1 : 0) + (MK_LAYERS >= 3 ? NPH_L2 : 0) + (MK_LAYERS >= 4 ? NPH_L3 : 0);

__global__ void __launch_bounds__(NWAVES * 64, 2) fwd(Args args) {
    extern __shared__ __attribute__((aligned(16))) unsigned char lds_raw[];
    Frame F;
    F.lds = (LAS unsigned char*)lds_raw;
    F.tid = threadIdx.x; F.lane = F.tid & 63; F.wave = __builtin_amdgcn_readfirstlane(F.tid >> 6);
    F.G = gridDim.x; { const int bx = blockIdx.x; F.vcu = (F.G % 8 == 0) ? (bx % 8) * (F.G / 8) + bx / 8 : bx; }
    unsigned char* ws = args.ws;
    gu32* ctl = (gu32*)(ws + WS_CTL);
    if (F.tid < 16) ((LAS unsigned*)(F.lds + MISC_OFF))[F.tid] = 0u;
    __syncthreads();
    const int lo = args.ph_lo, hi = args.ph_hi;
    XcdBarrier bar; bar.bar = (unsigned*)(ctl + CW_BAR); bar.x = 0; bar.st = nullptr;
    if (hi - lo > 1) bar = xcd_barrier_post((unsigned*)(ctl + CW_BAR), (volatile LAS unsigned*)(F.lds + MISC_OFF + 32));
#define IN(k) (lo <= (k) && (k) < hi)
#define SEAM(k) do { if (IN(k) && IN((k) + 1)) xcd_barrier(bar, F.wave); F.lane = fresh_lane(); F.tid = F.wave * 64 + F.lane; } while (0)
    bf16* const WB = (bf16*)(ws + WS_W);
    bf16* const S0 = (bf16*)(ws + WS_SLOT(0)); bf16* const S1 = (bf16*)(ws + WS_SLOT(1)); bf16* const S2 = (bf16*)(ws + WS_SLOT(2)); bf16* const S3 = (bf16*)(ws + WS_SLOT(3));
    bf16* const S4 = (bf16*)(ws + WS_SLOT(4)); bf16* const S5 = (bf16*)(ws + WS_SLOT(5)); bf16* const S6 = (bf16*)(ws + WS_SLOT(6));
    bf16* const L1B = (bf16*)(ws + WS_L1); float* const GX = (float*)(ws + WS_GX); float* const FB = (float*)(ws + WS_F);
    const float* const x_in = args.in[I_X]; float* const xo = args.out;
    int ph = 0;

    if (IN(ph)) {
        convert_matrix(F, args.in[I_SWA_WIN], 4608, 0, 2048, 4608, WB + W0_IN, 0);
        convert_matrix(F, args.in[I_SWA_WOUT], 2048, 0, 2048, 2048, WB + W0_OUT, 0);
        phase_norm(F, x_in, args.in[I_SWA_NORM], S0);
    } SEAM(ph); ++ph;
    if (IN(ph)) {
        pg8::Gemm g{S0, WB + W0_IN, MROWS, 4608, 2048}; pg8::StaticOrder S; S.init(MROWS, 4608, F.G, (int)blockIdx.x);
        pg8::EpiStore E{S1, P0, 18, nullptr};
        pg8::gemm_phase<pg8::EpiStore, pg8::StaticOrder, true, true>(F.lds, g, S, E, F.wave);
    } SEAM(ph); ++ph;
    if (IN(ph)) { phase_swa(F, S1, args.in[I_SWA_QG], args.in[I_SWA_KG], args.in[I_SWA_SINK], args.in[I_REL], S0); } SEAM(ph); ++ph;
    if (IN(ph)) {
        pg8::Gemm g{S0, WB + W0_OUT, MROWS, 2048, 2048}; pg8::StaticOrder S; S.init(MROWS, 2048, F.G, (int)blockIdx.x);
        pg8::EpiResid E{x_in, xo, 2048, MK_AMP};
        pg8::gemm_phase<pg8::EpiResid, pg8::StaticOrder, true, true>(F.lds, g, S, E, F.wave);
    } SEAM(ph); ++ph;

#if MK_LAYERS >= 2
    {
    const float* mix = args.in[I_RW_MIX];
    if (IN(ph)) {
        for (int c = 0; c < 4; ++c) convert_matrix(F, args.in[I_RW_WIN] + (size_t)c * 2048 * 2048, 2048, 0, 2048, 2048, WB + W1_IN + (size_t)c * 2048 * 2048, 0);
        convert_matrix(F, args.in[I_RW_WL1], 96, 0, 2048, 96, WB + W1_LA, 0);   zero_rows(F, WB + W1_LA, 2048, 96, 256);
        convert_matrix(F, args.in[I_RW_AL1], 96, 0, 2048, 96, WB + W1_LB, 128); zero_rows(F, WB + W1_LB, 2048, 0, 128); zero_rows(F, WB + W1_LB, 2048, 224, 256);
        convert_lora2(F, args.in[I_RW_WL2], args.in[I_RW_AL2], WB + W1_L2);
        convert_matrix(F, args.in[I_RW_WOUT], 2048, 0, 2048, 2048, WB + W1_OUT, 0);
        phase_mix_from_x(F, xo, args.in[I_RW_NORM], mix + 4 * 2048, mix + 5 * 2048, S4, S1, S2);
    } SEAM(ph); ++ph;
    if (IN(ph)) {
        { pg8::Gemm g{S1, WB + W1_LA, MROWS, 256, 2048}; pg8::StaticOrder S; S.init(MROWS, 256, F.G, (int)blockIdx.x); pg8::EpiLora1<0> E{L1B};
          pg8::gemm_phase<pg8::EpiLora1<0>, pg8::StaticOrder, true, true>(F.lds, g, S, E, F.wave); }
        { pg8::Gemm g{S2, WB + W1_LB, MROWS, 256, 2048}; pg8::StaticOrder S; S.init(MROWS, 256, F.G, (int)blockIdx.x); pg8::EpiLora1<1> E{L1B};
          pg8::gemm_phase<pg8::EpiLora1<1>, pg8::StaticOrder, true, true>(F.lds, g, S, E, F.wave); }
    } SEAM(ph); ++ph;
    if (IN(ph)) {
        pg8::Gemm g{L1B, WB + W1_L2, MROWS, 4096, 256}; pg8::StaticOrder S; S.init(MROWS, 4096, F.G, (int)blockIdx.x);
        pg8::EpiLora2 E{S5, S6, args.in[I_RW_W0], args.in[I_RW_A0]};
        pg8::gemm_phase<pg8::EpiLora2, pg8::StaticOrder, true, true>(F.lds, g, S, E, F.wave);
    } SEAM(ph); ++ph;
    if (IN(ph)) { phase_mix_from_h(F, S4, mix + 0 * 2048, S0, mix + 1 * 2048, S3); } SEAM(ph); ++ph;
    if (IN(ph)) {
        { pg8::Gemm g{S0, WB + W1_IN, MROWS, 2048, 2048}; pg8::StaticOrder S; S.init(MROWS, 2048, F.G, (int)blockIdx.x); pg8::EpiStore E{S1, 2048, 8, nullptr};
          pg8::gemm_phase<pg8::EpiStore, pg8::StaticOrder, true, true>(F.lds, g, S, E, F.wave); }
        { pg8::Gemm g{S3, WB + W1_IN + (size_t)2048 * 2048, MROWS, 2048, 2048}; pg8::StaticOrder S; S.init(MROWS, 2048, F.G, (int)blockIdx.x); pg8::EpiStore E{S2, 2048, 8, nullptr};
          pg8::gemm_phase<pg8::EpiStore, pg8::StaticOrder, true, true>(F.lds, g, S, E, F.wave); }
    } SEAM(ph); ++ph;
    if (IN(ph)) { phase_mix_from_h(F, S4, mix + 2 * 2048, S0, nullptr, nullptr); } SEAM(ph); ++ph;
    if (IN(ph)) {
        pg8::Gemm g{S0, WB + W1_IN + (size_t)2 * 2048 * 2048, MROWS, 2048, 2048}; pg8::StaticOrder S; S.init(MROWS, 2048, F.G, (int)blockIdx.x); pg8::EpiStore E{S3, 2048, 8, nullptr};
        pg8::gemm_phase<pg8::EpiStore, pg8::StaticOrder, true, true>(F.lds, g, S, E, F.wave);
    } SEAM(ph); ++ph;
    if (IN(ph)) { phase_mix_from_h(F, S4, mix + 3 * 2048, S0, nullptr, nullptr); } SEAM(ph); ++ph;
    if (IN(ph)) {
        pg8::Gemm g{S0, WB + W1_IN + (size_t)3 * 2048 * 2048, MROWS, 2048, 2048}; pg8::StaticOrder S; S.init(MROWS, 2048, F.G, (int)blockIdx.x); pg8::EpiStore E{S4, 2048, 8, nullptr};
        pg8::gemm_phase<pg8::EpiStore, pg8::StaticOrder, true, true>(F.lds, g, S, E, F.wave);
    } SEAM(ph); ++ph;
    if (IN(ph)) { phase_rwkv(F, S1, S2, S3, S4, S5, S6, args.in[I_RW_KK], args.in[I_RW_KA], args.in[I_RW_RK], args.in[I_RW_GNW], args.in[I_RW_GNB], S0); } SEAM(ph); ++ph;
    if (IN(ph)) {
        pg8::Gemm g{S0, WB + W1_OUT, MROWS, 2048, 2048}; pg8::StaticOrder S; S.init(MROWS, 2048, F.G, (int)blockIdx.x);
        pg8::EpiResid E{xo, xo, 2048, 1.0f};
        pg8::gemm_phase<pg8::EpiResid, pg8::StaticOrder, true, true>(F.lds, g, S, E, F.wave);
    } SEAM(ph); ++ph;
    }
#endif

#if MK_LAYERS >= 3
    if (IN(ph)) {
        convert_matrix(F, args.in[I_ML_WIN], 8208, 0, 2048, 8192, WB + W2_IN, 0);
        convert_cols_small(F, args.in[I_ML_WIN], 8208, 8192, 2048, 16, WB + W2_IN, 8192); zero_rows(F, WB + W2_IN, 2048, 8208, 8448);
        convert_matrix(F, args.in[I_ML_WOUT], 2048, 0, 2048, 2048, WB + W2_OUT, 0);
        phase_norm(F, xo, args.in[I_ML_NORM], S0);
    } SEAM(ph); ++ph;
    if (IN(ph)) {
        pg8::Gemm g{S0, WB + W2_IN, MROWS, 8448, 2048}; pg8::StaticOrder S; S.init(MROWS, 8448, F.G, (int)blockIdx.x);
        pg8::EpiStore E{S1, P2, 32, GX};
        pg8::gemm_phase<pg8::EpiStore, pg8::StaticOrder, true, true>(F.lds, g, S, E, F.wave);
    } SEAM(ph); ++ph;
    if (IN(ph)) { phase_mlstm(F, S1, GX, args.in[I_ML_BI], args.in[I_ML_BF], (float*)S5); } SEAM(ph); ++ph;
    if (IN(ph)) { phase_mlstm_post(F, (const float*)S5, S1, args.in[I_ML_HG], S0); } SEAM(ph); ++ph;
    if (IN(ph)) {
        pg8::Gemm g{S0, WB + W2_OUT, MROWS, 2048, 2048}; pg8::StaticOrder S; S.init(MROWS, 2048, F.G, (int)blockIdx.x);
        pg8::EpiResid E{xo, xo, 2048, 1.0f};
        pg8::gemm_phase<pg8::EpiResid, pg8::StaticOrder, true, true>(F.lds, g, S, E, F.wave);
    } SEAM(ph); ++ph;
#endif

#if MK_LAYERS >= 4
    if (IN(ph)) {
        convert_matrix(F, args.in[I_FX_WIN], 8224, 0, 2048, 8192, WB + W2_IN, 0);
        convert_cols_small(F, args.in[I_FX_WIN], 8224, 8192, 2048, 32, WB + W2_IN, 8192); zero_rows(F, WB + W2_IN, 2048, 8224, 8448);
        convert_matrix(F, args.in[I_FX_WOUT], 2048, 0, 2048, 2048, WB + W2_OUT, 0);
        phase_norm(F, xo, args.in[I_FX_NORM], S0);
    } SEAM(ph); ++ph;
    if (IN(ph)) {
        pg8::Gemm g{S0, WB + W2_IN, MROWS, 8448, 2048}; pg8::StaticOrder S; S.init(MROWS, 8448, F.G, (int)blockIdx.x);
        pg8::EpiStore E{S1, P3, 32, GX};
        pg8::gemm_phase<pg8::EpiStore, pg8::StaticOrder, true, true>(F.lds, g, S, E, F.wave);
    } SEAM(ph); ++ph;
    if (IN(ph)) { phase_fox_prep(F, S1, GX, args.in[I_FX_BF], args.in[I_FX_QG], args.in[I_FX_KG], FB); } SEAM(ph); ++ph;
    if (IN(ph)) { phase_fox_attn(F, S1, FB, S0); } SEAM(ph); ++ph;
    if (IN(ph)) {
        pg8::Gemm g{S0, WB + W2_OUT, MROWS, 2048, 2048}; pg8::StaticOrder S; S.init(MROWS, 2048, F.G, (int)blockIdx.x);
        pg8::EpiResid E{xo, xo, 2048, 1.0f};
        pg8::gemm_phase<pg8::EpiResid, pg8::StaticOrder, true, true>(F.lds, g, S, E, F.wave);
    } SEAM(ph); ++ph;
#endif
#undef IN
#undef SEAM
}

extern "C" void kernel_launch(void* const* d_in, const int* in_sizes, int n_in, void* d_out, int out_size, void* d_ws, size_t ws_size, hipStream_t stream) {
    static int grid = 0;
    if (grid == 0) {
        if (n_in != N_IN || out_size != MROWS * DM || ws_size < WS_END) { fprintf(stderr, "kernel_launch: unexpected shapes (n_in %d out %d ws %zu)\n", n_in, out_size, ws_size); grid = -1; return; }
        int dev = 0, cus = 0, per_cu = 0;
        if (hipGetDevice(&dev) != hipSuccess || hipDeviceGetAttribute(&cus, hipDeviceAttributeMultiprocessorCount, dev) != hipSuccess) { grid = -1; return; }
        if (hipFuncSetAttribute((const void*)fwd, hipFuncAttributeMaxDynamicSharedMemorySize, LDS_BYTES) != hipSuccess) { grid = -1; return; }
        if (hipOccupancyMaxActiveBlocksPerMultiprocessor(&per_cu, (const void*)fwd, NWAVES * 64, LDS_BYTES) != hipSuccess || per_cu < 1) per_cu = 1;
        (void)hipGetLastError();
        grid = cus;
    }
    if (grid < 0) return;
    (void)hipMemsetAsync((char*)d_ws + WS_CTL, 0, CTL_ZERO_BYTES, stream);
    Args a{};
    for (int i = 0; i < N_IN; ++i) a.in[i] = (const float*)d_in[i];
    a.out = (float*)d_out; a.ws = (unsigned char*)d_ws;
#if MK_SINGLE
    a.ph_lo = 0; a.ph_hi = NPH;
    hipLaunchKernelGGL(fwd, dim3(grid), dim3(NWAVES * 64), LDS_BYTES, stream, a);
#else
    for (int p = 0; p < NPH; ++p) { a.ph_lo = p; a.ph_hi = p + 1; hipLaunchKernelGGL(fwd, dim3(grid), dim3(NWAVES * 64), LDS_BYTES, stream, a); }
#endif
}
```

```cpp
#include <hip/hip_runtime.h>
#include <cstdio>
#include <cstdint>
__device__ __forceinline__ int fresh_lane() { int l; asm volatile("v_mbcnt_lo_u32_b32 %0, -1, 0\n\tv_mbcnt_hi_u32_b32 %0, -1, %0" : "=v"(l)); return l; }
namespace pg8 {
#define PG8_LAS __attribute__((address_space(3)))
typedef unsigned short bf16_t;
typedef short bf16x8 __attribute__((ext_vector_type(8)));
typedef float f32x4 __attribute__((ext_vector_type(4)));
typedef unsigned u32x4 __attribute__((ext_vector_type(4)));
constexpr int BM = 256, BK = 64, HALF = 128, HTB = HALF * BK * 2  , STAGE_BYTES = 8 * HTB, NXCD = 8, WGM = 8;

__host__ __device__ __forceinline__ int lds_byte(int r, int c) { const int st = (r >> 4) * 2 + (c >> 5), rr = r & 15, cc = c & 31, ob = rr * 64 + cc * 2; return st * 1024 + (ob ^ (((ob >> 9) & 1) << 5)); }
__host__ __device__ __forceinline__ void stage_rc(int b, int& R, int& C) { const int st = b / 1024, sb = b % 1024, swz = sb ^ (((sb >> 9) & 1) << 5); R = (st >> 1) * 16 + swz / 64; C = (st & 1) * 32 + (swz % 64) / 2; }
__host__ __device__ __forceinline__ int perm32(int rho) { const int n = rho >> 4, i = rho & 15; return 8 * (i >> 2) + 4 * n + (i & 3); }

struct Unit { int pm, pn; };
struct Gemm { const bf16_t* A; const bf16_t* Bt; int M, N, K; };

struct StaticOrder {
    int nM, nN, nwg, G, c;
    __host__ __device__ void init(int M, int N, int G_, int c_) { nM = M / BM; nN = N / BM; nwg = nM * nN; G = G_; c = c_; }
    __host__ __device__ bool next(int i, Unit& u) const {
        const long L = (long)i * G + c; if (L >= nwg) return false;
        int wgid = (int)L; { const int q = nwg / NXCD, r = nwg % NXCD, xcd = wgid % NXCD, off = wgid / NXCD; wgid = (xcd < r ? xcd * (q + 1) : r * (q + 1) + (xcd - r) * q) + off; }
        const int nig = WGM * nN, gid = wgid / nig, fm = gid * WGM, gsz = (nM - fm) < WGM ? (nM - fm) : WGM;
        u.pm = fm + ((wgid % nig) % gsz); u.pn = (wgid % nig) / gsz; return true;
    }
    __device__ __forceinline__ void a_ready(const Unit&) const {}
    __device__ __forceinline__ void done(const Unit&) const {}
};
__device__ __forceinline__ unsigned cvt_pk_bf16(float lo, float hi) { unsigned r; asm volatile("v_cvt_pk_bf16_f32 %0, %1, %2" : "=v"(r) : "v"(lo), "v"(hi)); return r; }
typedef float f32x2 __attribute__((ext_vector_type(2)));
struct EpiStore {
    static constexpr bool PERM = true, AFTER_DRAIN = false;
    bf16_t* O; int ldc; int n_main; float* X; const float* RS = nullptr;
    __device__ __forceinline__ void operator()(const f32x4 (&acc)[2][2][4][2], const Unit& u, int wr, int wc, int fr, int fq) const {
        const int row0 = u.pm * BM + wr * 64 + fr;
        if (u.pn < n_main) {
            const int col0 = u.pn * BM + wc * 32 + 8 * fq;
#pragma unroll
            for (int ai = 0; ai < 2; ++ai)
#pragma unroll
                for (int m = 0; m < 4; ++m) { bf16_t* rowp = O + (size_t)(row0 + ai * HALF + m * 16) * ldc + col0; const float rs = RS ? RS[row0 + ai * HALF + m * 16] : 1.0f;
#pragma unroll
                    for (int bj = 0; bj < 2; ++bj) { const f32x4 v0 = acc[ai][bj][m][0] * rs, v1 = acc[ai][bj][m][1] * rs;
                        u32x4 w; w.x = cvt_pk_bf16(v0[0], v0[1]); w.y = cvt_pk_bf16(v0[2], v0[3]); w.z = cvt_pk_bf16(v1[0], v1[1]); w.w = cvt_pk_bf16(v1[2], v1[3]);
                        *(u32x4*)(rowp + bj * HALF) = w; } }
        } else if (wc == 0) {
#pragma unroll
            for (int ai = 0; ai < 2; ++ai)
#pragma unroll
                for (int m = 0; m < 4; ++m) { float* rp = X + (size_t)(row0 + ai * HALF + m * 16) * 32 + 8 * fq; const float rs = RS ? RS[row0 + ai * HALF + m * 16] : 1.0f;
                    *(f32x4*)rp = acc[ai][0][m][0] * rs; *(f32x4*)(rp + 4) = acc[ai][0][m][1] * rs; }
        }
    }
};
template <int SEL> struct EpiLora1 {
    static constexpr bool PERM = true, AFTER_DRAIN = false;
    bf16_t* O;
    __device__ __forceinline__ void operator()(const f32x4 (&acc)[2][2][4][2], const Unit& u, int wr, int wc, int fr, int fq) const {
        const int row0 = u.pm * BM + wr * 64 + fr, col0 = SEL * HALF + wc * 32 + 8 * fq;
#pragma unroll
        for (int ai = 0; ai < 2; ++ai)
#pragma unroll
            for (int m = 0; m < 4; ++m) { bf16_t* rowp = O + (size_t)(row0 + ai * HALF + m * 16) * 256 + col0;
                f32x4 v0 = acc[ai][SEL][m][0], v1 = acc[ai][SEL][m][1];
                if (SEL == 0) {
#pragma unroll
                    for (int j = 0; j < 4; ++j) { v0[j] = tanhf(v0[j]); v1[j] = tanhf(v1[j]); } }
                u32x4 w; w.x = cvt_pk_bf16(v0[0], v0[1]); w.y = cvt_pk_bf16(v0[2], v0[3]); w.z = cvt_pk_bf16(v1[0], v1[1]); w.w = cvt_pk_bf16(v1[2], v1[3]);
                *(u32x4*)rowp = w; }
    }
};
struct EpiLora2 {
    static constexpr bool PERM = true, AFTER_DRAIN = false;
    bf16_t* LW; bf16_t* AA; const float* w0; const float* a0;
    __device__ __forceinline__ void operator()(const f32x4 (&acc)[2][2][4][2], const Unit& u, int wr, int wc, int fr, int fq) const {
        const int row0 = u.pm * BM + wr * 64 + fr;
        const bool isw = u.pn < 8;
        const int col0 = (isw ? u.pn : u.pn - 8) * BM + wc * 32 + 8 * fq;
        const float* bsrc = isw ? w0 : a0; bf16_t* dst = isw ? LW : AA;
        const f32x4 bv00 = *(const f32x4*)(bsrc + col0), bv01 = *(const f32x4*)(bsrc + col0 + 4), bv10 = *(const f32x4*)(bsrc + col0 + HALF), bv11 = *(const f32x4*)(bsrc + col0 + HALF + 4);
#pragma unroll
        for (int ai = 0; ai < 2; ++ai)
#pragma unroll
            for (int m = 0; m < 4; ++m) { bf16_t* rowp = dst + (size_t)(row0 + ai * HALF + m * 16) * 2048 + col0;
#pragma unroll
                for (int bj = 0; bj < 2; ++bj) { f32x4 v0 = acc[ai][bj][m][0] + (bj ? bv10 : bv00), v1 = acc[ai][bj][m][1] + (bj ? bv11 : bv01);
                    if (isw) {
#pragma unroll
                        for (int j = 0; j < 4; ++j) {
                            v0[j] = -0.875038775f * __builtin_amdgcn_rcpf(1.0f + __expf(-v0[j])); v1[j] = -0.875038775f * __builtin_amdgcn_rcpf(1.0f + __expf(-v1[j])); }
                    } else {
#pragma unroll
                        for (int j = 0; j < 4; ++j) { v0[j] = __builtin_amdgcn_rcpf(1.0f + __expf(-v0[j])); v1[j] = __builtin_amdgcn_rcpf(1.0f + __expf(-v1[j])); }
                    }
                    u32x4 w; w.x = cvt_pk_bf16(v0[0], v0[1]); w.y = cvt_pk_bf16(v0[2], v0[3]); w.z = cvt_pk_bf16(v1[0], v1[1]); w.w = cvt_pk_bf16(v1[2], v1[3]);
                    *(u32x4*)(rowp + bj * HALF) = w; } }
    }
};
struct EpiResid {
    static constexpr bool PERM = false, AFTER_DRAIN = false;
    const float* R; float* O; int ldc; float amp;
    __device__ __forceinline__ void operator()(const f32x4 (&acc)[2][2][4][2], const Unit& u, int wr, int wc, int fr, int fq) const {
        const int row0 = u.pm * BM + wr * 64 + fr, col0 = u.pn * BM + wc * 32 + 4 * fq;
        const float* __restrict__ Rr = R; float* __restrict__ Oo = O;
        f32x4 rv[2][4];
#define ER_LOAD(g, buf) do { const size_t off_ = (size_t)(row0 + ((g) >> 2) * HALF + ((g) & 3) * 16) * ldc + col0; \
            _Pragma("unroll") for (int bj = 0; bj < 2; ++bj) _Pragma("unroll") for (int n = 0; n < 2; ++n) rv[buf][bj * 2 + n] = *(const f32x4*)(Rr + off_ + bj * HALF + n * 16); } while (0)
        ER_LOAD(0, 0);
#pragma unroll
        for (int g = 0; g < 8; ++g) {
            if (g + 1 < 8) ER_LOAD(g + 1, (g + 1) & 1);
            const int ai = g >> 2, m = g & 3; const size_t off = (size_t)(row0 + ai * HALF + m * 16) * ldc + col0;
#pragma unroll
            for (int bj = 0; bj < 2; ++bj)
#pragma unroll
                for (int n = 0; n < 2; ++n) *(f32x4*)(Oo + off + bj * HALF + n * 16) = rv[g & 1][bj * 2 + n] + amp * acc[ai][bj][m][n];
        }
#undef ER_LOAD
    }
};
template <bool RBF, bool OBF> struct EpiResidX {
    static constexpr bool PERM = true, AFTER_DRAIN = false;
    const void* R; void* O; int ldc;
    __device__ __forceinline__ void operator()(const f32x4 (&acc)[2][2][4][2], const Unit& u, int wr, int wc, int fr, int fq) const {
        const int row0 = u.pm * BM + wr * 64 + fr, col0 = u.pn * BM + wc * 32 + 8 * fq;
        f32x4 rv[2][2][2];
#define ERX_LOAD(g, buf) do { const size_t off_ = (size_t)(row0 + ((g) >> 2) * HALF + ((g) & 3) * 16) * ldc + col0; \
            _Pragma("unroll") for (int bj = 0; bj < 2; ++bj) { \
                if constexpr (RBF) { const u32x4 w_ = *(const u32x4*)((const bf16_t*)R + off_ + bj * HALF); \
                    rv[buf][bj][0] = (f32x4){__builtin_bit_cast(float, w_.x << 16), __builtin_bit_cast(float, w_.x & 0xffff0000u), __builtin_bit_cast(float, w_.y << 16), __builtin_bit_cast(float, w_.y & 0xffff0000u)}; \
                    rv[buf][bj][1] = (f32x4){__builtin_bit_cast(float, w_.z << 16), __builtin_bit_cast(float, w_.z & 0xffff0000u), __builtin_bit_cast(float, w_.w << 16), __builtin_bit_cast(float, w_.w & 0xffff0000u)}; } \
                else { rv[buf][bj][0] = *(const f32x4*)((const float*)R + off_ + bj * HALF); rv[buf][bj][1] = *(const f32x4*)((const float*)R + off_ + bj * HALF + 4); } } } while (0)
        ERX_LOAD(0, 0);
#pragma unroll
        for (int g = 0; g < 8; ++g) {
            if (g + 1 < 8) ERX_LOAD(g + 1, (g + 1) & 1);
            const int ai = g >> 2, m = g & 3; const size_t off = (size_t)(row0 + ai * HALF + m * 16) * ldc + col0;
#pragma unroll
            for (int bj = 0; bj < 2; ++bj) { const f32x4 v0 = rv[g & 1][bj][0] + acc[ai][bj][m][0], v1 = rv[g & 1][bj][1] + acc[ai][bj][m][1];
                if constexpr (OBF) { u32x4 w; w.x = cvt_pk_bf16(v0[0], v0[1]); w.y = cvt_pk_bf16(v0[2], v0[3]); w.z = cvt_pk_bf16(v1[0], v1[1]); w.w = cvt_pk_bf16(v1[2], v1[3]);
                    *(u32x4*)((bf16_t*)O + off + bj * HALF) = w; }
                else { *(f32x4*)((float*)O + off + bj * HALF) = v0; *(f32x4*)((float*)O + off + bj * HALF + 4) = v1; } }
        }
#undef ERX_LOAD
    }
};
template <class Epi, class Sched, bool ALIGN_EPI = false, bool SP2 = false>
__device__ __forceinline__ void gemm_phase(PG8_LAS unsigned char* lds, const Gemm g, const Sched& S, const Epi& E, const int wid) {
    const int lane = fresh_lane(), tid = wid * 64 + lane, wr = wid >> 2, wc = wid & 3, fr = lane & 15, fq = lane >> 4;
    const int K = g.K, nt = K / BK;
    unsigned voffA[2], voffB[2];
#pragma unroll
    for (int i = 0; i < 2; ++i) { int R, C; stage_rc(tid * 16 + i * 8192, R, C); const int Rb = Epi::PERM ? ((R & ~31) + perm32(R & 31)) : R;
        voffA[i] = (unsigned)(R * K + C) * 2u; voffB[i] = (unsigned)(Rb * K + C) * 2u; }
    const size_t kstep = (size_t)(BK * 2);
    const size_t hstep = (size_t)HALF * K * 2;
    const size_t tstep = 2 * hstep;
    const unsigned ldsw = (unsigned)wid * 1024u;
    const int aoff = lds_byte(wr * 64 + fr, fq * 8), boff = lds_byte(wc * 32 + fr, fq * 8);
#define PG8_SA(b, h) (((b) * 2 + (h)) * HTB)
#define PG8_SB(b, h) ((4 + (b) * 2 + (h)) * HTB)
#define PG8_STAGE(bufoff, gbase, voff) do { _Pragma("unroll") for (int _i = 0; _i < 2; ++_i) \
        __builtin_amdgcn_global_load_lds((const unsigned*)((const char*)(gbase) + (voff)[_i]), (PG8_LAS unsigned*)(lds + (bufoff) + ldsw + _i * 8192), 16, 0, 0); } while (0)
#define PG8_LDA(dst, b, h) do { _Pragma("unroll") for (int m = 0; m < 4; ++m) _Pragma("unroll") for (int k = 0; k < 2; ++k) dst[m][k] = *(const PG8_LAS bf16x8*)(lds + PG8_SA(b, h) + aoff + m * 2048 + k * 1024); } while (0)
#define PG8_LDB(dst, b, h) do { _Pragma("unroll") for (int n = 0; n < 2; ++n) _Pragma("unroll") for (int k = 0; k < 2; ++k) dst[n][k] = *(const PG8_LAS bf16x8*)(lds + PG8_SB(b, h) + boff + n * 2048 + k * 1024); } while (0)
#define PG8_MMA(ai, bj, At, Bt) do { __builtin_amdgcn_s_setprio(1); _Pragma("unroll") for (int m = 0; m < 4; ++m) _Pragma("unroll") for (int n = 0; n < 2; ++n) _Pragma("unroll") for (int k = 0; k < 2; ++k) \
        acc[ai][bj][m][n] = __builtin_amdgcn_mfma_f32_16x16x32_bf16(Bt[n][k], At[m][k], acc[ai][bj][m][n], 0, 0, 0); __builtin_amdgcn_s_setprio(0); } while (0)
#define PG8_WAIT_V(n) asm volatile("s_waitcnt vmcnt(" #n ")" ::: "memory")
#define PG8_WAIT_L(n) asm volatile("s_waitcnt lgkmcnt(" #n ")" ::: "memory")
#define PG8_BAR __builtin_amdgcn_s_barrier()
#define PG8_SCHED __builtin_amdgcn_sched_barrier(0)
    Unit cur, nxt; int ui = 0;
    if (!S.next(0, cur)) return;
    f32x4 acc[2][2][4][2];
#pragma unroll
    for (int a = 0; a < 2; ++a)
#pragma unroll
        for (int b = 0; b < 2; ++b)
#pragma unroll
            for (int m = 0; m < 4; ++m)
#pragma unroll
                for (int n = 0; n < 2; ++n) acc[a][b][m][n] = (f32x4){0.f, 0.f, 0.f, 0.f};
    bf16x8 At[4][2], B0[2][2], B1[2][2];
    const char* cA = (const char*)g.A + (size_t)cur.pm * tstep; const char* cB = (const char*)g.Bt + (size_t)cur.pn * tstep;
    S.a_ready(cur);
    if constexpr (SP2) {
        PG8_STAGE(PG8_SB(0, 0), cB, voffB); PG8_STAGE(PG8_SB(0, 1), cB + hstep, voffB); PG8_STAGE(PG8_SA(0, 0), cA, voffA); PG8_STAGE(PG8_SA(0, 1), cA + hstep, voffA);
        if (wr == 1) PG8_BAR;
        PG8_WAIT_V(2); PG8_BAR;
        PG8_STAGE(PG8_SB(1, 0), cB + kstep, voffB); PG8_STAGE(PG8_SA(1, 0), cA + kstep, voffA); PG8_STAGE(PG8_SB(1, 1), cB + hstep + kstep, voffB);
        PG8_WAIT_V(6); PG8_BAR;
    } else {
        PG8_STAGE(PG8_SB(0, 0), cB, voffB); PG8_STAGE(PG8_SA(0, 0), cA, voffA); PG8_STAGE(PG8_SB(0, 1), cB + hstep, voffB); PG8_STAGE(PG8_SA(0, 1), cA + hstep, voffA);
        if (wr == 1) PG8_BAR;
        PG8_WAIT_V(4); PG8_BAR;
        PG8_STAGE(PG8_SB(1, 0), cB + kstep, voffB); PG8_STAGE(PG8_SA(1, 0), cA + kstep, voffA); PG8_STAGE(PG8_SB(1, 1), cB + hstep + kstep, voffB);
        PG8_WAIT_V(6); PG8_BAR;
    }
    for (;;) {
        const bool has_next = S.next(ui + 1, nxt);
        const char* nA = has_next ? (const char*)g.A + (size_t)nxt.pm * tstep : cA; const char* nB = has_next ? (const char*)g.Bt + (size_t)nxt.pn * tstep : cB;
        for (int t = 0; t < nt; t += 2) {
            const bool last = (t == nt - 2);
            const char* a1 = cA + (size_t)(t + 1) * kstep;
            const char* a2 = last ? nA : cA + (size_t)(t + 2) * kstep; const char* b2 = last ? nB : cB + (size_t)(t + 2) * kstep;
            const char* a3 = a2 + kstep; const char* b3 = b2 + kstep;
            if (last && has_next) S.a_ready(nxt);
            if constexpr (SP2) {
            PG8_LDB(B0, 0, 0); PG8_LDB(B1, 0, 1); PG8_SCHED; PG8_LDA(At, 0, 0); PG8_STAGE(PG8_SA(1, 1), a1 + hstep, voffA);
            PG8_WAIT_V(8); PG8_WAIT_L(0); PG8_BAR; PG8_MMA(0, 0, At, B0); PG8_MMA(0, 1, At, B1); PG8_BAR; PG8_SCHED;
            PG8_LDA(At, 0, 1); PG8_STAGE(PG8_SB(0, 0), b2, voffB); PG8_STAGE(PG8_SB(0, 1), b2 + hstep, voffB); PG8_STAGE(PG8_SA(0, 0), a2, voffA);
            PG8_WAIT_V(8); PG8_WAIT_L(0); PG8_BAR; PG8_MMA(1, 0, At, B0); PG8_MMA(1, 1, At, B1); PG8_BAR; PG8_SCHED;
            PG8_LDB(B0, 1, 0); PG8_LDB(B1, 1, 1); PG8_SCHED; PG8_LDA(At, 1, 0); PG8_STAGE(PG8_SA(0, 1), a2 + hstep, voffA);
            PG8_WAIT_V(8); PG8_WAIT_L(0); PG8_BAR; PG8_MMA(0, 0, At, B0); PG8_MMA(0, 1, At, B1); PG8_BAR; PG8_SCHED;
            PG8_LDA(At, 1, 1); PG8_STAGE(PG8_SB(1, 0), b3, voffB); PG8_STAGE(PG8_SB(1, 1), b3 + hstep, voffB); PG8_STAGE(PG8_SA(1, 0), a3, voffA);
            PG8_WAIT_V(8); PG8_WAIT_L(0); PG8_BAR; PG8_MMA(1, 0, At, B0); PG8_MMA(1, 1, At, B1); PG8_BAR; PG8_SCHED;
            } else {
            PG8_LDB(B0, 0, 0); PG8_SCHED; PG8_LDA(At, 0, 0); PG8_STAGE(PG8_SA(1, 1), a1 + hstep, voffA);
            PG8_WAIT_L(8); PG8_BAR; PG8_WAIT_L(0); PG8_MMA(0, 0, At, B0); PG8_BAR; PG8_SCHED;
            PG8_LDB(B1, 0, 1); PG8_STAGE(PG8_SB(0, 0), b2, voffB);
            PG8_BAR; PG8_WAIT_L(0); PG8_MMA(0, 1, At, B1); PG8_BAR;
            PG8_LDA(At, 0, 1); PG8_STAGE(PG8_SA(0, 0), a2, voffA);
            PG8_BAR; PG8_WAIT_L(0); PG8_MMA(1, 0, At, B0); PG8_BAR; PG8_SCHED;
            PG8_STAGE(PG8_SB(0, 1), b2 + hstep, voffB);
            PG8_WAIT_V(6); PG8_BAR; PG8_MMA(1, 1, At, B1); PG8_BAR;
            PG8_LDB(B0, 1, 0); PG8_SCHED; PG8_LDA(At, 1, 0); PG8_STAGE(PG8_SA(0, 1), a2 + hstep, voffA);
            PG8_WAIT_L(8); PG8_BAR; PG8_WAIT_L(0); PG8_MMA(0, 0, At, B0); PG8_BAR; PG8_SCHED;
            PG8_LDB(B1, 1, 1); PG8_STAGE(PG8_SB(1, 0), b3, voffB);
            PG8_BAR; PG8_WAIT_L(0); PG8_MMA(0, 1, At, B1); PG8_BAR;
            PG8_LDA(At, 1, 1); PG8_STAGE(PG8_SA(1, 0), a3, voffA);
            PG8_BAR; PG8_WAIT_L(0); PG8_MMA(1, 0, At, B0); PG8_BAR; PG8_SCHED;
            PG8_STAGE(PG8_SB(1, 1), b3 + hstep, voffB);
            PG8_WAIT_V(6); PG8_BAR; PG8_MMA(1, 1, At, B1); PG8_BAR;
            }
        }
        if constexpr (ALIGN_EPI) { if (wr == 0) PG8_BAR; }
        if constexpr (!Epi::AFTER_DRAIN) { E(acc, cur, wr, wc, fr, fq); S.done(cur); }
        if (!has_next) break;
#pragma unroll
        for (int a = 0; a < 2; ++a)
#pragma unroll
            for (int b = 0; b < 2; ++b)
#pragma unroll
                for (int m = 0; m < 4; ++m)
#pragma unroll
                    for (int n = 0; n < 2; ++n) acc[a][b][m][n] = (f32x4){0.f, 0.f, 0.f, 0.f};
        cur = nxt; cA = nA; cB = nB; ++ui;
        if constexpr (ALIGN_EPI) { if (wr == 1) PG8_BAR; }
    }
    PG8_WAIT_V(0);
    if constexpr (!ALIGN_EPI) { if (wr == 0) PG8_BAR; }
    PG8_BAR;
    if constexpr (Epi::AFTER_DRAIN) { E.fused(acc, cur, wr, wc, fr, fq, lds, wid, lane); S.done(cur); }
#undef PG8_SA
#undef PG8_SB
#undef PG8_STAGE
#undef PG8_LDA
#undef PG8_LDB
#undef PG8_MMA
#undef PG8_WAIT_V
#undef PG8_WAIT_L
#undef PG8_BAR
#undef PG8_SCHED
}
}

#define GAS __attribute__((address_space(1)))
#define LAS __attribute__((address_space(3)))
typedef unsigned short bf16;
typedef unsigned v4u __attribute__((ext_vector_type(4)));
typedef float f32x4 __attribute__((ext_vector_type(4)));
typedef short bf16x8 __attribute__((ext_vector_type(8)));
typedef GAS unsigned gu32;
typedef GAS unsigned long long gu64;
#define RLX_AGENT __ATOMIC_RELAXED, __HIP_MEMORY_SCOPE_AGENT
#define LDS_WAIT() asm volatile("s_waitcnt lgkmcnt(0)" ::: "memory")
#define VM_WAIT() asm volatile("s_waitcnt vmcnt(0)" ::: "memory")
__device__ __forceinline__ unsigned long long rt() { return __builtin_amdgcn_s_memrealtime(); }
__device__ __forceinline__ unsigned f2bf(float f) { unsigned u = __builtin_bit_cast(unsigned, f); return (u + 0x7fffu + ((u >> 16) & 1u)) >> 16; }
__device__ __forceinline__ unsigned pk2(float lo, float hi) { return f2bf(lo) | (f2bf(hi) << 16); }
#define XB_TMO      128
#define XB_XCNT(j)  (256  + 64 * (j))
#define XB_XSUB(j)  (1280 + 64 * (j))
#define XB_XGEN(j)  (2304 + 64 * (j))
#define XB_TOP      3328
#define XB_TOPGEN   3392
#define XCD_BAR_WORDS 3456
#define XB_SPIN_CAP (1u << 18)

__device__ __forceinline__ unsigned xb_ld(unsigned* p)              { return __hip_atomic_load(p, __ATOMIC_RELAXED, __HIP_MEMORY_SCOPE_AGENT); }
__device__ __forceinline__ unsigned xb_add(unsigned* p, unsigned v) { return __hip_atomic_fetch_add(p, v, __ATOMIC_RELAXED, __HIP_MEMORY_SCOPE_AGENT); }
__device__ __forceinline__ unsigned xb_xcc_id() { return (unsigned)__builtin_amdgcn_s_getreg((3 << 11) | 20) & 0xFu; }
#define XB_SPIN(cond, bar) do { unsigned _sp = 0; while (cond) { __builtin_amdgcn_s_sleep(1); \
    if ((++_sp & 255u) == 0u) { if (xb_ld(&(bar)[XB_TMO])) break; if (_sp > XB_SPIN_CAP) { atomicAdd(&(bar)[XB_TMO], 1u); break; } } } } while (0)

struct XcdBarrier {
    unsigned* bar; unsigned x;
    volatile LAS unsigned* st;
};

__device__ __forceinline__ XcdBarrier xcd_barrier_post(unsigned* bar, volatile LAS unsigned* st) {
    XcdBarrier b; b.bar = bar; b.x = xb_xcc_id(); b.st = st;
    if (threadIdx.x == 0) (void)xb_add(&bar[XB_XCNT(b.x)], 1u);
    return b;
}
__device__ __forceinline__ void xcd_barrier_complete(unsigned* bar, unsigned x, unsigned& nloc, unsigned& nx) {
    const unsigned G = gridDim.x * gridDim.y * gridDim.z;
    unsigned sum, cnt, mine, sp = 0u;
    for (;;) {
        sum = 0u; cnt = 0u; mine = 0u;
#pragma unroll
        for (unsigned j = 0; j < 16; ++j) { const unsigned c = xb_ld(&bar[XB_XCNT(j)]); sum += c; cnt += (c > 0u) ? 1u : 0u; mine = (j == x) ? c : mine; }
        if (sum == G) break;
        __builtin_amdgcn_s_sleep(1);
        if ((++sp & 255u) == 0u) { if (xb_ld(&bar[XB_TMO])) break; if (sp > XB_SPIN_CAP) { atomicAdd(&bar[XB_TMO], 1u); break; } }
    }
    nloc = mine > 0u ? mine : 1u; nx = cnt > 0u ? cnt : 1u;
}

__device__ __forceinline__ void xcd_barrier(const XcdBarrier& b, const int wave_sgpr) {
    const bool xb_t0 = (wave_sgpr == 0) && (fresh_lane() == 0);
    asm volatile("s_waitcnt vmcnt(0)" ::: "memory");
    __syncthreads();
    if (xb_t0) {
        unsigned* bar = b.bar;
        __builtin_amdgcn_s_waitcnt(0);
        unsigned nloc = b.st[0], nx = b.st[1];
        if (nloc == 0u) { xcd_barrier_complete(bar, b.x, nloc, nx); b.st[0] = nloc; b.st[1] = nx; }
        const unsigned old = xb_add(&bar[XB_XSUB(b.x)], 1u);
        const unsigned gen = old / nloc;
        if (old + 1u == (gen + 1u) * nloc) {
            __builtin_amdgcn_fence(__ATOMIC_RELEASE, "agent");
            asm volatile("s_waitcnt vmcnt(0)" ::: "memory");
            const unsigned og = xb_add(&bar[XB_TOP], 1u);
            const unsigned tg = og / nx;
            if (og + 1u == (tg + 1u) * nx) xb_add(&bar[XB_TOPGEN], 1u);
            else XB_SPIN(xb_ld(&bar[XB_TOPGEN]) == tg, bar);
            __builtin_amdgcn_fence(__ATOMIC_ACQUIRE, "agent");
            xb_add(&bar[XB_XGEN(b.x)], 1u);
            asm volatile("s_waitcnt vmcnt(0)" ::: "memory");
        } else {
            XB_SPIN(xb_ld(&bar[XB_XGEN(b.x)]) == gen, bar);
            __builtin_amdgcn_fence(__ATOMIC_ACQUIRE, "agent");
            asm volatile("s_waitcnt vmcnt(0)" ::: "memory");
        }
    }
    __syncthreads();
}

constexpr int NWAVES = 8;
constexpr int BATCH = 16, SEQ = 2048, DM = 2048, MROWS = BATCH * SEQ;
constexpr float RMS_EPS = 1e-6f, GN_EPS = 64e-5f, LOG2E = 1.4426950408889634f;
constexpr int P0 = 4608;
constexpr int P2 = 8192;
constexpr int P3 = 8192;
constexpr size_t MiB = 1u << 20;
constexpr size_t WS_CTL = 0, CTL_ZERO_BYTES = 1 * MiB;
constexpr size_t WS_W = 1 * MiB;
constexpr size_t WS_S0 = 48 * MiB, SLOT = 128 * MiB;
#define WS_SLOT(i) (WS_S0 + (size_t)(i) * SLOT)
constexpr size_t WS_SMALL = WS_S0 + 7 * SLOT;
constexpr size_t WS_L1 = WS_SMALL;
constexpr size_t WS_GX = WS_SMALL + 16 * MiB;
constexpr size_t WS_F = WS_SMALL + 20 * MiB;
constexpr size_t WS_W3 = WS_SMALL + 24 * MiB;
constexpr size_t WS_END = WS_W3 + 42 * MiB;
constexpr int CW_TMO = 0;
constexpr int CW_BAR = 4096;
constexpr int CW_MLF = 8192;
constexpr int CW_QUEUE = 2048;
constexpr size_t W0_IN = 0, W0_OUT = (size_t)4608 * 2048;
constexpr size_t W1_IN = 0, W1_LA = (size_t)4 * 2048 * 2048, W1_LB = W1_LA + (size_t)256 * 2048, W1_L2 = W1_LB + (size_t)256 * 2048, W1_OUT = W1_L2 + (size_t)4096 * 256;
constexpr size_t W2_IN = 0, W2_OUT = (size_t)8448 * 2048;
static_assert((W1_OUT + (size_t)2048 * 2048) * 2 <= 47 * MiB && (W2_OUT + (size_t)2048 * 2048) * 2 <= 47 * MiB, "weight region");
constexpr int RING_BYTES = 131072;
constexpr int MISC_OFF = RING_BYTES;
constexpr int LDS_BYTES = 147456;

typedef float f32x2 __attribute__((ext_vector_type(2)));
struct Frame {
    LAS unsigned char* lds;
    int tid, lane, wave, vcu, G;
    int cvi, cvn;
};
__device__ __forceinline__ float wave_sum(float v) {
#pragma unroll
    for (int o = 1; o < 64; o <<= 1) v += __shfl_xor(v, o);
    return v;
}
__device__ __forceinline__ float bf2f(unsigned short b) { return __builtin_bit_cast(float, (unsigned)b << 16); }
__device__ __forceinline__ float bflo(unsigned w) { return __builtin_bit_cast(float, w << 16); }
__device__ __forceinline__ float bfhi(unsigned w) { return __builtin_bit_cast(float, w & 0xffff0000u); }
__device__ __forceinline__ unsigned pkbf(float lo, float hi) { return pg8::cvt_pk_bf16(lo, hi); }
__device__ __forceinline__ float siluf(float x) { return x * __builtin_amdgcn_rcpf(1.0f + __expf(-x)); }
__device__ __forceinline__ float sigmf(float x) { return __builtin_amdgcn_rcpf(1.0f + __expf(-x)); }
__device__ __forceinline__ float logsigf(float z) { return fminf(z, 0.f) - log1pf(__expf(-fabsf(z))); }

__device__ __forceinline__ void transpose_item(const float* W, int ldw, int n0w, int K, int N, bf16* WT, int row_off, LAS float* scr, int item, int lane, const float* gk = nullptr) {
    const int nblk = N / 32, kb = item / nblk, nb = item % nblk, k0 = 64 * kb, n0 = 32 * nb;
#pragma unroll 8
    for (int i = 0; i < 32; ++i) { const int kk = 2 * i + (lane >> 5); float w = W[(size_t)(k0 + kk) * ldw + n0w + n0 + (lane & 31)]; if (gk) w *= gk[k0 + kk]; scr[kk * 33 + (lane & 31)] = w; }
    LDS_WAIT(); asm volatile("" ::: "memory");
    const int c = lane & 7;
#pragma unroll
    for (int j = 0; j < 4; ++j) { const int n = (lane >> 3) + 8 * j; const LAS float* s = scr + (8 * c) * 33 + n;
        v4u o; o.x = pkbf(s[0 * 33], s[1 * 33]); o.y = pkbf(s[2 * 33], s[3 * 33]); o.z = pkbf(s[4 * 33], s[5 * 33]); o.w = pkbf(s[6 * 33], s[7 * 33]);
        *(GAS v4u*)(WT + (size_t)(row_off + n0 + n) * K + k0 + 8 * c) = o; }
    LDS_WAIT(); asm volatile("" ::: "memory");
}
__device__ __forceinline__ void convert_matrix(Frame& F, const float* W, int ldw, int n0w, int K, int N, bf16* WT, int row_off, const float* gk = nullptr) {
    LAS float* scr = (LAS float*)(F.lds + F.wave * 16384);
    const int gw = F.cvi * NWAVES + F.wave, NGW = F.cvn * NWAVES, nitems = (K / 64) * (N / 32);
    for (int it = gw; it < nitems; it += NGW) transpose_item(W, ldw, n0w, K, N, WT, row_off, scr, it, F.lane, gk);
}
__device__ __forceinline__ void zero_rows(Frame& F, bf16* WT, int K, int r0, int r1) {
    const size_t n16 = (size_t)(r1 - r0) * K / 8; GAS v4u* p = (GAS v4u*)(WT + (size_t)r0 * K);
    for (size_t i = (size_t)F.cvi * 512 + F.tid; i < n16; i += (size_t)F.cvn * 512) p[i] = (v4u){0u, 0u, 0u, 0u};
}
__device__ __forceinline__ void convert_cols_small(Frame& F, const float* W, int ldw, int n0w, int K, int N, bf16* WT, int row_off, const float* gk = nullptr) {
    const int total = K * N;
    for (int i = F.cvi * 512 + F.tid; i < total; i += F.cvn * 512) { const int n = i / K, k = i % K; float w = W[(size_t)k * ldw + n0w + n]; if (gk) w *= gk[k]; WT[(size_t)(row_off + n) * K + k] = (bf16)f2bf(w); }
}

template <bool XBF> __device__ __forceinline__ f32x4 xrow_load(const void* x, size_t m, int lane, int j) {
    typedef unsigned u32x2_t __attribute__((ext_vector_type(2)));
    if constexpr (XBF) { const u32x2_t w = *((const GAS u32x2_t*)((const bf16*)x + m * DM) + lane + 64 * j); return (f32x4){bflo(w.x), bfhi(w.x), bflo(w.y), bfhi(w.y)}; }
    else return *((const GAS f32x4*)((const float*)x + m * DM) + lane + 64 * j);
}
template <bool XBF> __device__ __forceinline__ void phase_norm(Frame& F, const void* x, const float* gain, bf16* out) {
    const int gw = F.vcu * NWAVES + F.wave, NGW = F.G * NWAVES;
    f32x4 g[8];
#pragma unroll
    for (int j = 0; j < 8; ++j) g[j] = *(const f32x4*)(gain + (F.lane + 64 * j) * 4);
    f32x4 vn[8];
    if (gw < MROWS) {
#pragma unroll
        for (int j = 0; j < 8; ++j) vn[j] = xrow_load<XBF>(x, (size_t)gw, F.lane, j); }
    for (int m = gw; m < MROWS; m += NGW) {
        f32x4 v[8]; float s = 0.f;
#pragma unroll
        for (int j = 0; j < 8; ++j) { v[j] = vn[j]; s += (v[j].x * v[j].x + v[j].y * v[j].y) + (v[j].z * v[j].z + v[j].w * v[j].w); }
        if (m + NGW < MROWS) {
#pragma unroll
            for (int j = 0; j < 8; ++j) vn[j] = xrow_load<XBF>(x, (size_t)(m + NGW), F.lane, j); }
        const float rstd = 1.0f / sqrtf(wave_sum(s) * (1.0f / DM) + RMS_EPS);
        GAS unsigned long long* o8 = (GAS unsigned long long*)(out + (size_t)m * DM) + F.lane;
#pragma unroll
        for (int j = 0; j < 8; ++j) { const f32x4 y = v[j] * rstd * g[j]; o8[64 * j] = (unsigned long long)pkbf(y.x, y.y) | ((unsigned long long)pkbf(y.z, y.w) << 32); }
    }
}
__device__ __forceinline__ void phase_rstd(Frame& F, const bf16* x, float* RS) {
    const int gw = F.vcu * NWAVES + F.wave, NGW = F.G * NWAVES;
    typedef unsigned u32x4_t __attribute__((ext_vector_type(4)));
    u32x4_t vn[4];
    if (gw < MROWS) {
#pragma unroll
        for (int j = 0; j < 4; ++j) vn[j] = *((const GAS u32x4_t*)(x + (size_t)gw * DM) + F.lane + 64 * j); }
    for (int m = gw; m < MROWS; m += NGW) {
        float s = 0.f;
#pragma unroll
        for (int j = 0; j < 4; ++j) {
#pragma unroll
            for (int e = 0; e < 4; ++e) { const float a = bflo(vn[j][e]), c = bfhi(vn[j][e]); s += a * a + c * c; } }
        if (m + NGW < MROWS) {
#pragma unroll
            for (int j = 0; j < 4; ++j) vn[j] = *((const GAS u32x4_t*)(x + (size_t)(m + NGW) * DM) + F.lane + 64 * j); }
        s = wave_sum(s);
        if (F.lane == 0) RS[m] = 1.0f / sqrtf(s * (1.0f / DM) + RMS_EPS);
    }
}

typedef float f32x16 __attribute__((ext_vector_type(16)));
typedef short v4i16_t __attribute__((ext_vector_type(4)));
typedef unsigned u32x4 __attribute__((ext_vector_type(4)));
typedef unsigned u32x2 __attribute__((ext_vector_type(2)));
__device__ __forceinline__ int crow(int r, int hi) { return (r & 3) + 8 * (r >> 2) + 4 * hi; }
__device__ __forceinline__ bf16x8 mk8(v4i16_t lo, v4i16_t hi) { return (bf16x8){lo[0], lo[1], lo[2], lo[3], hi[0], hi[1], hi[2], hi[3]}; }
__device__ __forceinline__ v4i16_t ldtr(const LAS unsigned char* p) { return __builtin_amdgcn_ds_read_tr16_b64_v4i16((LAS v4i16_t*)p); }
__device__ __forceinline__ bf16x8 pack8(float a0, float a1, float a2, float a3, float a4, float a5, float a6, float a7) {
    u32x4 w; w.x = pkbf(a0, a1); w.y = pkbf(a2, a3); w.z = pkbf(a4, a5); w.w = pkbf(a6, a7); return __builtin_bit_cast(bf16x8, w); }
__device__ __forceinline__ int t5_bucket(int d) {
    if (d < 16) return d;
    int b = 15; b += (d >= 16); b += (d >= 19); b += (d >= 21); b += (d >= 24); b += (d >= 27); b += (d >= 31); b += (d >= 35); b += (d >= 40);
    b += (d >= 46); b += (d >= 52); b += (d >= 59); b += (d >= 67); b += (d >= 77); b += (d >= 87); b += (d >= 99); b += (d >= 113); return b;
}


__device__ __forceinline__ void attn_epilogue(const f32x16 (&O)[2], float rl, const bf16* gate0, int gpitch, bf16* out0, LAS unsigned char* stg, int lane) {
    const int r32 = lane & 31, hi = lane >> 5, srow = lane >> 3, sch = lane & 7;
#pragma unroll
    for (int i = 0; i < 4; ++i) { const int row = i * 8 + srow; *(LAS u32x4*)(stg + row * 128 + sch * 16) = *(const GAS u32x4*)(gate0 + (size_t)row * gpitch + sch * 8); }
#pragma unroll
    for (int db = 0; db < 2; ++db)
#pragma unroll
        for (int g4 = 0; g4 < 4; ++g4) { const int d0 = db * 32 + 8 * g4 + 4 * hi;
            LAS u32x2* sp = (LAS u32x2*)(stg + r32 * 128 + d0 * 2);
            const u32x2 gv = *sp;
            const float o0 = O[db][4 * g4 + 0] * rl * siluf(bflo(gv.x)), o1 = O[db][4 * g4 + 1] * rl * siluf(bfhi(gv.x));
            const float o2 = O[db][4 * g4 + 2] * rl * siluf(bflo(gv.y)), o3 = O[db][4 * g4 + 3] * rl * siluf(bfhi(gv.y));
            u32x2 w; w.x = pkbf(o0, o1); w.y = pkbf(o2, o3); *sp = w; }
#pragma unroll
    for (int i = 0; i < 4; ++i) { const int row = i * 8 + srow; *(GAS u32x4*)(out0 + (size_t)row * 2048 + sch * 8) = *(const LAS u32x4*)(stg + row * 128 + sch * 16); }
}

__device__ __forceinline__ void phase_swa(Frame& F, const bf16* proj, const float* q_gain, const float* k_gain, const float* sinks, const float* rel, bf16* og) {
    LAS unsigned char* KS = F.lds;
    LAS unsigned char* VS = F.lds + 36864;
    LAS float* BT = (LAS float*)(F.lds + 36864 + 32768) + F.wave * 128;
    LAS unsigned char* STG = F.lds + 36864 + 32768 + 4096 + F.wave * 4096;
    const int lane0 = F.lane, wave = F.wave;
    for (int u = F.vcu; u < 1024; u += F.G) {
        int lane = lane0; asm volatile("" : "+v"(lane)); const int tid = wave * 64 + lane;
        const int b = u >> 6, kvh = (u >> 4) & 3, j = u & 15;
        const size_t rowbase = (size_t)b * SEQ;
        const int head = kvh * 8 + wave;
        __syncthreads();
#pragma unroll
        for (int i = 0; i < 4; ++i) {
            const int s = (tid >> 3) + 64 * i, ch = tid & 7, t = j * 128 - 128 + s;
            u32x4 kv = {0u, 0u, 0u, 0u}, vv = {0u, 0u, 0u, 0u};
            if (t >= 0) { const bf16* rp = proj + (rowbase + t) * P0 + kvh * 64 + ch * 8; kv = *(const GAS u32x4*)(rp + 2048); vv = *(const GAS u32x4*)(rp + 2304); }
            float kf[8] = {bflo(kv.x), bfhi(kv.x), bflo(kv.y), bfhi(kv.y), bflo(kv.z), bfhi(kv.z), bflo(kv.w), bfhi(kv.w)};
            float ss = 0.f;
#pragma unroll
            for (int e = 0; e < 8; ++e) ss += kf[e] * kf[e];
            ss += __shfl_xor(ss, 1); ss += __shfl_xor(ss, 2); ss += __shfl_xor(ss, 4);
            const float rstd = 1.0f / sqrtf(ss * (1.0f / 64.0f) + RMS_EPS);
            const f32x4 g0 = *(const f32x4*)(k_gain + ch * 8), g1 = *(const f32x4*)(k_gain + ch * 8 + 4);
            u32x4 ko; ko.x = pkbf(kf[0] * rstd * g0.x, kf[1] * rstd * g0.y); ko.y = pkbf(kf[2] * rstd * g0.z, kf[3] * rstd * g0.w);
            ko.z = pkbf(kf[4] * rstd * g1.x, kf[5] * rstd * g1.y); ko.w = pkbf(kf[6] * rstd * g1.z, kf[7] * rstd * g1.w);
            *(LAS u32x4*)(KS + s * 144 + ch * 16) = ko;
            *(LAS u32x4*)(VS + (ch >> 2) * 16384 + s * 64 + (ch & 3) * 16) = vv;
        }
        for (int dd = lane; dd < 128; dd += 64) BT[dd] = rel[t5_bucket(dd) * 32 + head] * LOG2E;
        const float sink2 = sinks[head] * LOG2E;
        __syncthreads();
        const int ktmin = (j == 0) ? 4 : 0;
        for (int qs = 0; qs < 4; ++qs) {
            int lq = lane0; asm volatile("" : "+v"(lq)); const int r32 = lq & 31, hi = lq >> 5, g16 = lq >> 4, q4 = (lq & 15) >> 2, p4 = lq & 3;
            const size_t qrow = rowbase + j * 128 + qs * 32 + r32;
            const bf16* qp = proj + qrow * P0 + head * 64 + hi * 8;
            u32x4 qraw[4]; float ss = 0.f;
#pragma unroll
            for (int s4 = 0; s4 < 4; ++s4) { qraw[s4] = *(const GAS u32x4*)(qp + s4 * 16);
#pragma unroll
                for (int e = 0; e < 4; ++e) { const float a = bflo(qraw[s4][e]), c = bfhi(qraw[s4][e]); ss += a * a + c * c; } }
            ss += __shfl_xor(ss, 32);
            const float qsc = (0.125f * LOG2E) / sqrtf(ss * (1.0f / 64.0f) + RMS_EPS);
            bf16x8 qfr[4];
#pragma unroll
            for (int s4 = 0; s4 < 4; ++s4) { const f32x4 g0 = *(const f32x4*)(q_gain + s4 * 16 + hi * 8), g1 = *(const f32x4*)(q_gain + s4 * 16 + hi * 8 + 4);
                qfr[s4] = pack8(bflo(qraw[s4].x) * qsc * g0.x, bfhi(qraw[s4].x) * qsc * g0.y, bflo(qraw[s4].y) * qsc * g0.z, bfhi(qraw[s4].y) * qsc * g0.w,
                                bflo(qraw[s4].z) * qsc * g1.x, bfhi(qraw[s4].z) * qsc * g1.y, bflo(qraw[s4].w) * qsc * g1.z, bfhi(qraw[s4].w) * qsc * g1.w); }
            f32x16 S[5];
#pragma unroll
            for (int tt = 0; tt < 5; ++tt) {
                const int kt = qs + tt;
                if (kt >= ktmin) {
                    f32x16 acc;
#pragma unroll
                    for (int r = 0; r < 16; ++r) acc[r] = 0.f;
                    const LAS unsigned char* kp = KS + (32 * kt + r32) * 144 + hi * 16;
#pragma unroll
                    for (int s4 = 0; s4 < 4; ++s4) acc = __builtin_amdgcn_mfma_f32_32x32x16_bf16(*(const LAS bf16x8*)(kp + s4 * 32), qfr[s4], acc, 0, 0, 0);
#pragma unroll
                    for (int r = 0; r < 16; ++r) { const int c = crow(r, hi); const int dist = r32 + 128 - 32 * tt - c;
                        const bool valid = (tt == 0) ? (c > r32) : ((tt == 4) ? (c <= r32) : true);
                        const float bsv = BT[dist & 127];
                        acc[r] = valid ? acc[r] + bsv : -INFINITY; }
                    S[tt] = acc;
                } else {
#pragma unroll
                    for (int r = 0; r < 16; ++r) S[tt][r] = -INFINITY;
                }
            }
            float mx = sink2;
#pragma unroll
            for (int tt = 0; tt < 5; ++tt)
#pragma unroll
                for (int r = 0; r < 16; ++r) mx = fmaxf(mx, S[tt][r]);
            mx = fmaxf(mx, __shfl_xor(mx, 32));
            float l = 0.f;
#pragma unroll
            for (int tt = 0; tt < 5; ++tt)
#pragma unroll
                for (int r = 0; r < 16; ++r) { const float p = __builtin_amdgcn_exp2f(S[tt][r] - mx); S[tt][r] = p; l += p; }
            l += __shfl_xor(l, 32); l += __builtin_amdgcn_exp2f(sink2 - mx);
            const float rl = 1.0f / l;
            f32x16 O[2];
#pragma unroll
            for (int r = 0; r < 16; ++r) { O[0][r] = 0.f; O[1][r] = 0.f; }
#pragma unroll
            for (int tt = 0; tt < 5; ++tt) {
                const int kt = qs + tt;
                if (kt >= ktmin) {
#pragma unroll
                    for (int s2 = 0; s2 < 2; ++s2) {
                        const bf16x8 pf = pack8(S[tt][8 * s2 + 0], S[tt][8 * s2 + 1], S[tt][8 * s2 + 2], S[tt][8 * s2 + 3], S[tt][8 * s2 + 4], S[tt][8 * s2 + 5], S[tt][8 * s2 + 6], S[tt][8 * s2 + 7]);
#pragma unroll
                        for (int db = 0; db < 2; ++db) {
                            const LAS unsigned char* va = VS + db * 16384 + (32 * kt + 16 * s2 + 4 * (g16 >> 1) + q4) * 64 + (g16 & 1) * 32 + p4 * 8;
                            const v4i16_t lo = ldtr(va), hh = ldtr(va + 512);
                            O[db] = __builtin_amdgcn_mfma_f32_32x32x16_bf16(mk8(lo, hh), pf, O[db], 0, 0, 0);
                        }
                    }
                }
            }
            { const size_t row0 = rowbase + j * 128 + qs * 32;
              attn_epilogue(O, rl, proj + row0 * P0 + 2560 + head * 64, P0, og + row0 * 2048 + head * 64, STG, lq); }
        }
    }
}

__device__ __forceinline__ void phase_mix_from_x(Frame& F, const float* x, const float* gain, const float* mixA, const float* mixB, bf16* hout, bf16* xa, bf16* xb) {
    const int gw = F.vcu * NWAVES + F.wave, NGW = F.G * NWAVES;
    for (int run = gw; run < MROWS / 8; run += NGW) {
        const int m0 = run * 8;
        f32x4 prev[8];
        if ((m0 & (SEQ - 1)) == 0) {
#pragma unroll
            for (int j = 0; j < 8; ++j) prev[j] = (f32x4){0.f, 0.f, 0.f, 0.f};
        } else {
            float s = 0.f;
#pragma unroll
            for (int j = 0; j < 8; ++j) { prev[j] = xrow_load<true>(x, (size_t)(m0 - 1), F.lane, j); s += (prev[j].x * prev[j].x + prev[j].y * prev[j].y) + (prev[j].z * prev[j].z + prev[j].w * prev[j].w); }
            const float rstd = 1.0f / sqrtf(wave_sum(s) * (1.0f / DM) + RMS_EPS);
#pragma unroll
            for (int j = 0; j < 8; ++j) prev[j] = prev[j] * rstd * *(const f32x4*)(gain + (F.lane + 64 * j) * 4);
        }
        for (int r = 0; r < 8; ++r) {
            const size_t m = (size_t)(m0 + r);
            const GAS f32x4* xr = (const GAS f32x4*)(x + m * DM) + F.lane;
            f32x4 v[8]; float s = 0.f;
#pragma unroll
            for (int j = 0; j < 8; ++j) { v[j] = xr[64 * j]; s += (v[j].x * v[j].x + v[j].y * v[j].y) + (v[j].z * v[j].z + v[j].w * v[j].w); }
            const float rstd = 1.0f / sqrtf(wave_sum(s) * (1.0f / DM) + RMS_EPS);
            GAS unsigned long long* oh = (GAS unsigned long long*)(hout + m * DM) + F.lane;
            GAS unsigned long long* oa = (GAS unsigned long long*)(xa + m * DM) + F.lane;
            GAS unsigned long long* ob = (GAS unsigned long long*)(xb + m * DM) + F.lane;
#pragma unroll
            for (int j = 0; j < 8; ++j) {
                const int c = (F.lane + 64 * j) * 4;
                const f32x4 hcur = v[j] * rstd * *(const f32x4*)(gain + c);
                const f32x4 d = prev[j] - hcur;
                const f32x4 ya = hcur + d * *(const f32x4*)(mixA + c), yb = hcur + d * *(const f32x4*)(mixB + c);
                oh[64 * j] = (unsigned long long)pkbf(hcur.x, hcur.y) | ((unsigned long long)pkbf(hcur.z, hcur.w) << 32);
                oa[64 * j] = (unsigned long long)pkbf(ya.x, ya.y) | ((unsigned long long)pkbf(ya.z, ya.w) << 32);
                ob[64 * j] = (unsigned long long)pkbf(yb.x, yb.y) | ((unsigned long long)pkbf(yb.z, yb.w) << 32);
                prev[j] = hcur;
            }
        }
    }
}
__device__ __forceinline__ void phase_mix_from_h(Frame& F, const bf16* h, const float* mixA, bf16* xa, const float* mixB, bf16* xb) {
    const int gw = F.vcu * NWAVES + F.wave, NGW = F.G * NWAVES;
    for (int run = gw; run < MROWS / 8; run += NGW) {
        const int m0 = run * 8;
        u32x4 prev[4];
        if ((m0 & (SEQ - 1)) == 0) {
#pragma unroll
            for (int j = 0; j < 4; ++j) prev[j] = (u32x4){0u, 0u, 0u, 0u};
        } else {
            const GAS u32x4* hr = (const GAS u32x4*)(h + (size_t)(m0 - 1) * DM) + F.lane;
#pragma unroll
            for (int j = 0; j < 4; ++j) prev[j] = hr[64 * j];
        }
        for (int r = 0; r < 8; ++r) {
            const size_t m = (size_t)(m0 + r);
            const GAS u32x4* hr = (const GAS u32x4*)(h + m * DM) + F.lane;
            u32x4 cur[4];
#pragma unroll
            for (int j = 0; j < 4; ++j) cur[j] = hr[64 * j];
#pragma unroll
            for (int j = 0; j < 4; ++j) {
                const int c = (F.lane + 64 * j) * 8;
                const f32x4 ma0 = *(const f32x4*)(mixA + c), ma1 = *(const f32x4*)(mixA + c + 4);
                float hc[8], hp[8];
#pragma unroll
                for (int e = 0; e < 4; ++e) { hc[2 * e] = bflo(cur[j][e]); hc[2 * e + 1] = bfhi(cur[j][e]); hp[2 * e] = bflo(prev[j][e]); hp[2 * e + 1] = bfhi(prev[j][e]); }
                const float ma[8] = {ma0.x, ma0.y, ma0.z, ma0.w, ma1.x, ma1.y, ma1.z, ma1.w};
                u32x4 o;
#pragma unroll
                for (int e = 0; e < 4; ++e) o[e] = pkbf(hc[2 * e] + (hp[2 * e] - hc[2 * e]) * ma[2 * e], hc[2 * e + 1] + (hp[2 * e + 1] - hc[2 * e + 1]) * ma[2 * e + 1]);
                *((GAS u32x4*)(xa + m * DM) + F.lane + 64 * j) = o;
                if (xb) {
                    const f32x4 mb0 = *(const f32x4*)(mixB + c), mb1 = *(const f32x4*)(mixB + c + 4);
                    const float mb[8] = {mb0.x, mb0.y, mb0.z, mb0.w, mb1.x, mb1.y, mb1.z, mb1.w};
#pragma unroll
                    for (int e = 0; e < 4; ++e) o[e] = pkbf(hc[2 * e] + (hp[2 * e] - hc[2 * e]) * mb[2 * e], hc[2 * e + 1] + (hp[2 * e + 1] - hc[2 * e + 1]) * mb[2 * e + 1]);
                    *((GAS u32x4*)(xb + m * DM) + F.lane + 64 * j) = o;
                }
            }
#pragma unroll
            for (int j = 0; j < 4; ++j) prev[j] = cur[j];
        }
    }
}
__device__ __forceinline__ void phase_mix6(Frame& F, const bf16* x, const float* gain, const float* mix, bf16* o0, bf16* o1, bf16* o2, bf16* o3, bf16* o4, bf16* o5) {
    LAS float* GL = (LAS float*)F.lds;
    for (int i = F.tid; i < 2048 / 4; i += 512) *(LAS f32x4*)(GL + 4 * i) = *(const f32x4*)(gain + 4 * i);
    for (int i = F.tid; i < 6 * 2048 / 4; i += 512) *(LAS f32x4*)(GL + 2048 + 4 * i) = *(const f32x4*)(mix + 4 * i);
    __syncthreads();
    const int gw = F.vcu * NWAVES + F.wave, NGW = F.G * NWAVES;
    for (int run = gw; run < MROWS / 8; run += NGW) {
        const int m0 = run * 8;
        f32x4 prev[8];
        if ((m0 & (SEQ - 1)) == 0) {
#pragma unroll
            for (int j = 0; j < 8; ++j) prev[j] = (f32x4){0.f, 0.f, 0.f, 0.f};
        } else {
            float s = 0.f;
#pragma unroll
            for (int j = 0; j < 8; ++j) { prev[j] = xrow_load<true>(x, (size_t)(m0 - 1), F.lane, j); s += (prev[j].x * prev[j].x + prev[j].y * prev[j].y) + (prev[j].z * prev[j].z + prev[j].w * prev[j].w); }
            const float rstd = 1.0f / sqrtf(wave_sum(s) * (1.0f / DM) + RMS_EPS);
#pragma unroll
            for (int j = 0; j < 8; ++j) prev[j] = prev[j] * rstd * *(const LAS f32x4*)(GL + (F.lane + 64 * j) * 4);
        }
        f32x4 vn[8];
        {
#pragma unroll
          for (int j = 0; j < 8; ++j) vn[j] = xrow_load<true>(x, (size_t)m0, F.lane, j); }
        for (int r = 0; r < 8; ++r) {
            const size_t m = (size_t)(m0 + r);
            f32x4 v[8]; float s = 0.f;
#pragma unroll
            for (int j = 0; j < 8; ++j) { v[j] = vn[j]; s += (v[j].x * v[j].x + v[j].y * v[j].y) + (v[j].z * v[j].z + v[j].w * v[j].w); }
            if (r + 1 < 8) {
#pragma unroll
                for (int j = 0; j < 8; ++j) vn[j] = xrow_load<true>(x, m + 1, F.lane, j); }
            const float rstd = 1.0f / sqrtf(wave_sum(s) * (1.0f / DM) + RMS_EPS);
#pragma unroll
            for (int j = 0; j < 8; ++j) {
                const int c = (F.lane + 64 * j) * 4;
                const f32x4 hcur = v[j] * rstd * *(const LAS f32x4*)(GL + c);
                const f32x4 d = prev[j] - hcur;
#define MIX6_ST(ci, op) do { const f32x4 y = hcur + d * *(const LAS f32x4*)(GL + 2048 * ((ci) + 1) + c); \
                    *((GAS unsigned long long*)((op) + m * DM) + F.lane + 64 * j) = (unsigned long long)pkbf(y.x, y.y) | ((unsigned long long)pkbf(y.z, y.w) << 32); } while (0)
                MIX6_ST(0, o0); MIX6_ST(1, o1); MIX6_ST(2, o2); MIX6_ST(3, o3); MIX6_ST(4, o4); MIX6_ST(5, o5);
#undef MIX6_ST
                prev[j] = hcur;
            }
        }
    }
}
__device__ __forceinline__ void convert_lora2(Frame& F, const float* wl2, const float* al2, bf16* WT) {
    const int total = 4096 * 256;
    for (int i = F.cvi * 512 + F.tid; i < total; i += F.cvn * 512) {
        const int k = i >> 12, n = i & 4095;
        float v = 0.f;
        if (n < 2048) { if (k < 96) v = wl2[(size_t)k * 2048 + n]; } else { if (k >= 128 && k < 224) v = al2[(size_t)(k - 128) * 2048 + (n - 2048)]; }
        WT[(size_t)n * 256 + k] = (bf16)f2bf(v);
    }
}

constexpr int RW_T = 16;
constexpr int RW_MS = 144;
constexpr int RW_MAT = 16 * RW_MS;
constexpr int RW_O_AL = 0, RW_O_NB = RW_MAT, RW_O_KA = 2 * RW_MAT, RW_O_RH = 3 * RW_MAT, RW_O_PL = 4 * RW_MAT, RW_OPS = 4 * RW_MAT + 256;
constexpr int RW_OFF_OPS = 0;
constexpr int RW_OFF_VV = 3 * RW_OPS;
constexpr int RW_OFF_BON = RW_OFF_VV + 4 * RW_MAT;
constexpr int RW_OFF_GR = RW_OFF_BON + 4 * 64;
constexpr int RW_GRS = 1024 + 3 * 512 + 1024;
constexpr int RW_OFF_YB = RW_OFF_GR + 2 * RW_GRS;
constexpr int RW_OFF_LWS = RW_OFF_YB + 2 * 4096;
constexpr int RW_SEQ_BYTES = RW_OFF_LWS + 2 * 4096;
static_assert(2 * RW_SEQ_BYTES <= RING_BYTES, "rwkv LDS");
template <int CTRL> __device__ __forceinline__ float dppmov(float v) { return __builtin_bit_cast(float, __builtin_amdgcn_mov_dpp(__builtin_bit_cast(int, v), CTRL, 0xf, 0xf, true)); }
__device__ __forceinline__ float red16(float v) {
    v += dppmov<0xB1>(v); v += dppmov<0x4E>(v); v += dppmov<0x141>(v); v += dppmov<0x140>(v); return v;
}
__device__ __forceinline__ int rw_tau(int p) { return ((p & 3) << 2) | (p >> 2); }
__device__ __forceinline__ void red16x2(float& a, float& b) {
    a += dppmov<0xB1>(a); b += dppmov<0xB1>(b); asm("" : "+v"(a), "+v"(b));
    a += dppmov<0x4E>(a); b += dppmov<0x4E>(b); asm("" : "+v"(a), "+v"(b));
    a += dppmov<0x141>(a); b += dppmov<0x141>(b); asm("" : "+v"(a), "+v"(b));
    a += dppmov<0x140>(a); b += dppmov<0x140>(b);
}
__device__ __forceinline__ void phase_rwkv(Frame& F, const bf16* Rb, const bf16* Kb, const bf16* Vb, const bf16* Gb, const bf16* LWb, const bf16* Ab,
                                           const float* k_k, const float* k_a, const float* r_k, const float* gn_w, const float* gn_b, bf16* out) {
    const int lane = F.lane, sq = F.wave >> 2, wq = F.wave & 3, tid4 = wq * 64 + lane;
    const int pt = tid4 >> 4, pq = tid4 & 15;
    const int l15 = lane & 15, g = lane >> 4, q4 = l15 >> 2, p4 = lane & 3;
    LAS unsigned char* base = F.lds + sq * RW_SEQ_BYTES;
    constexpr int NB = SEQ / RW_T;
    for (int s0 = 2 * F.vcu; s0 < BATCH * 32; s0 += 2 * F.G) {
        const int seq = s0 + sq, b = seq >> 5, hd = seq & 31;
        const size_t rowbase = (size_t)b * SEQ; const int cb = hd * 64 + 4 * pq;
        const f32x4 kkc = *(const f32x4*)(k_k + cb), kac = *(const f32x4*)(k_a + cb), rkc = *(const f32x4*)(r_k + cb), gwc = *(const f32x4*)(gn_w + cb), gbc = *(const f32x4*)(gn_b + cb);
        f32x4 st[4]; bf16x8 sb[2];
#pragma unroll
        for (int kb = 0; kb < 4; ++kb) st[kb] = (f32x4){0.f, 0.f, 0.f, 0.f};
        sb[0] = (bf16x8){0, 0, 0, 0, 0, 0, 0, 0}; sb[1] = sb[0];
        __syncthreads();
        u32x2 pr_r, pr_k, pr_v, pr_a, pg_g = {0u, 0u};
        unsigned short pw0, pw1, pw2, pw3;
        const size_t wofs = (size_t)hd * 64 + lane;
#define RW_LWLOAD(blk) do { const bf16* p_ = LWb + (rowbase + (size_t)(blk) * RW_T + 4 * wq) * DM + wofs; pw0 = p_[0]; pw1 = p_[DM]; pw2 = p_[2 * DM]; pw3 = p_[3 * DM]; } while (0)
#define RW_LWSCAN(stage) do { LAS float* q_ = (LAS float*)(base + RW_OFF_LWS + (stage) * 4096) + (4 * wq) * 64 + lane; const float c0_ = bf2f(pw0), c1_ = c0_ + bf2f(pw1), c2_ = c1_ + bf2f(pw2), c3_ = c2_ + bf2f(pw3); \
            q_[0] = c0_; q_[64] = c1_; q_[128] = c2_; q_[192] = c3_; } while (0)
        { const size_t o = (rowbase + pt) * DM + cb; pr_r = *(const GAS u32x2*)(Rb + o); pr_k = *(const GAS u32x2*)(Kb + o); pr_v = *(const GAS u32x2*)(Vb + o); pr_a = *(const GAS u32x2*)(Ab + o); }
        RW_LWLOAD(0);
        RW_LWSCAN(0);
        __syncthreads();
        for (int it = 0; it < NB + 3; ++it) {
            if (it < NB) {
                LAS unsigned char* OPS = base + RW_OFF_OPS + (it % 3) * RW_OPS;
                LAS unsigned char* VV = base + RW_OFF_VV + (it & 3) * RW_MAT;
                const f32x4 r = {bflo(pr_r.x), bfhi(pr_r.x), bflo(pr_r.y), bfhi(pr_r.y)}, k = {bflo(pr_k.x), bfhi(pr_k.x), bflo(pr_k.y), bfhi(pr_k.y)};
                const f32x4 a = {bflo(pr_a.x), bfhi(pr_a.x), bflo(pr_a.y), bfhi(pr_a.y)};
                const LAS float* lws = (const LAS float*)(base + RW_OFF_LWS + (it & 1) * 4096) + 4 * pq;
                f32x4 tot = {0.f, 0.f, 0.f, 0.f};
                for (int w2 = 0; w2 < wq; ++w2) tot += *(const LAS f32x4*)(lws + (4 * w2 + 3) * 64);
                const f32x4 cum = tot + *(const LAS f32x4*)(lws + pt * 64);
                f32x4 cprev = tot; if (pt & 3) cprev += *(const LAS f32x4*)(lws + (pt - 1) * 64);
                const f32x4 Pp = {__builtin_amdgcn_exp2f(cprev.x), __builtin_amdgcn_exp2f(cprev.y), __builtin_amdgcn_exp2f(cprev.z), __builtin_amdgcn_exp2f(cprev.w)};
                const f32x4 P = {__builtin_amdgcn_exp2f(cum.x), __builtin_amdgcn_exp2f(cum.y), __builtin_amdgcn_exp2f(cum.z), __builtin_amdgcn_exp2f(cum.w)};
                const f32x4 iP = {__builtin_amdgcn_exp2f(-cum.x), __builtin_amdgcn_exp2f(-cum.y), __builtin_amdgcn_exp2f(-cum.z), __builtin_amdgcn_exp2f(-cum.w)};
                const f32x4 kkv = k * kkc;
                const f32x4 kp = k * (1.0f + (a - 1.0f) * kac);
                const f32x4 rk = r * kp * rkc;
                float ss = (kkv.x * kkv.x + kkv.y * kkv.y) + (kkv.z * kkv.z + kkv.w * kkv.w), bon = (rk.x + rk.y) + (rk.z + rk.w);
                red16x2(ss, bon);
                const f32x4 kkn = kkv * __builtin_amdgcn_rcpf(fmaxf(__builtin_amdgcn_sqrtf(ss), 1e-12f));
                const f32x4 al = Pp * kkn, nb = -(kkn * a) * iP, ka = kp * iP, rh = P * r;
                const int mo = rw_tau(pt) * RW_MS + pq * 8;
                u32x2 w2;
                w2.x = pkbf(al.x, al.y); w2.y = pkbf(al.z, al.w); *(LAS u32x2*)(OPS + RW_O_AL + mo) = w2;
                w2.x = pkbf(nb.x, nb.y); w2.y = pkbf(nb.z, nb.w); *(LAS u32x2*)(OPS + RW_O_NB + mo) = w2;
                w2.x = pkbf(ka.x, ka.y); w2.y = pkbf(ka.z, ka.w); *(LAS u32x2*)(OPS + RW_O_KA + mo) = w2;
                w2.x = pkbf(rh.x, rh.y); w2.y = pkbf(rh.z, rh.w); *(LAS u32x2*)(OPS + RW_O_RH + mo) = w2;
                *(LAS u32x2*)(VV + mo) = pr_v;
                if (pt == 15) *(LAS f32x4*)(OPS + RW_O_PL + pq * 16) = P;
                if (pq == 0) *(LAS float*)(base + RW_OFF_BON + (it & 3) * 64 + pt * 4) = bon;
            }
            if (it + 1 < NB) { const size_t o = (rowbase + (it + 1) * RW_T + pt) * DM + cb; pr_r = *(const GAS u32x2*)(Rb + o); pr_k = *(const GAS u32x2*)(Kb + o); pr_v = *(const GAS u32x2*)(Vb + o); pr_a = *(const GAS u32x2*)(Ab + o); RW_LWLOAD(it + 1); }
            if (it >= 3) pg_g = *(const GAS u32x2*)(Gb + (rowbase + (it - 3) * RW_T + pt) * DM + cb);
            if (it >= 1 && it <= NB) {
                const int bi = it - 1;
                const LAS unsigned char* OPS = base + RW_OFF_OPS + (bi % 3) * RW_OPS;
                LAS unsigned char* GR = base + RW_OFF_GR + (bi & 1) * RW_GRS;
                const LAS unsigned char* X = OPS + ((wq & 1) ? RW_O_KA : RW_O_NB) + l15 * RW_MS + g * 16;
                const LAS unsigned char* Yt = OPS + ((wq & 2) ? RW_O_RH : RW_O_AL) + l15 * RW_MS + g * 16;
                f32x4 acc = {0.f, 0.f, 0.f, 0.f};
#pragma unroll
                for (int m = 0; m < 2; ++m) acc = __builtin_amdgcn_mfma_f32_16x16x32_bf16(*(const LAS bf16x8*)(X + m * 64), *(const LAS bf16x8*)(Yt + m * 64), acc, 0, 0, 0);
                const int tt = rw_tau(l15);
#pragma unroll
                for (int r = 0; r < 4; ++r) { const int ts = 4 * r + g; const bool keep = (wq & 2) ? (ts <= tt) : (ts < tt); acc[r] = keep ? acc[r] : 0.f; }
                if (wq == 0) {
                    LAS float* GT = (LAS float*)GR;
#pragma unroll
                    for (int r = 0; r < 4; ++r) GT[tt * 16 + 4 * r + g] = acc[r];
                    const int t = l15, B = g;
                    const f32x4 g4 = *(const LAS f32x4*)(GT + t * 16 + 4 * B);
                    const f32x4 r1 = *(const LAS f32x4*)(GT + (4 * B + 1) * 16 + 4 * B), r2 = *(const LAS f32x4*)(GT + (4 * B + 2) * 16 + 4 * B), r3 = *(const LAS f32x4*)(GT + (4 * B + 3) * 16 + 4 * B);
                    const float N10 = r1.x, N21 = r2.y, N32 = r3.z, N20 = fmaf(r2.y, N10, r2.x), N31 = fmaf(r3.z, N21, r3.y), N30 = fmaf(r3.z, N20, fmaf(r3.y, N10, r3.x));
                    const int i = t - 4 * B;
                    f32x4 E;
                    if (i >= 4) { E.x = fmaf(g4.w, N30, fmaf(g4.z, N20, fmaf(g4.y, N10, g4.x))); E.y = fmaf(g4.w, N31, fmaf(g4.z, N21, g4.y)); E.z = fmaf(g4.w, N32, g4.z); E.w = g4.w; }
                    else { E.x = i == 1 ? N10 : i == 2 ? N20 : i == 3 ? N30 : 0.f; E.y = i == 2 ? N21 : i == 3 ? N31 : 0.f; E.z = i == 3 ? N32 : 0.f; E.w = 0.f; }
                    *(LAS f32x4*)(GR + 2560 + B * 256 + rw_tau(t) * 16) = E;
                }
                else { u32x2 w2; w2.x = pkbf(acc.x, acc.y); w2.y = pkbf(acc.z, acc.w); *(LAS u32x2*)(GR + 1024 + (wq - 1) * 512 + l15 * 32 + g * 8) = w2; }
            }
            if (it >= 2 && it <= NB + 1) {
                const int bi = it - 2;
                const LAS unsigned char* OPS = base + RW_OFF_OPS + (bi % 3) * RW_OPS;
                const LAS unsigned char* VV = base + RW_OFF_VV + (bi & 3) * RW_MAT;
                const LAS unsigned char* GR = base + RW_OFF_GR + (bi & 1) * RW_GRS;
                LAS float* YB = (LAS float*)(base + RW_OFF_YB + (bi & 1) * 4096);
                const v4i16_t vq = ldtr(VV + (4 * g + q4) * RW_MS + (16 * wq + 4 * p4) * 2);
                const v4i16_t zq0 = {0, 0, 0, 0};
                f32x4 racc = {0.f, 0.f, 0.f, 0.f};
#pragma unroll
                for (int m = 0; m < 2; ++m) { const LAS unsigned char* ap = OPS + RW_O_AL + l15 * RW_MS + m * 64 + g * 8;
                    const u32x2 lo = *(const LAS u32x2*)ap, hh = *(const LAS u32x2*)(ap + 32); const u32x4 aw = {lo.x, lo.y, hh.x, hh.y};
                    racc = __builtin_amdgcn_mfma_f32_16x16x32_bf16(__builtin_bit_cast(bf16x8, aw), sb[m], racc, 0, 0, 0); }
                { const v4i16_t b1 = *(const LAS v4i16_t*)(GR + 1024 + 0 * 512 + l15 * 32 + g * 8);
                  racc = __builtin_amdgcn_mfma_f32_16x16x32_bf16(mk8(zq0, b1), mk8(zq0, vq), racc, 0, 0, 0); }
#pragma unroll
                for (int B = 0; B < 4; ++B) { const float e = *(const LAS float*)(GR + 2560 + B * 256 + l15 * 16 + g * 4);
                    racc = __builtin_amdgcn_mfma_f32_16x16x4f32(e, racc[B], racc, 0, 0, 0); }
                u32x2 zw; zw.x = pkbf(racc[0], racc[1]); zw.y = pkbf(racc[2], racc[3]);
                const bf16x8 zv = mk8(__builtin_bit_cast(v4i16_t, zw), vq);
                f32x4 yacc = {0.f, 0.f, 0.f, 0.f};
#pragma unroll
                for (int m = 0; m < 2; ++m) { const LAS unsigned char* ap = OPS + RW_O_RH + l15 * RW_MS + m * 64 + g * 8;
                    const u32x2 lo = *(const LAS u32x2*)ap, hh = *(const LAS u32x2*)(ap + 32); const u32x4 aw = {lo.x, lo.y, hh.x, hh.y};
                    yacc = __builtin_amdgcn_mfma_f32_16x16x32_bf16(__builtin_bit_cast(bf16x8, aw), sb[m], yacc, 0, 0, 0); }
                { const v4i16_t a2 = *(const LAS v4i16_t*)(GR + 1024 + 1 * 512 + l15 * 32 + g * 8), b2 = *(const LAS v4i16_t*)(GR + 1024 + 2 * 512 + l15 * 32 + g * 8);
                  yacc = __builtin_amdgcn_mfma_f32_16x16x32_bf16(mk8(a2, b2), zv, yacc, 0, 0, 0); }
#pragma unroll
                for (int r = 0; r < 4; ++r) YB[(4 * r + g) * 64 + 16 * wq + l15] = yacc[r];
                const LAS unsigned char* ua = OPS + RW_O_NB + (4 * g + q4) * RW_MS + 4 * p4 * 2;
#pragma unroll
                for (int kb = 0; kb < 4; ++kb) {
                    const v4i16_t lo = ldtr(ua + kb * 32), hh = ldtr(ua + (RW_O_KA - RW_O_NB) + kb * 32);
                    const f32x4 d = __builtin_amdgcn_mfma_f32_16x16x32_bf16(mk8(lo, hh), zv, st[kb], 0, 0, 0);
                    st[kb] = d * *(const LAS f32x4*)(OPS + RW_O_PL + (16 * kb + 4 * g) * 4);
                }
#pragma unroll
                for (int m = 0; m < 2; ++m) sb[m] = pack8(st[2 * m][0], st[2 * m][1], st[2 * m][2], st[2 * m][3], st[2 * m + 1][0], st[2 * m + 1][1], st[2 * m + 1][2], st[2 * m + 1][3]);
            }
            if (it >= 3) {
                const int bi = it - 3;
                const LAS float* YB = (const LAS float*)(base + RW_OFF_YB + (bi & 1) * 4096);
                const u32x2 vw = *(const LAS u32x2*)(base + RW_OFF_VV + (bi & 3) * RW_MAT + rw_tau(pt) * RW_MS + pq * 8);
                const f32x4 v = {bflo(vw.x), bfhi(vw.x), bflo(vw.y), bfhi(vw.y)};
                const float bon = *(const LAS float*)(base + RW_OFF_BON + (bi & 3) * 64 + pt * 4);
                const size_t o = (rowbase + bi * RW_T + pt) * DM + cb;
                const u32x2 gg = pg_g;
                const f32x4 y = *(const LAS f32x4*)(YB + pt * 64 + 4 * pq);
                float s1 = (y.x + y.y) + (y.z + y.w), s2 = (y.x * y.x + y.y * y.y) + (y.z * y.z + y.w * y.w);
                red16x2(s1, s2);
                const float mu = s1 * (1.0f / 64.0f);
                const f32x4 d = y - mu;
                const float var = fmaxf(s2 * (1.0f / 64.0f) - mu * mu, 0.f);
                const f32x4 oo = d * __builtin_amdgcn_rsqf(var + GN_EPS) * gwc + gbc + bon * v;
                u32x2 w; w.x = pkbf(oo.x * siluf(bflo(gg.x)), oo.y * siluf(bfhi(gg.x))); w.y = pkbf(oo.z * siluf(bflo(gg.y)), oo.w * siluf(bfhi(gg.y)));
                *(GAS u32x2*)(out + o) = w;
            }
            if (it + 1 < NB) RW_LWSCAN((it + 1) & 1);
            __syncthreads();
        }
    }
#undef RW_LWSCAN
#undef RW_LWLOAD
}

typedef float f32x4v __attribute__((ext_vector_type(4)));
typedef float f32x2v __attribute__((ext_vector_type(2)));
__device__ __forceinline__ int sw_off(int row, int chunk) { return row * 256 + ((chunk ^ (row & 15)) << 4); }
constexpr int ML_QS = 0, ML_KS = 32768, ML_VS = 65536, ML_SW = 98304;
constexpr int ML_GA2 = MISC_OFF + 256, ML_GM2 = ML_GA2 + 512, ML_GBL = ML_GM2 + 512, ML_DEN = ML_GBL + 512, ML_NQ = ML_DEN + 512, ML_NV = ML_NQ + 512, ML_WSV = ML_NV + 512, ML_SC = ML_WSV + 512;
static_assert(ML_SC + 64 <= LDS_BYTES, "mlstm LDS");
constexpr int ML_SSQ = MISC_OFF + 4096, ML_RSTD = MISC_OFF + 6144;
static_assert(ML_SC + 64 <= ML_SSQ && ML_RSTD + 512 <= LDS_BYTES, "mlstm LDS (fused head norm)");
__device__ __forceinline__ void phase_mlstm(Frame& F, const bf16* proj, const float* GXp, const float* b_i, const float* b_f, bf16* hs, const float* h_gain, bf16* out, float* xch, unsigned* flags) {
    const int lane0 = F.lane, wave = F.wave;
    LAS unsigned char* L = F.lds;
#define ML_LANES() int lane = lane0; asm volatile("" : "+v"(lane)); const int tid = wave * 64 + lane, l15 = lane & 15, g = lane >> 4, q4 = l15 >> 2, p4 = lane & 3; (void)tid; (void)q4; (void)p4; (void)l15; (void)g
    LAS float* GA2 = (LAS float*)(L + ML_GA2); LAS float* GM2 = (LAS float*)(L + ML_GM2); LAS float* GBL = (LAS float*)(L + ML_GBL); LAS float* DEN = (LAS float*)(L + ML_DEN);
    LAS float* NQ = (LAS float*)(L + ML_NQ); LAS float* NV = (LAS float*)(L + ML_NV); LAS float* WSV = (LAS float*)(L + ML_WSV); LAS float* SC = (LAS float*)(L + ML_SC);
    constexpr float LOG2SC = -3.5f;
    LAS float* SSQ = (LAS float*)(L + ML_SSQ); LAS float* RSTD = (LAS float*)(L + ML_RSTD);
    for (int item = F.vcu; item < BATCH * 8 * 2; item += F.G) {
        const int b = item >> 4, h = (item >> 1) & 7, vh = item & 1;
        const size_t rowbase = (size_t)b * SEQ;
        const float bi = b_i[h], bfv = b_f[h];
        f32x4v st[8], nst;
#pragma unroll
        for (int kb = 0; kb < 8; ++kb) st[kb] = (f32x4v){0.f, 0.f, 0.f, 0.f};
        nst = (f32x4v){0.f, 0.f, 0.f, 0.f};
        __syncthreads();
        { ML_LANES(); if (tid < 128) NV[tid] = 0.f;
          if (tid == 0) { SC[0] = 0.f; SC[1] = 0.f; } }
        { ML_LANES(); SSQ[tid] = 0.f; }
        float* const xmine = xch + (size_t)item * 2048; const float* const xpart = xch + (size_t)(item ^ 1) * 2048;
        unsigned* const fmine = flags + item * 64; unsigned* const fpart = flags + (item ^ 1) * 64;
        u32x4 fh[4], fo[4], fg[4];
#define ML_FIN_LOAD(cf) do { ML_LANES(); const size_t r0_ = rowbase + (size_t)(cf) * 128; \
            _Pragma("unroll") for (int i = 0; i < 4; ++i) { const int idx = tid + 512 * i, row = idx >> 4, col = h * 256 + vh * 128 + (idx & 15) * 8; \
                fh[i] = *(const GAS u32x4*)(hs + (r0_ + row) * 2048 + col); fo[i] = *(const GAS u32x4*)(proj + (r0_ + row) * P2 + 4096 + col); fg[i] = *(const GAS u32x4*)(proj + (r0_ + row) * P2 + 6144 + col); } } while (0)
#define ML_FIN_DO(cf) do { ML_LANES(); const size_t r0_ = rowbase + (size_t)(cf) * 128; \
            _Pragma("unroll") for (int i = 0; i < 4; ++i) { const int idx = tid + 512 * i, row = idx >> 4, col = h * 256 + vh * 128 + (idx & 15) * 8; \
                const float rs_ = RSTD[row]; const f32x4 g0_ = *(const f32x4*)(h_gain + col), g1_ = *(const f32x4*)(h_gain + col + 4); u32x4 y_; \
                y_.x = pkbf(bflo(fh[i].x) * rs_ * g0_.x * sigmf(bflo(fo[i].x)) * siluf(bflo(fg[i].x)), bfhi(fh[i].x) * rs_ * g0_.y * sigmf(bfhi(fo[i].x)) * siluf(bfhi(fg[i].x))); \
                y_.y = pkbf(bflo(fh[i].y) * rs_ * g0_.z * sigmf(bflo(fo[i].y)) * siluf(bflo(fg[i].y)), bfhi(fh[i].y) * rs_ * g0_.w * sigmf(bfhi(fo[i].y)) * siluf(bfhi(fg[i].y))); \
                y_.z = pkbf(bflo(fh[i].z) * rs_ * g1_.x * sigmf(bflo(fo[i].z)) * siluf(bflo(fg[i].z)), bfhi(fh[i].z) * rs_ * g1_.y * sigmf(bfhi(fo[i].z)) * siluf(bfhi(fg[i].z))); \
                y_.w = pkbf(bflo(fh[i].w) * rs_ * g1_.z * sigmf(bflo(fo[i].w)) * siluf(bflo(fg[i].w)), bfhi(fh[i].w) * rs_ * g1_.w * sigmf(bfhi(fo[i].w)) * siluf(bfhi(fg[i].w))); \
                *(GAS u32x4*)(out + (r0_ + row) * 2048 + col) = y_; } } while (0)
#define ML_PUBLISH(cp) do { ML_LANES(); const f32x2v v_ = *(const LAS f32x2v*)(SSQ + ((cp) & 3) * 128 + 2 * lane); \
            __hip_atomic_store(xmine + (cp) * 128 + 2 * lane, v_.x, __ATOMIC_RELAXED, __HIP_MEMORY_SCOPE_AGENT); __hip_atomic_store(xmine + (cp) * 128 + 2 * lane + 1, v_.y, __ATOMIC_RELAXED, __HIP_MEMORY_SCOPE_AGENT); \
            asm volatile("s_waitcnt vmcnt(0)" ::: "memory"); \
            if (lane == 0) __hip_atomic_store(fmine, (unsigned)((cp) + 1), __ATOMIC_RELAXED, __HIP_MEMORY_SCOPE_AGENT); } while (0)
#define ML_RSTD(cf) do { ML_LANES(); int spins_ = 0; \
            while (__hip_atomic_load(fpart, __ATOMIC_RELAXED, __HIP_MEMORY_SCOPE_AGENT) < (unsigned)((cf) + 1) && ++spins_ < (1 << 22)) __builtin_amdgcn_s_sleep(2); \
            asm volatile("" ::: "memory"); \
            const float p0_ = __hip_atomic_load(xpart + (cf) * 128 + 2 * lane, __ATOMIC_RELAXED, __HIP_MEMORY_SCOPE_AGENT), p1_ = __hip_atomic_load(xpart + (cf) * 128 + 2 * lane + 1, __ATOMIC_RELAXED, __HIP_MEMORY_SCOPE_AGENT); \
            const f32x2v m_ = *(const LAS f32x2v*)(SSQ + ((cf) & 3) * 128 + 2 * lane); \
            RSTD[2 * lane] = __builtin_amdgcn_rsqf((m_.x + p0_) * (1.0f / 256.0f) + RMS_EPS); RSTD[2 * lane + 1] = __builtin_amdgcn_rsqf((m_.y + p1_) * (1.0f / 256.0f) + RMS_EPS); } while (0)
        u32x4 pfq[4], pfk[4], pfv[4];
#define ML_PREFETCH(cc) do { ML_LANES(); const bf16* qg_ = proj + (rowbase + (size_t)(cc) * 128) * P2 + h * 128; const bf16* vg_ = qg_ + 2048 + h * 128 + vh * 128; \
            _Pragma("unroll") for (int i = 0; i < 4; ++i) { const int idx = tid + 512 * i, row = idx >> 4, ch = idx & 15; \
                pfq[i] = *(const GAS u32x4*)(qg_ + (size_t)row * P2 + ch * 8); pfk[i] = *(const GAS u32x4*)(qg_ + (size_t)row * P2 + 1024 + ch * 8); pfv[i] = *(const GAS u32x4*)(vg_ + (size_t)row * P2 + ch * 8); } } while (0)
        ML_PREFETCH(0);
        float gpi0 = 0.f, gpi1 = 0.f, gpf0 = 0.f, gpf1 = 0.f;
        if (wave == 0) { ML_LANES(); const size_t rn = rowbase + 2 * lane; gpi0 = GXp[rn * 32 + h]; gpi1 = GXp[(rn + 1) * 32 + h]; gpf0 = GXp[rn * 32 + 8 + h]; gpf1 = GXp[(rn + 1) * 32 + 8 + h]; }
        for (int c = 0; c < 16; ++c) {
            const int par = c & 1;
            const size_t row0 = rowbase + (size_t)c * 128;
            {
                ML_LANES();
#pragma unroll
                for (int i = 0; i < 4; ++i) { const int idx = tid + 512 * i, row = idx >> 4, ch = idx & 15;
                    const int o = sw_off(row, ch);
                    *(LAS u32x4*)(L + ML_QS + o) = pfq[i]; *(LAS u32x4*)(L + ML_KS + o) = pfk[i]; *(LAS u32x4*)(L + ML_VS + o) = pfv[i]; }
            }
            if (c >= 2) ML_FIN_LOAD(c - 2);
            if (wave == 0) {
                ML_LANES();
                const int t0 = 2 * lane;
                const float i0 = gpi0 + bi, i1 = gpi1 + bi;
                const float f0 = logsigf(gpf0 + bfv), f1 = logsigf(gpf1 + bfv);
                if (c + 1 < 16) { const size_t rn = row0 + 128 + t0; gpi0 = GXp[rn * 32 + h]; gpi1 = GXp[(rn + 1) * 32 + h]; gpf0 = GXp[rn * 32 + 8 + h]; gpf1 = GXp[(rn + 1) * 32 + 8 + h]; }
                const float pr = f0 + f1; float incl = pr;
#pragma unroll
                for (int o = 1; o < 64; o <<= 1) { const float y = __shfl_up(incl, o); if (lane >= o) incl += y; }
                const float excl = incl - pr, b0 = excl + f0, b1 = excl + pr;
                const float a0 = i0 - b0, a1 = i1 - b1;
                float im = fmaxf(a0, a1);
#pragma unroll
                for (int o = 1; o < 64; o <<= 1) { const float y = __shfl_up(im, o); if (lane >= o) im = fmaxf(im, y); }
                float exm = __shfl_up(im, 1); if (lane == 0) exm = -INFINITY;
                const float mprev = SC[par];
                const float M0 = fmaxf(mprev, fmaxf(exm, a0)), M1 = fmaxf(mprev, im);
                const float M127 = __shfl(M1, 63), g127 = __shfl(b1, 63);
                GA2[t0] = a0 * LOG2E; GA2[t0 + 1] = a1 * LOG2E; GM2[t0] = M0 * LOG2E; GM2[t0 + 1] = M1 * LOG2E;
                GBL[t0] = (b0 + M0) * LOG2E; GBL[t0 + 1] = (b1 + M1) * LOG2E; DEN[t0] = 0.f; DEN[t0 + 1] = 0.f;
                WSV[t0] = __builtin_amdgcn_exp2f((a0 - M127) * LOG2E); WSV[t0 + 1] = __builtin_amdgcn_exp2f((a1 - M127) * LOG2E);
                if (lane == 0) { SC[par ^ 1] = g127 + M127; SC[2] = M127 * LOG2E; }
            }
            else if (wave == 1) { if (c >= 1) ML_PUBLISH(c - 1); { ML_LANES(); *(LAS f32x2v*)(SSQ + ((c + 1) & 3) * 128 + 2 * lane) = (f32x2v){0.f, 0.f}; } }
            else if (wave == 2) { if (c >= 2) ML_RSTD(c - 2); }
            __syncthreads();
            const float m2 = SC[par] * LOG2E, M2_127 = SC[2];
            {
            ML_LANES();
            for (int idx = wave; idx < 40; idx += 8) {
                int tb, bs; if (idx < 2) { tb = 0; bs = 0; } else if (idx < 4) { tb = 1; bs = 2; } else if (idx < 8) { tb = 2; bs = 4; } else if (idx < 12) { tb = 3; bs = 8; }
                else if (idx < 18) { tb = 4; bs = 12; } else if (idx < 24) { tb = 5; bs = 18; } else if (idx < 32) { tb = 6; bs = 24; } else { tb = 7; bs = 32; }
                const int sb = idx - bs;
                f32x4v acc = (f32x4v){0.f, 0.f, 0.f, 0.f};
                const int srow = 16 * sb + l15, trow = 16 * tb + l15;
#pragma unroll
                for (int ks = 0; ks < 4; ++ks) {
                    const bf16x8 af = *(const LAS bf16x8*)(L + ML_KS + sw_off(srow, 4 * ks + g)), bfr = *(const LAS bf16x8*)(L + ML_QS + sw_off(trow, 4 * ks + g));
                    acc = __builtin_amdgcn_mfma_f32_16x16x32_bf16(af, bfr, acc, 0, 0, 0); }
                const float M2t = GM2[trow]; const f32x4v a2 = *(const LAS f32x4v*)(GA2 + 16 * sb + 4 * g);
                float val[4];
#pragma unroll
                for (int r = 0; r < 4; ++r) { const int s = 16 * sb + 4 * g + r; const float w = (s <= trow) ? __builtin_amdgcn_exp2f(a2[r] - M2t + LOG2SC) : 0.f; val[r] = acc[r] * w; }
                float d = (val[0] + val[1]) + (val[2] + val[3]); d += __shfl_xor(d, 16); d += __shfl_xor(d, 32);
                if (g == 0) __hip_atomic_fetch_add(DEN + trow, d, __ATOMIC_RELAXED, __HIP_MEMORY_SCOPE_WORKGROUP);
                u32x2 pk; pk.x = pkbf(val[0], val[1]); pk.y = pkbf(val[2], val[3]);
                *(LAS u32x2*)(L + ML_SW + sw_off(trow, 2 * sb + (g >> 1)) + (g & 1) * 8) = pk;
            }
            {
                const int trow = 16 * wave + l15; float s = 0.f;
#pragma unroll
                for (int i = 0; i < 4; ++i) { const u32x4 qv = *(const LAS u32x4*)(L + ML_QS + sw_off(trow, 4 * g + i));
                    const f32x4v n0 = *(const LAS f32x4v*)(NV + 32 * g + 8 * i), n1 = *(const LAS f32x4v*)(NV + 32 * g + 8 * i + 4);
                    s += bflo(qv.x) * n0.x + bfhi(qv.x) * n0.y + bflo(qv.y) * n0.z + bfhi(qv.y) * n0.w + bflo(qv.z) * n1.x + bfhi(qv.z) * n1.y + bflo(qv.w) * n1.z + bfhi(qv.w) * n1.w; }
                s += __shfl_xor(s, 16); s += __shfl_xor(s, 32);
                if (g == 0) NQ[trow] = s;
            }
            }
            if (c >= 2) ML_FIN_DO(c - 2);
            __syncthreads();
            f32x4v num[8];
            {
                ML_LANES();
                bf16x8 cf[4];
#pragma unroll
                for (int kp = 0; kp < 4; ++kp) cf[kp] = pack8(st[2 * kp][0], st[2 * kp][1], st[2 * kp][2], st[2 * kp][3], st[2 * kp + 1][0], st[2 * kp + 1][1], st[2 * kp + 1][2], st[2 * kp + 1][3]);
#pragma unroll
                for (int tb = 0; tb < 8; ++tb) {
                    const int trow = 16 * tb + l15; f32x4v acc = (f32x4v){0.f, 0.f, 0.f, 0.f};
#pragma unroll
                    for (int kp = 0; kp < 4; ++kp) {
                        const u32x2 lo = *(const LAS u32x2*)(L + ML_QS + sw_off(trow, 4 * kp + (g >> 1)) + (g & 1) * 8), hh = *(const LAS u32x2*)(L + ML_QS + sw_off(trow, 4 * kp + 2 + (g >> 1)) + (g & 1) * 8);
                        const u32x4 bw = {lo.x, lo.y, hh.x, hh.y};
                        acc = __builtin_amdgcn_mfma_f32_16x16x32_bf16(cf[kp], __builtin_bit_cast(bf16x8, bw), acc, 0, 0, 0); }
                    const float wi = __builtin_amdgcn_exp2f(m2 - GM2[trow] + LOG2SC);
                    num[tb] = acc * wi;
                    asm volatile("" ::: "memory");
                }
            }
            bf16x8 vfr[4];
            {
            ML_LANES();
#pragma unroll
            for (int sc = 0; sc < 4; ++sc) {
                const int rA = 32 * sc + 8 * g + q4, rB = rA + 4;
                const v4i16_t lo = ldtr(L + ML_VS + sw_off(rA, 2 * wave + (p4 >> 1)) + (p4 & 1) * 8), hh = ldtr(L + ML_VS + sw_off(rB, 2 * wave + (p4 >> 1)) + (p4 & 1) * 8);
                vfr[sc] = mk8(lo, hh);
#pragma unroll
                for (int tb = 0; tb < 8; ++tb) if (tb >= 2 * sc) {
                    const int trow = 16 * tb + l15;
                    const bf16x8 bfr = *(const LAS bf16x8*)(L + ML_SW + sw_off(trow, 4 * sc + g));
                    num[tb] = __builtin_amdgcn_mfma_f32_16x16x32_bf16(vfr[sc], bfr, num[tb], 0, 0, 0); }
                asm volatile("" ::: "memory");
            }
            float hsq[8];
#pragma unroll
            for (int tb = 0; tb < 8; ++tb) {
                const int trow = 16 * tb + l15;
                const float den = __builtin_amdgcn_exp2f(m2 - GM2[trow] + LOG2SC) * NQ[trow] + DEN[trow];
                const float rd = 1.0f / fmaxf(fabsf(den), __builtin_amdgcn_exp2f(-GBL[trow]));
                const f32x4v hv = num[tb] * rd; u32x2 hw; hw.x = pkbf(hv.x, hv.y); hw.y = pkbf(hv.z, hv.w);
                *(GAS u32x2*)(hs + (row0 + trow) * 2048 + h * 256 + vh * 128 + 16 * wave + 4 * g) = hw;
                hsq[tb] = (hv.x * hv.x + hv.y * hv.y) + (hv.z * hv.z + hv.w * hv.w);
            }
#pragma unroll
            for (int tb = 0; tb < 8; ++tb) hsq[tb] += __shfl_xor(hsq[tb], 16);
#pragma unroll
            for (int tb = 0; tb < 8; ++tb) hsq[tb] += __shfl_xor(hsq[tb], 32);
            if (g == 0) {
#pragma unroll
                for (int tb = 0; tb < 8; ++tb) __hip_atomic_fetch_add(SSQ + (c & 3) * 128 + 16 * tb + l15, hsq[tb], __ATOMIC_RELAXED, __HIP_MEMORY_SCOPE_WORKGROUP);
            }
            }
            if (c + 1 < 16) ML_PREFETCH(c + 1);
            {
                ML_LANES();
                const float cs = __builtin_amdgcn_exp2f(m2 - M2_127);
#pragma unroll
                for (int sc = 0; sc < 4; ++sc) {
                    const f32x4v wa = *(const LAS f32x4v*)(WSV + 32 * sc + 8 * g), wb = *(const LAS f32x4v*)(WSV + 32 * sc + 8 * g + 4);
                    const u32x4 vw = __builtin_bit_cast(u32x4, vfr[sc]);
                    vfr[sc] = pack8(bflo(vw.x) * wa.x, bfhi(vw.x) * wa.y, bflo(vw.y) * wa.z, bfhi(vw.y) * wa.w, bflo(vw.z) * wb.x, bfhi(vw.z) * wb.y, bflo(vw.w) * wb.z, bfhi(vw.w) * wb.w);
                }
#pragma unroll
                for (int kb = 0; kb < 8; ++kb) {
                    f32x4v acc = st[kb] * cs;
#pragma unroll
                    for (int sc = 0; sc < 4; ++sc) {
                        const int rA = 32 * sc + 8 * g + q4, rB = rA + 4;
                        const v4i16_t lo = ldtr(L + ML_KS + sw_off(rA, 2 * kb + (p4 >> 1)) + (p4 & 1) * 8), hh = ldtr(L + ML_KS + sw_off(rB, 2 * kb + (p4 >> 1)) + (p4 & 1) * 8);
                        acc = __builtin_amdgcn_mfma_f32_16x16x32_bf16(mk8(lo, hh), vfr[sc], acc, 0, 0, 0);
                    }
                    st[kb] = acc;
                    asm volatile("" ::: "memory");
                }
                f32x4v nacc = nst * cs;
#pragma unroll
                for (int sc = 0; sc < 4; ++sc) {
                    const int rA = 32 * sc + 8 * g + q4, rB = rA + 4;
                    const v4i16_t lo = ldtr(L + ML_KS + sw_off(rA, 2 * wave + (p4 >> 1)) + (p4 & 1) * 8), hh = ldtr(L + ML_KS + sw_off(rB, 2 * wave + (p4 >> 1)) + (p4 & 1) * 8);
                    const f32x4v wa = *(const LAS f32x4v*)(WSV + 32 * sc + 8 * g), wb = *(const LAS f32x4v*)(WSV + 32 * sc + 8 * g + 4);
                    nacc = __builtin_amdgcn_mfma_f32_16x16x32_bf16(mk8(lo, hh), pack8(wa.x, wa.y, wa.z, wa.w, wb.x, wb.y, wb.z, wb.w), nacc, 0, 0, 0);
                }
                nst = nacc;
                if (l15 == 0) *(LAS f32x4v*)(NV + 16 * wave + 4 * g) = nst;
            }
            __syncthreads();
        }
        if (wave == 1) ML_PUBLISH(15); else if (wave == 2) ML_RSTD(14);
        ML_FIN_LOAD(14);
        __syncthreads();
        ML_FIN_DO(14);
        __syncthreads();
        if (wave == 2) ML_RSTD(15);
        ML_FIN_LOAD(15);
        __syncthreads();
        ML_FIN_DO(15);
    }
}
#undef ML_FIN_LOAD
#undef ML_FIN_DO
#undef ML_PUBLISH
#undef ML_RSTD
#undef ML_PREFETCH
#undef ML_LANES
__device__ __forceinline__ void phase_mlstm_post(Frame& F, const bf16* hs, const bf16* proj, const float* h_gain, bf16* out) {
    const int gw = F.vcu * NWAVES + F.wave, NGW = F.G * NWAVES;
    for (int m = gw; m < MROWS; m += NGW) {
        const GAS u32x2* xr = (const GAS u32x2*)(hs + (size_t)m * DM) + F.lane;
        const bf16* pr = proj + (size_t)m * P2;
        GAS unsigned long long* o8 = (GAS unsigned long long*)(out + (size_t)m * DM) + F.lane;
        u32x2 vw[8], ov[8], gv[8]; float ss[8];
#pragma unroll
        for (int j = 0; j < 8; ++j) { const int c = (F.lane + 64 * j) * 4; vw[j] = xr[64 * j]; ov[j] = *(const GAS u32x2*)(pr + 4096 + c); gv[j] = *(const GAS u32x2*)(pr + 6144 + c); }
#pragma unroll
        for (int j = 0; j < 8; ++j) { const float a = bflo(vw[j].x), b = bfhi(vw[j].x), c = bflo(vw[j].y), e = bfhi(vw[j].y); ss[j] = (a * a + b * b) + (c * c + e * e); }
#pragma unroll
        for (int o = 1; o < 64; o <<= 1)
#pragma unroll
            for (int j = 0; j < 8; ++j) ss[j] += __shfl_xor(ss[j], o);
#pragma unroll
        for (int j = 0; j < 8; ++j) {
            const float rstd = 1.0f / sqrtf(ss[j] * (1.0f / 256.0f) + RMS_EPS);
            const int c = (F.lane + 64 * j) * 4;
            const f32x4 hg = *(const f32x4*)(h_gain + c);
            const float y0 = bflo(vw[j].x) * rstd * hg.x * sigmf(bflo(ov[j].x)) * siluf(bflo(gv[j].x)), y1 = bfhi(vw[j].x) * rstd * hg.y * sigmf(bfhi(ov[j].x)) * siluf(bfhi(gv[j].x));
            const float y2 = bflo(vw[j].y) * rstd * hg.z * sigmf(bflo(ov[j].y)) * siluf(bflo(gv[j].y)), y3 = bfhi(vw[j].y) * rstd * hg.w * sigmf(bfhi(ov[j].y)) * siluf(bfhi(gv[j].y));
            o8[64 * j] = (unsigned long long)pkbf(y0, y1) | ((unsigned long long)pkbf(y2, y3) << 32);
        }
    }
}

constexpr int FX_KS = 0, FX_VS = 9216, FX_FB = 9216 + 8192, FX_BUF = 9216 + 8192 + 256;
__device__ __forceinline__ u32x4 fox_knorm(u32x4 kv, f32x4 g0, f32x4 g1) {
    float e[8] = {bflo(kv.x), bfhi(kv.x), bflo(kv.y), bfhi(kv.y), bflo(kv.z), bfhi(kv.z), bflo(kv.w), bfhi(kv.w)}; float ss = 0.f;
#pragma unroll
    for (int i = 0; i < 8; ++i) ss += e[i] * e[i];
    ss += __builtin_bit_cast(float, __builtin_amdgcn_mov_dpp(__builtin_bit_cast(int, ss), 0xB1, 0xf, 0xf, true));
    ss += __builtin_bit_cast(float, __builtin_amdgcn_mov_dpp(__builtin_bit_cast(int, ss), 0x4E, 0xf, 0xf, true));
    ss += __builtin_bit_cast(float, __builtin_amdgcn_mov_dpp(__builtin_bit_cast(int, ss), 0x141, 0xf, 0xf, true));
    const float r = __builtin_amdgcn_rsqf(ss * (1.0f / 64.0f) + RMS_EPS);
    u32x4 o; o.x = pkbf(e[0] * r * g0.x, e[1] * r * g0.y); o.y = pkbf(e[2] * r * g0.z, e[3] * r * g0.w); o.z = pkbf(e[4] * r * g1.x, e[5] * r * g1.y); o.w = pkbf(e[6] * r * g1.z, e[7] * r * g1.w); return o;
}
constexpr int FX_FL = 2 * FX_BUF;
__device__ __forceinline__ void phase_fox_attn(Frame& F, const bf16* proj, const float* GXp, const float* b_f, const float* q_gain, const float* k_gain, bf16* og, unsigned* qctr) {
    const int lane = F.lane, r32 = lane & 31, hi = lane >> 5, wave = F.wave, tid = F.tid;
    const int g16 = lane >> 4, q4 = (lane & 15) >> 2, p4 = lane & 3;
    LAS unsigned char* L = F.lds;
    const int srow = tid >> 3, sch = tid & 7;
    LAS float* KG = (LAS float*)(L + FX_FL + 8192 + 32768 + 256);
    if (tid < 64) KG[tid] = k_gain[tid];
#define kg0 (*(const LAS f32x4*)(KG + sch * 8))
#define kg1 (*(const LAS f32x4*)(KG + sch * 8 + 4))
    float gqm = fabsf(q_gain[lane]), gkm = fabsf(k_gain[lane]);
#pragma unroll
    for (int o = 1; o < 64; o <<= 1) { gqm = fmaxf(gqm, __shfl_xor(gqm, o)); gkm = fmaxf(gkm, __shfl_xor(gkm, o)); }
    const float QKB = 64.0f * gqm * gkm * (0.125f * LOG2E) * 1.03f;
    LAS unsigned* DN = (LAS unsigned*)(L + FX_FL + 8192 + 32768);
    LAS unsigned* QW = DN + 16;
    if (wave == 0 && lane < 32) { const float mine = b_f[lane]; int rank = 0;
        for (int o = 0; o < 32; ++o) { const float other = b_f[o]; rank += (other > mine || (other == mine && o < lane)) ? 1 : 0; }
        QW[1 + rank] = (unsigned)lane; }
    const int lane_o = lane;
    for (;;) {
        int lane = lane_o; asm volatile("" : "+v"(lane));
        const int r32 = lane & 31, hi = lane >> 5, tid = wave * 64 + lane, g16 = lane >> 4, q4 = (lane & 15) >> 2, p4 = lane & 3, srow = tid >> 3, sch = tid & 7;
        __syncthreads();
        if (tid == 0) QW[0] = __hip_atomic_fetch_add(qctr, 1u, __ATOMIC_RELAXED, __HIP_MEMORY_SCOPE_AGENT);
        __syncthreads();
        const unsigned unit = QW[0];
        if (unit >= (unsigned)(BATCH * 32)) break;
        const int h = (int)QW[1 + (unit >> 4)], b = (int)(unit & 15u), bh = b * 32 + h; (void)bh;
        const size_t rowbase = (size_t)b * SEQ;
        const LAS float* Fp = (const LAS float*)(L + FX_FL);
        if (wave == 0) {
            const float bf = b_f[h];
            const float* gp = GXp + (rowbase + lane * 32) * 32 + h;
            float acc[32]; float run = 0.f;
#pragma unroll
            for (int i = 0; i < 32; ++i) { run += logsigf(gp[i * 32] + bf); acc[i] = run; }
            float incl = run;
            int ln = lane; asm volatile("" : "+v"(ln));
#pragma unroll
            for (int o = 1; o < 64; o <<= 1) { const float y = __builtin_bit_cast(float, __builtin_amdgcn_ds_bpermute((ln - o) << 2, __builtin_bit_cast(int, incl))); if (ln >= o) incl += y; }
            const float excl = incl - run;
            LAS float* op = (LAS float*)(L + FX_FL) + lane * 32;
#pragma unroll
            for (int i = 0; i < 32; i += 4) *(LAS f32x4*)(op + i) = (f32x4){(acc[i] + excl) * LOG2E, (acc[i + 1] + excl) * LOG2E, (acc[i + 2] + excl) * LOG2E, (acc[i + 3] + excl) * LOG2E};
        }
        __syncthreads();
        const bf16* kbase = proj + rowbase * P3 + 2048 + h * 64 + sch * 8;
        u32x4 nq[4], nkv, nvv;
#define FX_PRELOAD(qbn) do { const size_t qr_ = rowbase + (qbn) * 256 + wave * 32 + r32; \
            _Pragma("unroll") for (int s4 = 0; s4 < 4; ++s4) nq[s4] = *(const GAS u32x4*)(proj + qr_ * P3 + h * 64 + s4 * 16 + hi * 8); \
            const size_t kr_ = (size_t)((4 * ((qbn) + 1) - 1) * 64 + srow) * P3; nkv = *(const GAS u32x4*)(kbase + kr_); nvv = *(const GAS u32x4*)(kbase + kr_ + 2048); } while (0)
        FX_PRELOAD(7);
        for (int qb = 7; qb >= 0; --qb) {
            const int q0 = qb * 256, NT = 4 * (qb + 1);
            bf16x8 qfr[4];
            {
                u32x4 qraw[4]; float ss = 0.f;
#pragma unroll
                for (int s4 = 0; s4 < 4; ++s4) { qraw[s4] = nq[s4];
#pragma unroll
                    for (int i = 0; i < 4; ++i) { const float a = bflo(qraw[s4][i]), c = bfhi(qraw[s4][i]); ss += a * a + c * c; } }
                ss += __shfl_xor(ss, 32);
                const float qsc = (0.125f * LOG2E) * __builtin_amdgcn_rsqf(ss * (1.0f / 64.0f) + RMS_EPS);
#pragma unroll
                for (int s4 = 0; s4 < 4; ++s4) { const f32x4 g0 = *(const f32x4*)(q_gain + s4 * 16 + hi * 8), g1 = *(const f32x4*)(q_gain + s4 * 16 + hi * 8 + 4);
                    qfr[s4] = pack8(bflo(qraw[s4].x) * qsc * g0.x, bfhi(qraw[s4].x) * qsc * g0.y, bflo(qraw[s4].y) * qsc * g0.z, bfhi(qraw[s4].y) * qsc * g0.w,
                                    bflo(qraw[s4].z) * qsc * g1.x, bfhi(qraw[s4].z) * qsc * g1.y, bflo(qraw[s4].w) * qsc * g1.z, bfhi(qraw[s4].w) * qsc * g1.w); }
            }
            const float Fref = Fp[q0];
            const int qpos = q0 + wave * 32 + r32;
            float mrun = -1e30f, lsum = 0.f;
            f32x16 O[2];
#pragma unroll
            for (int r = 0; r < 16; ++r) { O[0][r] = 0.f; O[1][r] = 0.f; }
            __syncthreads();
            {
                const u32x4 kv = nkv, vv = nvv;
                *(LAS u32x4*)(L + FX_KS + srow * 144 + sch * 16) = fox_knorm(kv, kg0, kg1);
                *(LAS u32x4*)(L + FX_VS + (sch >> 2) * 4096 + srow * 64 + (sch & 3) * 16) = vv;
                if (tid < 64) *(LAS float*)(L + FX_FB + tid * 4) = Fref - Fp[(NT - 1) * 64 + tid];
            }
            __syncthreads();
            bool wdone = false;
            u32x4 kvA = {0u, 0u, 0u, 0u}, vvA = {0u, 0u, 0u, 0u}, kvB = {0u, 0u, 0u, 0u}, vvB = {0u, 0u, 0u, 0u};
            { const size_t kr = (size_t)((NT - 2) * 64 + srow) * P3; kvA = *(const GAS u32x4*)(kbase + kr); vvA = *(const GAS u32x4*)(kbase + kr + 2048); }
            auto step = [&](const int tt, const u32x4& kvS, const u32x4& vvS, u32x4& kvL, u32x4& vvL) -> bool {
                const int t = NT - 1 - tt;
                LAS unsigned char* cur = L + (tt & 1) * FX_BUF; LAS unsigned char* nxt = L + ((tt + 1) & 1) * FX_BUF;
                if (tt + 2 < NT) { const size_t kr = (size_t)((t - 2) * 64 + srow) * P3; kvL = *(const GAS u32x4*)(kbase + kr); vvL = *(const GAS u32x4*)(kbase + kr + 2048); }
                const int k0 = t * 64;
                if (k0 <= q0 + wave * 32 + 31 && !wdone) {
                    f32x16 S[2];
                    const bool diag = (k0 + 63 > q0 + wave * 32);
                    {
                        bf16x8 kf[2][4];
#pragma unroll
                        for (int kb = 0; kb < 2; ++kb) { const LAS unsigned char* kp = cur + FX_KS + (32 * kb + r32) * 144 + hi * 16;
#pragma unroll
                            for (int s4 = 0; s4 < 4; ++s4) kf[kb][s4] = *(const LAS bf16x8*)(kp + s4 * 32); }
#pragma unroll
                        for (int kb = 0; kb < 2; ++kb)
#pragma unroll
                            for (int g4 = 0; g4 < 4; ++g4) { const f32x4 fbv = *(const LAS f32x4*)(cur + FX_FB + (32 * kb + 8 * g4 + 4 * hi) * 4);
                                S[kb][4 * g4 + 0] = fbv.x; S[kb][4 * g4 + 1] = fbv.y; S[kb][4 * g4 + 2] = fbv.z; S[kb][4 * g4 + 3] = fbv.w; }
                        __builtin_amdgcn_sched_barrier(0);
#pragma unroll
                        for (int s4 = 0; s4 < 4; ++s4) { S[0] = __builtin_amdgcn_mfma_f32_32x32x16_bf16(kf[0][s4], qfr[s4], S[0], 0, 0, 0); S[1] = __builtin_amdgcn_mfma_f32_32x32x16_bf16(kf[1][s4], qfr[s4], S[1], 0, 0, 0); }
                        __builtin_amdgcn_sched_barrier(0);
                        if (diag) {
#pragma unroll
                            for (int kb = 0; kb < 2; ++kb)
#pragma unroll
                                for (int r = 0; r < 16; ++r) { const int kpos = k0 + 32 * kb + crow(r, hi); S[kb][r] = (kpos <= qpos) ? S[kb][r] : -INFINITY; } }
                    }
                    float mx = fmaxf(S[0][0], S[1][0]);
#pragma unroll
                    for (int r = 1; r < 16; ++r) mx = fmaxf(mx, fmaxf(S[0][r], S[1][r]));
                    mx = fmaxf(mx, __shfl_xor(mx, 32));
                    if (__any(mx > mrun)) {
                        mx = fmaxf(mx, mrun);
                        const float alpha = __builtin_amdgcn_exp2f(mrun - mx);
                        mrun = mx; lsum *= alpha;
#pragma unroll
                        for (int r = 0; r < 16; ++r) { O[0][r] *= alpha; O[1][r] *= alpha; }
                    }
                    float ps = 0.f;
#pragma unroll
                    for (int r = 0; r < 16; ++r) { const float p0 = __builtin_amdgcn_exp2f(S[0][r] - mrun), p1 = __builtin_amdgcn_exp2f(S[1][r] - mrun); S[0][r] = p0; S[1][r] = p1; ps += p0 + p1; }
                    lsum += ps;
#pragma unroll
                    for (int kb = 0; kb < 2; ++kb)
#pragma unroll
                        for (int s2 = 0; s2 < 2; ++s2) {
                            const bf16x8 pf = pack8(S[kb][8 * s2 + 0], S[kb][8 * s2 + 1], S[kb][8 * s2 + 2], S[kb][8 * s2 + 3], S[kb][8 * s2 + 4], S[kb][8 * s2 + 5], S[kb][8 * s2 + 6], S[kb][8 * s2 + 7]);
#pragma unroll
                            for (int db = 0; db < 2; ++db) {
                                const LAS unsigned char* va = cur + FX_VS + db * 4096 + (32 * kb + 16 * s2 + 4 * (g16 >> 1) + q4) * 64 + (g16 & 1) * 32 + p4 * 8;
                                const v4i16_t lo = ldtr(va), hh = ldtr(va + 512);
                                O[db] = __builtin_amdgcn_mfma_f32_32x32x16_bf16(mk8(lo, hh), pf, O[db], 0, 0, 0);
                            }
                        }
                }
                if (tt + 1 < NT) {
                    *(LAS u32x4*)(nxt + FX_KS + srow * 144 + sch * 16) = fox_knorm(kvS, kg0, kg1);
                    *(LAS u32x4*)(nxt + FX_VS + (sch >> 2) * 4096 + srow * 64 + (sch & 3) * 16) = vvS;
                    if (tid < 64) *(LAS float*)(nxt + FX_FB + tid * 4) = Fref - Fp[(t - 1) * 64 + tid];
                    const float nb = Fref - Fp[(t - 1) * 64 + 63];
                    wdone = wdone || __all(nb + QKB <= mrun - 40.0f);
                    if (lane == 0) DN[(tt & 1) * 8 + wave] = wdone ? 1u : 0u;
                }
                __syncthreads();
                if (tt + 1 < NT) { const u32x4 d0 = *(const LAS u32x4*)(DN + (tt & 1) * 8), d1 = *(const LAS u32x4*)(DN + (tt & 1) * 8 + 4);
                    if ((d0.x & d0.y & d0.z & d0.w & d1.x & d1.y & d1.z & d1.w) != 0u) return true; }
                return false;
            };
            for (int tt = 0; tt < NT; tt += 2) {
                if (step(tt, kvA, vvA, kvB, vvB)) break;
                if (step(tt + 1, kvB, vvB, kvA, vvA)) break;
            }
            lsum += __shfl_xor(lsum, 32);
            const float rl = 1.0f / lsum;
            FX_PRELOAD(qb > 0 ? qb - 1 : 0);
            { const size_t row0 = rowbase + q0 + wave * 32;
              attn_epilogue(O, rl, proj + row0 * P3 + 6144 + h * 64, P3, og + row0 * 2048 + h * 64, L + FX_FL + 8192 + wave * 4096, lane); }
        }
#undef FX_PRELOAD
    }
#undef kg0
#undef kg1
}

#ifndef MK_SINGLE
#define MK_SINGLE 1
#endif
#ifndef MK_LAYERS
#define MK_LAYERS 4
#endif
#ifndef MK_DUP
#define MK_DUP 0
#endif
#ifndef MK_AMP
#define MK_AMP 1.0f
#endif
enum { I_X = 0, I_REL, I_SWA_NORM, I_SWA_WIN, I_SWA_QG, I_SWA_KG, I_SWA_SINK, I_SWA_WOUT,
       I_RW_NORM, I_RW_MIX, I_RW_WIN, I_RW_W0, I_RW_WL1, I_RW_WL2, I_RW_A0, I_RW_AL1, I_RW_AL2, I_RW_KK, I_RW_KA, I_RW_RK, I_RW_GNW, I_RW_GNB, I_RW_WOUT,
       I_ML_NORM, I_ML_WIN, I_ML_BI, I_ML_BF, I_ML_HG, I_ML_WOUT,
       I_FX_NORM, I_FX_WIN, I_FX_BF, I_FX_QG, I_FX_KG, I_FX_WOUT, N_IN };
struct Args { const float* in[N_IN]; float* out; unsigned char* ws; int ph_lo, ph_hi; };
constexpr int NPH_L0 = 4;
constexpr int NPH_L1 = 6;
constexpr int NPH_L2 = 4;
constexpr int NPH_L3 = 4;
constexpr int NPH = (MK_LAYERS >= 1 ? NPH_L0 : 0) + (MK_LAYERS >= 2 ? NPH_L1 : 0) + (MK_LAYERS >= 3 ? NPH_L2 : 0) + (MK_LAYERS >= 4 ? NPH_L3 : 0);

__global__ void __launch_bounds__(NWAVES * 64, 2) fwd(Args args) {
    extern __shared__ __attribute__((aligned(16))) unsigned char lds_raw[];
    Frame F;
    F.lds = (LAS unsigned char*)lds_raw;
    F.tid = threadIdx.x; F.lane = F.tid & 63; F.wave = __builtin_amdgcn_readfirstlane(F.tid >> 6);
    F.G = gridDim.x; { const int bx = blockIdx.x; F.vcu = (F.G % 8 == 0) ? (bx % 8) * (F.G / 8) + bx / 8 : bx; }
    F.cvi = F.vcu; F.cvn = F.G;
    unsigned char* ws = args.ws;
    gu32* ctl = (gu32*)(ws + WS_CTL);
    if (F.tid < 16) ((LAS unsigned*)(F.lds + MISC_OFF))[F.tid] = 0u;
    __syncthreads();
    const int lo = args.ph_lo, hi = args.ph_hi;
    XcdBarrier bar; bar.bar = (unsigned*)(ctl + CW_BAR); bar.x = 0; bar.st = nullptr;
    if (hi - lo > 1) bar = xcd_barrier_post((unsigned*)(ctl + CW_BAR), (volatile LAS unsigned*)(F.lds + MISC_OFF + 32));
#define IN(k) (lo <= (k) && (k) < hi)
#define SEAM(k) do { if (IN(k) && IN((k) + 1)) xcd_barrier(bar, F.wave); F.lane = fresh_lane(); F.tid = F.wave * 64 + F.lane; } while (0)
    bf16* const WB = (bf16*)(ws + WS_W); bf16* const WB3 = (bf16*)(ws + WS_W3);
    bf16* const S0 = (bf16*)(ws + WS_SLOT(0)); bf16* const S1 = (bf16*)(ws + WS_SLOT(1)); bf16* const S2 = (bf16*)(ws + WS_SLOT(2)); bf16* const S3 = (bf16*)(ws + WS_SLOT(3));
    bf16* const S4 = (bf16*)(ws + WS_SLOT(4)); bf16* const S5 = (bf16*)(ws + WS_SLOT(5)); bf16* const S6 = (bf16*)(ws + WS_SLOT(6));
    bf16* const L1B = (bf16*)(ws + WS_L1); float* const GX = (float*)(ws + WS_GX); float* const FB = (float*)(ws + WS_F); float* const RSB = (float*)(ws + WS_F + 2 * MiB);
    const float* const x_in = args.in[I_X]; float* const xo = args.out; bf16* const xb = (bf16*)args.out;
    int ph = 0;

    if (IN(ph)) {
        convert_matrix(F, args.in[I_SWA_WIN], 4608, 0, 2048, 4608, WB + W0_IN, 0);
        convert_matrix(F, args.in[I_SWA_WOUT], 2048, 0, 2048, 2048, WB + W0_OUT, 0);
        for (int rep = 0; rep < ((MK_DUP & 32) ? 2 : 1); ++rep) phase_norm<false>(F, x_in, args.in[I_SWA_NORM], S0);
    } SEAM(ph); ++ph;
    if (IN(ph)) {
        pg8::Gemm g{S0, WB + W0_IN, MROWS, 4608, 2048}; pg8::StaticOrder S; S.init(MROWS, 4608, F.G, (int)blockIdx.x);
        pg8::EpiStore E{S1, P0, 18, nullptr};
        for (int rep = 0; rep < ((MK_DUP & 16) ? 2 : 1); ++rep) pg8::gemm_phase<pg8::EpiStore, pg8::StaticOrder, false, true>(F.lds, g, S, E, F.wave);
    } SEAM(ph); ++ph;
    if (IN(ph)) { for (int rep = 0; rep < ((MK_DUP & 1) ? 2 : 1); ++rep) phase_swa(F, S1, args.in[I_SWA_QG], args.in[I_SWA_KG], args.in[I_SWA_SINK], args.in[I_REL], S0); } SEAM(ph); ++ph;
    if (IN(ph)) {
        pg8::Gemm g{S0, WB + W0_OUT, MROWS, 2048, 2048}; pg8::StaticOrder S; S.init(MROWS, 2048, F.G, (int)blockIdx.x);
        pg8::EpiResidX<false, true> E{x_in, xb, 2048};
        pg8::gemm_phase<pg8::EpiResidX<false, true>, pg8::StaticOrder, false, true>(F.lds, g, S, E, F.wave);
    } SEAM(ph); ++ph;

#if MK_LAYERS >= 2
    {
    const float* mix = args.in[I_RW_MIX];
    if (IN(ph)) {
        for (int c = 0; c < 4; ++c) convert_matrix(F, args.in[I_RW_WIN] + (size_t)c * 2048 * 2048, 2048, 0, 2048, 2048, WB + W1_IN + (size_t)c * 2048 * 2048, 0);
        convert_matrix(F, args.in[I_RW_WL1], 96, 0, 2048, 96, WB + W1_LA, 0);   zero_rows(F, WB + W1_LA, 2048, 96, 256);
        convert_matrix(F, args.in[I_RW_AL1], 96, 0, 2048, 96, WB + W1_LB, 128); zero_rows(F, WB + W1_LB, 2048, 0, 128); zero_rows(F, WB + W1_LB, 2048, 224, 256);
        convert_lora2(F, args.in[I_RW_WL2], args.in[I_RW_AL2], WB + W1_L2);
        convert_matrix(F, args.in[I_RW_WOUT], 2048, 0, 2048, 2048, WB + W1_OUT, 0);
        __syncthreads();
        phase_mix6(F, xb, args.in[I_RW_NORM], mix, S0, S1, S2, S3, S4, S5);
    } SEAM(ph); ++ph;
    if (IN(ph)) {
        { pg8::Gemm g{S4, WB + W1_LA, MROWS, 256, 2048}; pg8::StaticOrder S; S.init(MROWS, 256, F.G, (int)blockIdx.x); pg8::EpiLora1<0> E{L1B};
          pg8::gemm_phase<pg8::EpiLora1<0>, pg8::StaticOrder, false, true>(F.lds, g, S, E, F.wave); }
        { pg8::Gemm g{S5, WB + W1_LB, MROWS, 256, 2048}; pg8::StaticOrder S; S.init(MROWS, 256, F.G, (int)((blockIdx.x + F.G / 2) % F.G)); pg8::EpiLora1<1> E{L1B};
          pg8::gemm_phase<pg8::EpiLora1<1>, pg8::StaticOrder, false, true>(F.lds, g, S, E, F.wave); }
    } SEAM(ph); ++ph;
    if (IN(ph)) {
        { pg8::Gemm g{S0, WB + W1_IN, MROWS, 2048, 2048}; pg8::StaticOrder S; S.init(MROWS, 2048, F.G, (int)blockIdx.x); pg8::EpiStore E{S6, 2048, 8, nullptr};
          pg8::gemm_phase<pg8::EpiStore, pg8::StaticOrder, false, true>(F.lds, g, S, E, F.wave); }
        { pg8::Gemm g{S1, WB + W1_IN + (size_t)2048 * 2048, MROWS, 2048, 2048}; pg8::StaticOrder S; S.init(MROWS, 2048, F.G, (int)blockIdx.x); pg8::EpiStore E{S4, 2048, 8, nullptr};
          pg8::gemm_phase<pg8::EpiStore, pg8::StaticOrder, false, true>(F.lds, g, S, E, F.wave); }
        { pg8::Gemm g{S2, WB + W1_IN + (size_t)2 * 2048 * 2048, MROWS, 2048, 2048}; pg8::StaticOrder S; S.init(MROWS, 2048, F.G, (int)blockIdx.x); pg8::EpiStore E{S5, 2048, 8, nullptr};
          pg8::gemm_phase<pg8::EpiStore, pg8::StaticOrder, false, true>(F.lds, g, S, E, F.wave); }
    } SEAM(ph); ++ph;
    if (IN(ph)) {
        { pg8::Gemm g{L1B, WB + W1_L2, MROWS, 4096, 256}; pg8::StaticOrder S; S.init(MROWS, 4096, F.G, (int)blockIdx.x);
          pg8::EpiLora2 E{S0, S1, args.in[I_RW_W0], args.in[I_RW_A0]};
          pg8::gemm_phase<pg8::EpiLora2, pg8::StaticOrder, false, true>(F.lds, g, S, E, F.wave); }
        { pg8::Gemm g{S3, WB + W1_IN + (size_t)3 * 2048 * 2048, MROWS, 2048, 2048}; pg8::StaticOrder S; S.init(MROWS, 2048, F.G, (int)blockIdx.x); pg8::EpiStore E{S2, 2048, 8, nullptr};
          pg8::gemm_phase<pg8::EpiStore, pg8::StaticOrder, false, true>(F.lds, g, S, E, F.wave); }
    } SEAM(ph); ++ph;
    if (IN(ph)) { for (int rep = 0; rep < ((MK_DUP & 2) ? 2 : 1); ++rep) phase_rwkv(F, S6, S4, S5, S2, S0, S1, args.in[I_RW_KK], args.in[I_RW_KA], args.in[I_RW_RK], args.in[I_RW_GNW], args.in[I_RW_GNB], S3); } SEAM(ph); ++ph;
    if (IN(ph)) {
        pg8::Gemm g{S3, WB + W1_OUT, MROWS, 2048, 2048}; pg8::StaticOrder S; S.init(MROWS, 2048, F.G, (int)blockIdx.x);
        pg8::EpiResidX<true, true> E{xb, xb, 2048};
        pg8::gemm_phase<pg8::EpiResidX<true, true>, pg8::StaticOrder, false, true>(F.lds, g, S, E, F.wave);
    } SEAM(ph); ++ph;
    }
#endif

#if MK_LAYERS >= 3
    if (IN(ph)) {
        convert_matrix(F, args.in[I_ML_WIN], 8208, 0, 2048, 8192, WB + W2_IN, 0, args.in[I_ML_NORM]);
        convert_cols_small(F, args.in[I_ML_WIN], 8208, 8192, 2048, 16, WB + W2_IN, 8192, args.in[I_ML_NORM]); zero_rows(F, WB + W2_IN, 2048, 8208, 8448);
        convert_matrix(F, args.in[I_ML_WOUT], 2048, 0, 2048, 2048, WB + W2_OUT, 0);
        phase_rstd(F, xb, RSB);
    } SEAM(ph); ++ph;
    if (IN(ph)) {
        pg8::Gemm g{xb, WB + W2_IN, MROWS, 8448, 2048}; pg8::StaticOrder S; S.init(MROWS, 8448, F.G, (int)blockIdx.x);
        pg8::EpiStore E{S1, P2, 32, GX, RSB};
        pg8::gemm_phase<pg8::EpiStore, pg8::StaticOrder, false, true>(F.lds, g, S, E, F.wave);
        {
            const int rem = (int)(((size_t)(MROWS / 256) * (8448 / 256)) % (size_t)F.G), bx = (int)blockIdx.x;
            if (rem == 0 || bx >= rem) {
                F.lane = fresh_lane(); F.tid = F.wave * 64 + F.lane;
                F.cvi = rem == 0 ? bx : bx - rem; F.cvn = rem == 0 ? F.G : F.G - rem;
                convert_matrix(F, args.in[I_FX_WIN], 8224, 0, 2048, 8192, WB3 + W2_IN, 0, args.in[I_FX_NORM]);
                convert_cols_small(F, args.in[I_FX_WIN], 8224, 8192, 2048, 32, WB3 + W2_IN, 8192, args.in[I_FX_NORM]); zero_rows(F, WB3 + W2_IN, 2048, 8224, 8448);
                convert_matrix(F, args.in[I_FX_WOUT], 2048, 0, 2048, 2048, WB3 + W2_OUT, 0);
                F.cvi = F.vcu; F.cvn = F.G;
            }
        }
    } SEAM(ph); ++ph;
    if (IN(ph)) { phase_mlstm(F, S1, GX, args.in[I_ML_BI], args.in[I_ML_BF], S5, args.in[I_ML_HG], S0, FB, (unsigned*)(ctl + CW_MLF)); } SEAM(ph); ++ph;
    if (IN(ph)) {
        pg8::Gemm g{S0, WB + W2_OUT, MROWS, 2048, 2048}; pg8::StaticOrder S; S.init(MROWS, 2048, F.G, (int)blockIdx.x);
        pg8::EpiResidX<true, true> E{xb, S5, 2048};
        pg8::gemm_phase<pg8::EpiResidX<true, true>, pg8::StaticOrder, false, true>(F.lds, g, S, E, F.wave);
    } SEAM(ph); ++ph;
#endif

#if MK_LAYERS >= 4
    if (IN(ph)) {
#if MK_LAYERS < 3
#error "L3's weights are converted inside L2's projection phase"
#endif
        phase_rstd(F, S5, RSB);
    } SEAM(ph); ++ph;
    if (IN(ph)) {
        pg8::Gemm g{S5, WB3 + W2_IN, MROWS, 8448, 2048}; pg8::StaticOrder S; S.init(MROWS, 8448, F.G, (int)blockIdx.x);
        pg8::EpiStore E{S1, P3, 32, GX, RSB};
        pg8::gemm_phase<pg8::EpiStore, pg8::StaticOrder, false, true>(F.lds, g, S, E, F.wave);
    } SEAM(ph); ++ph;
    if (IN(ph)) { for (int rep = 0; rep < ((MK_DUP & 8) ? 2 : 1); ++rep) phase_fox_attn(F, S1, GX, args.in[I_FX_BF], args.in[I_FX_QG], args.in[I_FX_KG], S0, (unsigned*)(ctl + CW_QUEUE) + rep * 64); } SEAM(ph); ++ph;
    if (IN(ph)) {
        pg8::Gemm g{S0, WB3 + W2_OUT, MROWS, 2048, 2048}; pg8::StaticOrder S; S.init(MROWS, 2048, F.G, (int)blockIdx.x);
        pg8::EpiResidX<true, false> E{S5, xo, 2048};
        pg8::gemm_phase<pg8::EpiResidX<true, false>, pg8::StaticOrder, false, true>(F.lds, g, S, E, F.wave);
    } SEAM(ph); ++ph;
#endif
#undef IN
#undef SEAM
}

extern "C" void kernel_launch(void* const* d_in, const int* in_sizes, int n_in, void* d_out, int out_size, void* d_ws, size_t ws_size, hipStream_t stream) {
    static int grid = 0;
    if (grid == 0) {
        if (n_in != N_IN || out_size != MROWS * DM || ws_size < WS_END) { fprintf(stderr, "kernel_launch: unexpected shapes (n_in %d out %d ws %zu)\n", n_in, out_size, ws_size); grid = -1; return; }
        int dev = 0, cus = 0, per_cu = 0;
        if (hipGetDevice(&dev) != hipSuccess || hipDeviceGetAttribute(&cus, hipDeviceAttributeMultiprocessorCount, dev) != hipSuccess) { grid = -1; return; }
        if (hipFuncSetAttribute((const void*)fwd, hipFuncAttributeMaxDynamicSharedMemorySize, LDS_BYTES) != hipSuccess) { grid = -1; return; }
        if (hipOccupancyMaxActiveBlocksPerMultiprocessor(&per_cu, (const void*)fwd, NWAVES * 64, LDS_BYTES) != hipSuccess || per_cu < 1) per_cu = 1;
        (void)hipGetLastError();
        grid = cus & ~1;
    }
    if (grid < 0) return;
    (void)hipMemsetAsync((char*)d_ws + WS_CTL, 0, CTL_ZERO_BYTES, stream);
    Args a{};
    for (int i = 0; i < N_IN; ++i) a.in[i] = (const float*)d_in[i];
    a.out = (float*)d_out; a.ws = (unsigned char*)d_ws;
#if MK_SINGLE
    a.ph_lo = 0; a.ph_hi = NPH;
    hipLaunchKernelGGL(fwd, dim3(grid), dim3(NWAVES * 64), LDS_BYTES, stream, a);
#else
    for (int p = 0; p < NPH; ++p) { a.ph_lo = p; a.ph_hi = p + 1; hipLaunchKernelGGL(fwd, dim3(grid), dim3(NWAVES * 64), LDS_BYTES, stream, a); }
#endif
}
```

```cpp
#include <hip/hip_runtime.h>
#include <cstdio>
#include <cstdint>
__device__ __forceinline__ int fresh_lane() { int l; asm volatile("v_mbcnt_lo_u32_b32 %0, -1, 0\n\tv_mbcnt_hi_u32_b32 %0, -1, %0" : "=v"(l)); return l; }
namespace pg8 {
#define PG8_LAS __attribute__((address_space(3)))
typedef unsigned short bf16_t;
typedef short bf16x8 __attribute__((ext_vector_type(8)));
typedef float f32x4 __attribute__((ext_vector_type(4)));
typedef unsigned u32x4 __attribute__((ext_vector_type(4)));
constexpr int BM = 256, BK = 64, HALF = 128, HTB = HALF * BK * 2  , STAGE_BYTES = 8 * HTB, NXCD = 8, WGM = 8;

__host__ __device__ __forceinline__ int lds_byte(int r, int c) { const int st = (r >> 4) * 2 + (c >> 5), rr = r & 15, cc = c & 31, ob = rr * 64 + cc * 2; return st * 1024 + (ob ^ (((ob >> 9) & 1) << 5)); }
__host__ __device__ __forceinline__ void stage_rc(int b, int& R, int& C) { const int st = b / 1024, sb = b % 1024, swz = sb ^ (((sb >> 9) & 1) << 5); R = (st >> 1) * 16 + swz / 64; C = (st & 1) * 32 + (swz % 64) / 2; }
__host__ __device__ __forceinline__ int perm32(int rho) { const int n = rho >> 4, i = rho & 15; return 8 * (i >> 2) + 4 * n + (i & 3); }

struct Unit { int pm, pn; };
struct Gemm { const bf16_t* A; const bf16_t* Bt; int M, N, K; };

struct StaticOrder {
    int nM, nN, nwg, G, c;
    __host__ __device__ void init(int M, int N, int G_, int c_) { nM = M / BM; nN = N / BM; nwg = nM * nN; G = G_; c = c_; }
    __host__ __device__ bool next(int i, Unit& u) const {
        const long L = (long)i * G + c; if (L >= nwg) return false;
        int wgid = (int)L; { const int q = nwg / NXCD, r = nwg % NXCD, xcd = wgid % NXCD, off = wgid / NXCD; wgid = (xcd < r ? xcd * (q + 1) : r * (q + 1) + (xcd - r) * q) + off; }
        const int nig = WGM * nN, gid = wgid / nig, fm = gid * WGM, gsz = (nM - fm) < WGM ? (nM - fm) : WGM;
        u.pm = fm + ((wgid % nig) % gsz); u.pn = (wgid % nig) / gsz; return true;
    }
    __device__ __forceinline__ void a_ready(const Unit&) const {}
    __device__ __forceinline__ void done(const Unit&) const {}
};
__device__ __forceinline__ unsigned cvt_pk_bf16(float lo, float hi) { unsigned r; asm volatile("v_cvt_pk_bf16_f32 %0, %1, %2" : "=v"(r) : "v"(lo), "v"(hi)); return r; }
typedef float f32x2 __attribute__((ext_vector_type(2)));
struct EpiStore {
    static constexpr bool PERM = true, AFTER_DRAIN = false;
    bf16_t* O; int ldc; int n_main; float* X; const float* RS = nullptr;
    __device__ __forceinline__ void operator()(const f32x4 (&acc)[2][2][4][2], const Unit& u, int wr, int wc, int fr, int fq) const {
        const int row0 = u.pm * BM + wr * 64 + fr;
        float rsv[2][4];
#pragma unroll
        for (int ai = 0; ai < 2; ++ai)
#pragma unroll
            for (int m = 0; m < 4; ++m) rsv[ai][m] = RS ? RS[row0 + ai * HALF + m * 16] : 1.0f;
        if (u.pn < n_main) {
            const int col0 = u.pn * BM + wc * 32 + 8 * fq;
#pragma unroll
            for (int ai = 0; ai < 2; ++ai)
#pragma unroll
                for (int m = 0; m < 4; ++m) { bf16_t* rowp = O + (size_t)(row0 + ai * HALF + m * 16) * ldc + col0; const float rs = rsv[ai][m];
#pragma unroll
                    for (int bj = 0; bj < 2; ++bj) { const f32x4 v0 = acc[ai][bj][m][0] * rs, v1 = acc[ai][bj][m][1] * rs;
                        u32x4 w; w.x = cvt_pk_bf16(v0[0], v0[1]); w.y = cvt_pk_bf16(v0[2], v0[3]); w.z = cvt_pk_bf16(v1[0], v1[1]); w.w = cvt_pk_bf16(v1[2], v1[3]);
                        *(u32x4*)(rowp + bj * HALF) = w; } }
        } else if (wc == 0) {
#pragma unroll
            for (int ai = 0; ai < 2; ++ai)
#pragma unroll
                for (int m = 0; m < 4; ++m) { float* rp = X + (size_t)(row0 + ai * HALF + m * 16) * 32 + 8 * fq; const float rs = rsv[ai][m];
                    *(f32x4*)rp = acc[ai][0][m][0] * rs; *(f32x4*)(rp + 4) = acc[ai][0][m][1] * rs; }
        }
    }
};
template <int SEL> struct EpiLora1 {
    static constexpr bool PERM = true, AFTER_DRAIN = false;
    bf16_t* O;
    __device__ __forceinline__ void operator()(const f32x4 (&acc)[2][2][4][2], const Unit& u, int wr, int wc, int fr, int fq) const {
        const int row0 = u.pm * BM + wr * 64 + fr, col0 = SEL * HALF + wc * 32 + 8 * fq;
#pragma unroll
        for (int ai = 0; ai < 2; ++ai)
#pragma unroll
            for (int m = 0; m < 4; ++m) { bf16_t* rowp = O + (size_t)(row0 + ai * HALF + m * 16) * 256 + col0;
                f32x4 v0 = acc[ai][SEL][m][0], v1 = acc[ai][SEL][m][1];
                if (SEL == 0) {
#pragma unroll
                    for (int j = 0; j < 4; ++j) { v0[j] = tanhf(v0[j]); v1[j] = tanhf(v1[j]); } }
                u32x4 w; w.x = cvt_pk_bf16(v0[0], v0[1]); w.y = cvt_pk_bf16(v0[2], v0[3]); w.z = cvt_pk_bf16(v1[0], v1[1]); w.w = cvt_pk_bf16(v1[2], v1[3]);
                *(u32x4*)rowp = w; }
    }
};
struct EpiLora2 {
    static constexpr bool PERM = true, AFTER_DRAIN = false;
    bf16_t* LW; bf16_t* AA; const float* w0; const float* a0;
    __device__ __forceinline__ void operator()(const f32x4 (&acc)[2][2][4][2], const Unit& u, int wr, int wc, int fr, int fq) const {
        const int row0 = u.pm * BM + wr * 64 + fr;
        const bool isw = u.pn < 8;
        const int col0 = (isw ? u.pn : u.pn - 8) * BM + wc * 32 + 8 * fq;
        const float* bsrc = isw ? w0 : a0; bf16_t* dst = isw ? LW : AA;
        const f32x4 bv00 = *(const f32x4*)(bsrc + col0), bv01 = *(const f32x4*)(bsrc + col0 + 4), bv10 = *(const f32x4*)(bsrc + col0 + HALF), bv11 = *(const f32x4*)(bsrc + col0 + HALF + 4);
#pragma unroll
        for (int ai = 0; ai < 2; ++ai)
#pragma unroll
            for (int m = 0; m < 4; ++m) { bf16_t* rowp = dst + (size_t)(row0 + ai * HALF + m * 16) * 2048 + col0;
#pragma unroll
                for (int bj = 0; bj < 2; ++bj) { f32x4 v0 = acc[ai][bj][m][0] + (bj ? bv10 : bv00), v1 = acc[ai][bj][m][1] + (bj ? bv11 : bv01);
                    if (isw) {
#pragma unroll
                        for (int j = 0; j < 4; ++j) {
                            v0[j] = -0.875038775f * __builtin_amdgcn_rcpf(1.0f + __expf(-v0[j])); v1[j] = -0.875038775f * __builtin_amdgcn_rcpf(1.0f + __expf(-v1[j])); }
                    } else {
#pragma unroll
                        for (int j = 0; j < 4; ++j) { v0[j] = __builtin_amdgcn_rcpf(1.0f + __expf(-v0[j])); v1[j] = __builtin_amdgcn_rcpf(1.0f + __expf(-v1[j])); }
                    }
                    u32x4 w; w.x = cvt_pk_bf16(v0[0], v0[1]); w.y = cvt_pk_bf16(v0[2], v0[3]); w.z = cvt_pk_bf16(v1[0], v1[1]); w.w = cvt_pk_bf16(v1[2], v1[3]);
                    *(u32x4*)(rowp + bj * HALF) = w; } }
    }
};
struct EpiResid {
    static constexpr bool PERM = false, AFTER_DRAIN = false;
    const float* R; float* O; int ldc; float amp;
    __device__ __forceinline__ void operator()(const f32x4 (&acc)[2][2][4][2], const Unit& u, int wr, int wc, int fr, int fq) const {
        const int row0 = u.pm * BM + wr * 64 + fr, col0 = u.pn * BM + wc * 32 + 4 * fq;
        const float* __restrict__ Rr = R; float* __restrict__ Oo = O;
        f32x4 rv[2][4];
#define ER_LOAD(g, buf) do { const size_t off_ = (size_t)(row0 + ((g) >> 2) * HALF + ((g) & 3) * 16) * ldc + col0; \
            _Pragma("unroll") for (int bj = 0; bj < 2; ++bj) _Pragma("unroll") for (int n = 0; n < 2; ++n) rv[buf][bj * 2 + n] = *(const f32x4*)(Rr + off_ + bj * HALF + n * 16); } while (0)
        ER_LOAD(0, 0);
#pragma unroll
        for (int g = 0; g < 8; ++g) {
            if (g + 1 < 8) ER_LOAD(g + 1, (g + 1) & 1);
            const int ai = g >> 2, m = g & 3; const size_t off = (size_t)(row0 + ai * HALF + m * 16) * ldc + col0;
#pragma unroll
            for (int bj = 0; bj < 2; ++bj)
#pragma unroll
                for (int n = 0; n < 2; ++n) *(f32x4*)(Oo + off + bj * HALF + n * 16) = rv[g & 1][bj * 2 + n] + amp * acc[ai][bj][m][n];
        }
#undef ER_LOAD
    }
};
template <bool RBF, bool OBF> struct EpiResidX {
    static constexpr bool PERM = true, AFTER_DRAIN = false;
    const void* R; void* O; int ldc;
    __device__ __forceinline__ void operator()(const f32x4 (&acc)[2][2][4][2], const Unit& u, int wr, int wc, int fr, int fq) const {
        const int row0 = u.pm * BM + wr * 64 + fr, col0 = u.pn * BM + wc * 32 + 8 * fq;
        f32x4 rv[2][2][2];
#define ERX_LOAD(g, buf) do { const size_t off_ = (size_t)(row0 + ((g) >> 2) * HALF + ((g) & 3) * 16) * ldc + col0; \
            _Pragma("unroll") for (int bj = 0; bj < 2; ++bj) { \
                if constexpr (RBF) { const u32x4 w_ = *(const u32x4*)((const bf16_t*)R + off_ + bj * HALF); \
                    rv[buf][bj][0] = (f32x4){__builtin_bit_cast(float, w_.x << 16), __builtin_bit_cast(float, w_.x & 0xffff0000u), __builtin_bit_cast(float, w_.y << 16), __builtin_bit_cast(float, w_.y & 0xffff0000u)}; \
                    rv[buf][bj][1] = (f32x4){__builtin_bit_cast(float, w_.z << 16), __builtin_bit_cast(float, w_.z & 0xffff0000u), __builtin_bit_cast(float, w_.w << 16), __builtin_bit_cast(float, w_.w & 0xffff0000u)}; } \
                else { rv[buf][bj][0] = *(const f32x4*)((const float*)R + off_ + bj * HALF); rv[buf][bj][1] = *(const f32x4*)((const float*)R + off_ + bj * HALF + 4); } } } while (0)
        ERX_LOAD(0, 0);
#pragma unroll
        for (int g = 0; g < 8; ++g) {
            if (g + 1 < 8) ERX_LOAD(g + 1, (g + 1) & 1);
            const int ai = g >> 2, m = g & 3; const size_t off = (size_t)(row0 + ai * HALF + m * 16) * ldc + col0;
#pragma unroll
            for (int bj = 0; bj < 2; ++bj) { const f32x4 v0 = rv[g & 1][bj][0] + acc[ai][bj][m][0], v1 = rv[g & 1][bj][1] + acc[ai][bj][m][1];
                if constexpr (OBF) { u32x4 w; w.x = cvt_pk_bf16(v0[0], v0[1]); w.y = cvt_pk_bf16(v0[2], v0[3]); w.z = cvt_pk_bf16(v1[0], v1[1]); w.w = cvt_pk_bf16(v1[2], v1[3]);
                    *(u32x4*)((bf16_t*)O + off + bj * HALF) = w; }
                else { *(f32x4*)((float*)O + off + bj * HALF) = v0; *(f32x4*)((float*)O + off + bj * HALF + 4) = v1; } }
        }
#undef ERX_LOAD
    }
};
template <class Epi, class Sched, bool ALIGN_EPI = false, bool SP2 = false>
__device__ __forceinline__ void gemm_phase(PG8_LAS unsigned char* lds, const Gemm g, const Sched& S, const Epi& E, const int wid) {
    const int lane = fresh_lane(), tid = wid * 64 + lane, wr = wid >> 2, wc = wid & 3, fr = lane & 15, fq = lane >> 4;
    const int K = g.K, nt = K / BK;
    unsigned voffA[2], voffB[2];
#pragma unroll
    for (int i = 0; i < 2; ++i) { int R, C; stage_rc(tid * 16 + i * 8192, R, C); const int Rb = Epi::PERM ? ((R & ~31) + perm32(R & 31)) : R;
        voffA[i] = (unsigned)(R * K + C) * 2u; voffB[i] = (unsigned)(Rb * K + C) * 2u; }
    const size_t kstep = (size_t)(BK * 2);
    const size_t hstep = (size_t)HALF * K * 2;
    const size_t tstep = 2 * hstep;
    const unsigned ldsw = (unsigned)wid * 1024u;
    const int aoff = lds_byte(wr * 64 + fr, fq * 8), boff = lds_byte(wc * 32 + fr, fq * 8);
#define PG8_SA(b, h) (((b) * 2 + (h)) * HTB)
#define PG8_SB(b, h) ((4 + (b) * 2 + (h)) * HTB)
#define PG8_STAGE(bufoff, gbase, voff) do { _Pragma("unroll") for (int _i = 0; _i < 2; ++_i) \
        __builtin_amdgcn_global_load_lds((const unsigned*)((const char*)(gbase) + (voff)[_i]), (PG8_LAS unsigned*)(lds + (bufoff) + ldsw + _i * 8192), 16, 0, 0); } while (0)
#define PG8_LDA(dst, b, h) do { _Pragma("unroll") for (int m = 0; m < 4; ++m) _Pragma("unroll") for (int k = 0; k < 2; ++k) dst[m][k] = *(const PG8_LAS bf16x8*)(lds + PG8_SA(b, h) + aoff + m * 2048 + k * 1024); } while (0)
#define PG8_LDB(dst, b, h) do { _Pragma("unroll") for (int n = 0; n < 2; ++n) _Pragma("unroll") for (int k = 0; k < 2; ++k) dst[n][k] = *(const PG8_LAS bf16x8*)(lds + PG8_SB(b, h) + boff + n * 2048 + k * 1024); } while (0)
#define PG8_MMA(ai, bj, At, Bt) do { __builtin_amdgcn_s_setprio(1); _Pragma("unroll") for (int m = 0; m < 4; ++m) _Pragma("unroll") for (int n = 0; n < 2; ++n) _Pragma("unroll") for (int k = 0; k < 2; ++k) \
        acc[ai][bj][m][n] = __builtin_amdgcn_mfma_f32_16x16x32_bf16(Bt[n][k], At[m][k], acc[ai][bj][m][n], 0, 0, 0); __builtin_amdgcn_s_setprio(0); } while (0)
#define PG8_WAIT_V(n) asm volatile("s_waitcnt vmcnt(" #n ")" ::: "memory")
#define PG8_WAIT_L(n) asm volatile("s_waitcnt lgkmcnt(" #n ")" ::: "memory")
#define PG8_BAR __builtin_amdgcn_s_barrier()
#define PG8_SCHED __builtin_amdgcn_sched_barrier(0)
    Unit cur, nxt; int ui = 0;
    if (!S.next(0, cur)) return;
    f32x4 acc[2][2][4][2];
#pragma unroll
    for (int a = 0; a < 2; ++a)
#pragma unroll
        for (int b = 0; b < 2; ++b)
#pragma unroll
            for (int m = 0; m < 4; ++m)
#pragma unroll
                for (int n = 0; n < 2; ++n) acc[a][b][m][n] = (f32x4){0.f, 0.f, 0.f, 0.f};
    bf16x8 At[4][2], B0[2][2], B1[2][2];
    const char* cA = (const char*)g.A + (size_t)cur.pm * tstep; const char* cB = (const char*)g.Bt + (size_t)cur.pn * tstep;
    S.a_ready(cur);
    if constexpr (SP2) {
        PG8_STAGE(PG8_SB(0, 0), cB, voffB); PG8_STAGE(PG8_SB(0, 1), cB + hstep, voffB); PG8_STAGE(PG8_SA(0, 0), cA, voffA); PG8_STAGE(PG8_SA(0, 1), cA + hstep, voffA);
        if (wr == 1) PG8_BAR;
        PG8_WAIT_V(2); PG8_BAR;
        PG8_STAGE(PG8_SB(1, 0), cB + kstep, voffB); PG8_STAGE(PG8_SA(1, 0), cA + kstep, voffA); PG8_STAGE(PG8_SB(1, 1), cB + hstep + kstep, voffB);
        PG8_WAIT_V(6); PG8_BAR;
    } else {
        PG8_STAGE(PG8_SB(0, 0), cB, voffB); PG8_STAGE(PG8_SA(0, 0), cA, voffA); PG8_STAGE(PG8_SB(0, 1), cB + hstep, voffB); PG8_STAGE(PG8_SA(0, 1), cA + hstep, voffA);
        if (wr == 1) PG8_BAR;
        PG8_WAIT_V(4); PG8_BAR;
        PG8_STAGE(PG8_SB(1, 0), cB + kstep, voffB); PG8_STAGE(PG8_SA(1, 0), cA + kstep, voffA); PG8_STAGE(PG8_SB(1, 1), cB + hstep + kstep, voffB);
        PG8_WAIT_V(6); PG8_BAR;
    }
    for (;;) {
        const bool has_next = S.next(ui + 1, nxt);
        const char* nA = has_next ? (const char*)g.A + (size_t)nxt.pm * tstep : cA; const char* nB = has_next ? (const char*)g.Bt + (size_t)nxt.pn * tstep : cB;
        for (int t = 0; t < nt; t += 2) {
            const bool last = (t == nt - 2);
            const char* a1 = cA + (size_t)(t + 1) * kstep;
            const char* a2 = last ? nA : cA + (size_t)(t + 2) * kstep; const char* b2 = last ? nB : cB + (size_t)(t + 2) * kstep;
            const char* a3 = a2 + kstep; const char* b3 = b2 + kstep;
            if (last && has_next) S.a_ready(nxt);
            if constexpr (SP2) {
            PG8_LDB(B0, 0, 0); PG8_LDB(B1, 0, 1); PG8_SCHED; PG8_LDA(At, 0, 0); PG8_STAGE(PG8_SA(1, 1), a1 + hstep, voffA);
            PG8_WAIT_V(8); PG8_WAIT_L(0); PG8_BAR; PG8_MMA(0, 0, At, B0); PG8_MMA(0, 1, At, B1); PG8_BAR; PG8_SCHED;
            PG8_LDA(At, 0, 1); PG8_STAGE(PG8_SB(0, 0), b2, voffB); PG8_STAGE(PG8_SB(0, 1), b2 + hstep, voffB); PG8_STAGE(PG8_SA(0, 0), a2, voffA);
            PG8_WAIT_V(8); PG8_WAIT_L(0); PG8_BAR; PG8_MMA(1, 0, At, B0); PG8_MMA(1, 1, At, B1); PG8_BAR; PG8_SCHED;
            PG8_LDB(B0, 1, 0); PG8_LDB(B1, 1, 1); PG8_SCHED; PG8_LDA(At, 1, 0); PG8_STAGE(PG8_SA(0, 1), a2 + hstep, voffA);
            PG8_WAIT_V(8); PG8_WAIT_L(0); PG8_BAR; PG8_MMA(0, 0, At, B0); PG8_MMA(0, 1, At, B1); PG8_BAR; PG8_SCHED;
            PG8_LDA(At, 1, 1); PG8_STAGE(PG8_SB(1, 0), b3, voffB); PG8_STAGE(PG8_SB(1, 1), b3 + hstep, voffB); PG8_STAGE(PG8_SA(1, 0), a3, voffA);
            PG8_WAIT_V(8); PG8_WAIT_L(0); PG8_BAR; PG8_MMA(1, 0, At, B0); PG8_MMA(1, 1, At, B1); PG8_BAR; PG8_SCHED;
            } else {
            PG8_LDB(B0, 0, 0); PG8_SCHED; PG8_LDA(At, 0, 0); PG8_STAGE(PG8_SA(1, 1), a1 + hstep, voffA);
            PG8_WAIT_L(8); PG8_BAR; PG8_WAIT_L(0); PG8_MMA(0, 0, At, B0); PG8_BAR; PG8_SCHED;
            PG8_LDB(B1, 0, 1); PG8_STAGE(PG8_SB(0, 0), b2, voffB);
            PG8_BAR; PG8_WAIT_L(0); PG8_MMA(0, 1, At, B1); PG8_BAR;
            PG8_LDA(At, 0, 1); PG8_STAGE(PG8_SA(0, 0), a2, voffA);
            PG8_BAR; PG8_WAIT_L(0); PG8_MMA(1, 0, At, B0); PG8_BAR; PG8_SCHED;
            PG8_STAGE(PG8_SB(0, 1), b2 + hstep, voffB);
            PG8_WAIT_V(6); PG8_BAR; PG8_MMA(1, 1, At, B1); PG8_BAR;
            PG8_LDB(B0, 1, 0); PG8_SCHED; PG8_LDA(At, 1, 0); PG8_STAGE(PG8_SA(0, 1), a2 + hstep, voffA);
            PG8_WAIT_L(8); PG8_BAR; PG8_WAIT_L(0); PG8_MMA(0, 0, At, B0); PG8_BAR; PG8_SCHED;
            PG8_LDB(B1, 1, 1); PG8_STAGE(PG8_SB(1, 0), b3, voffB);
            PG8_BAR; PG8_WAIT_L(0); PG8_MMA(0, 1, At, B1); PG8_BAR;
            PG8_LDA(At, 1, 1); PG8_STAGE(PG8_SA(1, 0), a3, voffA);
            PG8_BAR; PG8_WAIT_L(0); PG8_MMA(1, 0, At, B0); PG8_BAR; PG8_SCHED;
            PG8_STAGE(PG8_SB(1, 1), b3 + hstep, voffB);
            PG8_WAIT_V(6); PG8_BAR; PG8_MMA(1, 1, At, B1); PG8_BAR;
            }
        }
        if constexpr (ALIGN_EPI) { if (wr == 0) PG8_BAR; }
        if constexpr (!Epi::AFTER_DRAIN) { E(acc, cur, wr, wc, fr, fq); S.done(cur); }
        if (!has_next) break;
#pragma unroll
        for (int a = 0; a < 2; ++a)
#pragma unroll
            for (int b = 0; b < 2; ++b)
#pragma unroll
                for (int m = 0; m < 4; ++m)
#pragma unroll
                    for (int n = 0; n < 2; ++n) acc[a][b][m][n] = (f32x4){0.f, 0.f, 0.f, 0.f};
        cur = nxt; cA = nA; cB = nB; ++ui;
        if constexpr (ALIGN_EPI) { if (wr == 1) PG8_BAR; }
    }
    PG8_WAIT_V(0);
    if constexpr (!ALIGN_EPI) { if (wr == 0) PG8_BAR; }
    PG8_BAR;
    if constexpr (Epi::AFTER_DRAIN) { E.fused(acc, cur, wr, wc, fr, fq, lds, wid, lane); S.done(cur); }
#undef PG8_SA
#undef PG8_SB
#undef PG8_STAGE
#undef PG8_LDA
#undef PG8_LDB
#undef PG8_MMA
#undef PG8_WAIT_V
#undef PG8_WAIT_L
#undef PG8_BAR
#undef PG8_SCHED
}
}

#define GAS __attribute__((address_space(1)))
#define LAS __attribute__((address_space(3)))
typedef unsigned short bf16;
typedef unsigned v4u __attribute__((ext_vector_type(4)));
typedef float f32x4 __attribute__((ext_vector_type(4)));
typedef short bf16x8 __attribute__((ext_vector_type(8)));
typedef GAS unsigned gu32;
typedef GAS unsigned long long gu64;
#define RLX_AGENT __ATOMIC_RELAXED, __HIP_MEMORY_SCOPE_AGENT
#define LDS_WAIT() asm volatile("s_waitcnt lgkmcnt(0)" ::: "memory")
#define VM_WAIT() asm volatile("s_waitcnt vmcnt(0)" ::: "memory")
__device__ __forceinline__ unsigned long long rt() { return __builtin_amdgcn_s_memrealtime(); }
__device__ __forceinline__ unsigned f2bf(float f) { unsigned u = __builtin_bit_cast(unsigned, f); return (u + 0x7fffu + ((u >> 16) & 1u)) >> 16; }
__device__ __forceinline__ unsigned pk2(float lo, float hi) { return f2bf(lo) | (f2bf(hi) << 16); }
#define XB_TMO      128
#define XB_XCNT(j)  (256  + 64 * (j))
#define XB_XSUB(j)  (1280 + 64 * (j))
#define XB_XGEN(j)  (2304 + 64 * (j))
#define XB_TOP      3328
#define XB_TOPGEN   3392
#define XCD_BAR_WORDS 3456
#define XB_SPIN_CAP (1u << 18)

__device__ __forceinline__ unsigned xb_ld(unsigned* p)              { return __hip_atomic_load(p, __ATOMIC_RELAXED, __HIP_MEMORY_SCOPE_AGENT); }
__device__ __forceinline__ unsigned xb_add(unsigned* p, unsigned v) { return __hip_atomic_fetch_add(p, v, __ATOMIC_RELAXED, __HIP_MEMORY_SCOPE_AGENT); }
__device__ __forceinline__ unsigned xb_xcc_id() { return (unsigned)__builtin_amdgcn_s_getreg((3 << 11) | 20) & 0xFu; }
#define XB_SPIN(cond, bar) do { unsigned _sp = 0; while (cond) { __builtin_amdgcn_s_sleep(1); \
    if ((++_sp & 255u) == 0u) { if (xb_ld(&(bar)[XB_TMO])) break; if (_sp > XB_SPIN_CAP) { atomicAdd(&(bar)[XB_TMO], 1u); break; } } } } while (0)

struct XcdBarrier {
    unsigned* bar; unsigned x;
    volatile LAS unsigned* st;
};

__device__ __forceinline__ XcdBarrier xcd_barrier_post(unsigned* bar, volatile LAS unsigned* st) {
    XcdBarrier b; b.bar = bar; b.x = xb_xcc_id(); b.st = st;
    if (threadIdx.x == 0) (void)xb_add(&bar[XB_XCNT(b.x)], 1u);
    return b;
}
__device__ __forceinline__ void xcd_barrier_complete(unsigned* bar, unsigned x, unsigned& nloc, unsigned& nx) {
    const unsigned G = gridDim.x * gridDim.y * gridDim.z;
    unsigned sum, cnt, mine, sp = 0u;
    for (;;) {
        sum = 0u; cnt = 0u; mine = 0u;
#pragma unroll
        for (unsigned j = 0; j < 16; ++j) { const unsigned c = xb_ld(&bar[XB_XCNT(j)]); sum += c; cnt += (c > 0u) ? 1u : 0u; mine = (j == x) ? c : mine; }
        if (sum == G) break;
        __builtin_amdgcn_s_sleep(1);
        if ((++sp & 255u) == 0u) { if (xb_ld(&bar[XB_TMO])) break; if (sp > XB_SPIN_CAP) { atomicAdd(&bar[XB_TMO], 1u); break; } }
    }
    nloc = mine > 0u ? mine : 1u; nx = cnt > 0u ? cnt : 1u;
}

__device__ __forceinline__ void xcd_barrier(const XcdBarrier& b, const int wave_sgpr) {
    const bool xb_t0 = (wave_sgpr == 0) && (fresh_lane() == 0);
    asm volatile("s_waitcnt vmcnt(0)" ::: "memory");
    __syncthreads();
    if (xb_t0) {
        unsigned* bar = b.bar;
        __builtin_amdgcn_s_waitcnt(0);
        unsigned nloc = b.st[0], nx = b.st[1];
        if (nloc == 0u) { xcd_barrier_complete(bar, b.x, nloc, nx); b.st[0] = nloc; b.st[1] = nx; }
        const unsigned old = xb_add(&bar[XB_XSUB(b.x)], 1u);
        const unsigned gen = old / nloc;
        if (old + 1u == (gen + 1u) * nloc) {
            __builtin_amdgcn_fence(__ATOMIC_RELEASE, "agent");
            asm volatile("s_waitcnt vmcnt(0)" ::: "memory");
            const unsigned og = xb_add(&bar[XB_TOP], 1u);
            const unsigned tg = og / nx;
            if (og + 1u == (tg + 1u) * nx) xb_add(&bar[XB_TOPGEN], 1u);
            else XB_SPIN(xb_ld(&bar[XB_TOPGEN]) == tg, bar);
            __builtin_amdgcn_fence(__ATOMIC_ACQUIRE, "agent");
            xb_add(&bar[XB_XGEN(b.x)], 1u);
            asm volatile("s_waitcnt vmcnt(0)" ::: "memory");
        } else {
            XB_SPIN(xb_ld(&bar[XB_XGEN(b.x)]) == gen, bar);
            __builtin_amdgcn_fence(__ATOMIC_ACQUIRE, "agent");
            asm volatile("s_waitcnt vmcnt(0)" ::: "memory");
        }
    }
    __syncthreads();
}

constexpr int NWAVES = 8;
constexpr int BATCH = 16, SEQ = 2048, DM = 2048, MROWS = BATCH * SEQ;
constexpr float RMS_EPS = 1e-6f, GN_EPS = 64e-5f, LOG2E = 1.4426950408889634f;
constexpr int P0 = 4608;
constexpr int P2 = 8192;
constexpr int P3 = 8192;
constexpr size_t MiB = 1u << 20;
constexpr size_t WS_CTL = 0, CTL_ZERO_BYTES = 1 * MiB;
constexpr size_t WS_W = 1 * MiB;
constexpr size_t WS_S0 = 48 * MiB, SLOT = 128 * MiB;
#define WS_SLOT(i) (WS_S0 + (size_t)(i) * SLOT)
constexpr size_t WS_SMALL = WS_S0 + 7 * SLOT;
constexpr size_t WS_L1 = WS_SMALL;
constexpr size_t WS_GX = WS_SMALL + 16 * MiB;
constexpr size_t WS_F = WS_SMALL + 20 * MiB;
constexpr size_t WS_W3 = WS_SMALL + 24 * MiB;
constexpr size_t WS_END = WS_W3 + 42 * MiB;
constexpr int CW_TMO = 0;
constexpr int CW_BAR = 4096;
constexpr int CW_MLF = 8192;
constexpr int CW_QUEUE = 2048;
constexpr size_t W0_IN = 0, W0_OUT = (size_t)4608 * 2048;
constexpr size_t W1_IN = 0, W1_LA = (size_t)4 * 2048 * 2048, W1_LB = W1_LA + (size_t)256 * 2048, W1_L2 = W1_LB + (size_t)256 * 2048, W1_OUT = W1_L2 + (size_t)4096 * 256;
constexpr size_t W2_IN = 0, W2_OUT = (size_t)8448 * 2048;
static_assert((W1_OUT + (size_t)2048 * 2048) * 2 <= 47 * MiB && (W2_OUT + (size_t)2048 * 2048) * 2 <= 47 * MiB, "weight region");
constexpr int RING_BYTES = 131072;
constexpr int MISC_OFF = RING_BYTES;
constexpr int LDS_BYTES = 147456;

typedef float f32x2 __attribute__((ext_vector_type(2)));
struct Frame {
    LAS unsigned char* lds;
    int tid, lane, wave, vcu, G;
    int cvi, cvn;
};
__device__ __forceinline__ float wave_sum(float v) {
#pragma unroll
    for (int o = 1; o < 64; o <<= 1) v += __shfl_xor(v, o);
    return v;
}
__device__ __forceinline__ float bf2f(unsigned short b) { return __builtin_bit_cast(float, (unsigned)b << 16); }
__device__ __forceinline__ float bflo(unsigned w) { return __builtin_bit_cast(float, w << 16); }
__device__ __forceinline__ float bfhi(unsigned w) { return __builtin_bit_cast(float, w & 0xffff0000u); }
__device__ __forceinline__ unsigned pkbf(float lo, float hi) { return pg8::cvt_pk_bf16(lo, hi); }
__device__ __forceinline__ float siluf(float x) { return x * __builtin_amdgcn_rcpf(1.0f + __expf(-x)); }
__device__ __forceinline__ float sigmf(float x) { return __builtin_amdgcn_rcpf(1.0f + __expf(-x)); }
__device__ __forceinline__ float logsigf(float z) { return fminf(z, 0.f) - log1pf(__expf(-fabsf(z))); }

__device__ __forceinline__ void transpose_item(const float* W, int ldw, int n0w, int K, int N, bf16* WT, int row_off, LAS float* scr, int item, int lane, const float* gk = nullptr) {
    const int nblk = N / 32, kb = item / nblk, nb = item % nblk, k0 = 64 * kb, n0 = 32 * nb;
#pragma unroll 8
    for (int i = 0; i < 32; ++i) { const int kk = 2 * i + (lane >> 5); float w = W[(size_t)(k0 + kk) * ldw + n0w + n0 + (lane & 31)]; if (gk) w *= gk[k0 + kk]; scr[kk * 33 + (lane & 31)] = w; }
    LDS_WAIT(); asm volatile("" ::: "memory");
    const int c = lane & 7;
#pragma unroll
    for (int j = 0; j < 4; ++j) { const int n = (lane >> 3) + 8 * j; const LAS float* s = scr + (8 * c) * 33 + n;
        v4u o; o.x = pkbf(s[0 * 33], s[1 * 33]); o.y = pkbf(s[2 * 33], s[3 * 33]); o.z = pkbf(s[4 * 33], s[5 * 33]); o.w = pkbf(s[6 * 33], s[7 * 33]);
        *(GAS v4u*)(WT + (size_t)(row_off + n0 + n) * K + k0 + 8 * c) = o; }
    LDS_WAIT(); asm volatile("" ::: "memory");
}
__device__ __forceinline__ void convert_matrix(Frame& F, const float* W, int ldw, int n0w, int K, int N, bf16* WT, int row_off, const float* gk = nullptr) {
    LAS float* scr = (LAS float*)(F.lds + F.wave * 16384);
    const int gw = F.cvi * NWAVES + F.wave, NGW = F.cvn * NWAVES, nitems = (K / 64) * (N / 32);
    for (int it = gw; it < nitems; it += NGW) transpose_item(W, ldw, n0w, K, N, WT, row_off, scr, it, F.lane, gk);
}
__device__ __forceinline__ void zero_rows(Frame& F, bf16* WT, int K, int r0, int r1) {
    const size_t n16 = (size_t)(r1 - r0) * K / 8; GAS v4u* p = (GAS v4u*)(WT + (size_t)r0 * K);
    for (size_t i = (size_t)F.cvi * 512 + F.tid; i < n16; i += (size_t)F.cvn * 512) p[i] = (v4u){0u, 0u, 0u, 0u};
}
__device__ __forceinline__ void convert_cols_small(Frame& F, const float* W, int ldw, int n0w, int K, int N, bf16* WT, int row_off, const float* gk = nullptr) {
    const int total = K * N;
    for (int i = F.cvi * 512 + F.tid; i < total; i += F.cvn * 512) { const int n = i / K, k = i % K; float w = W[(size_t)k * ldw + n0w + n]; if (gk) w *= gk[k]; WT[(size_t)(row_off + n) * K + k] = (bf16)f2bf(w); }
}

template <bool XBF> __device__ __forceinline__ f32x4 xrow_load(const void* x, size_t m, int lane, int j) {
    typedef unsigned u32x2_t __attribute__((ext_vector_type(2)));
    if constexpr (XBF) { const u32x2_t w = *((const GAS u32x2_t*)((const bf16*)x + m * DM) + lane + 64 * j); return (f32x4){bflo(w.x), bfhi(w.x), bflo(w.y), bfhi(w.y)}; }
    else return *((const GAS f32x4*)((const float*)x + m * DM) + lane + 64 * j);
}
template <bool XBF> __device__ __forceinline__ void phase_norm(Frame& F, const void* x, const float* gain, bf16* out) {
    const int gw = F.vcu * NWAVES + F.wave, NGW = F.G * NWAVES;
    f32x4 g[8];
#pragma unroll
    for (int j = 0; j < 8; ++j) g[j] = *(const f32x4*)(gain + (F.lane + 64 * j) * 4);
    f32x4 vn[8];
    if (gw < MROWS) {
#pragma unroll
        for (int j = 0; j < 8; ++j) vn[j] = xrow_load<XBF>(x, (size_t)gw, F.lane, j); }
    for (int m = gw; m < MROWS; m += NGW) {
        f32x4 v[8]; float s = 0.f;
#pragma unroll
        for (int j = 0; j < 8; ++j) { v[j] = vn[j]; s += (v[j].x * v[j].x + v[j].y * v[j].y) + (v[j].z * v[j].z + v[j].w * v[j].w); }
        if (m + NGW < MROWS) {
#pragma unroll
            for (int j = 0; j < 8; ++j) vn[j] = xrow_load<XBF>(x, (size_t)(m + NGW), F.lane, j); }
        const float rstd = 1.0f / sqrtf(wave_sum(s) * (1.0f / DM) + RMS_EPS);
        GAS unsigned long long* o8 = (GAS unsigned long long*)(out + (size_t)m * DM) + F.lane;
#pragma unroll
        for (int j = 0; j < 8; ++j) { const f32x4 y = v[j] * rstd * g[j]; o8[64 * j] = (unsigned long long)pkbf(y.x, y.y) | ((unsigned long long)pkbf(y.z, y.w) << 32); }
    }
}
__device__ __forceinline__ void phase_rstd(Frame& F, const bf16* x, float* RS) {
    const int gw = F.vcu * NWAVES + F.wave, NGW = F.G * NWAVES;
    typedef unsigned u32x4_t __attribute__((ext_vector_type(4)));
    u32x4_t vn[4];
    if (gw < MROWS) {
#pragma unroll
        for (int j = 0; j < 4; ++j) vn[j] = *((const GAS u32x4_t*)(x + (size_t)gw * DM) + F.lane + 64 * j); }
    for (int m = gw; m < MROWS; m += NGW) {
        float s = 0.f;
#pragma unroll
        for (int j = 0; j < 4; ++j) {
#pragma unroll
            for (int e = 0; e < 4; ++e) { const float a = bflo(vn[j][e]), c = bfhi(vn[j][e]); s += a * a + c * c; } }
        if (m + NGW < MROWS) {
#pragma unroll
            for (int j = 0; j < 4; ++j) vn[j] = *((const GAS u32x4_t*)(x + (size_t)(m + NGW) * DM) + F.lane + 64 * j); }
        s = wave_sum(s);
        if (F.lane == 0) RS[m] = 1.0f / sqrtf(s * (1.0f / DM) + RMS_EPS);
    }
}

typedef float f32x16 __attribute__((ext_vector_type(16)));
typedef short v4i16_t __attribute__((ext_vector_type(4)));
typedef unsigned u32x4 __attribute__((ext_vector_type(4)));
typedef unsigned u32x2 __attribute__((ext_vector_type(2)));
__device__ __forceinline__ int crow(int r, int hi) { return (r & 3) + 8 * (r >> 2) + 4 * hi; }
__device__ __forceinline__ bf16x8 mk8(v4i16_t lo, v4i16_t hi) { return (bf16x8){lo[0], lo[1], lo[2], lo[3], hi[0], hi[1], hi[2], hi[3]}; }
__device__ __forceinline__ v4i16_t ldtr(const LAS unsigned char* p) { return __builtin_amdgcn_ds_read_tr16_b64_v4i16((LAS v4i16_t*)p); }
__device__ __forceinline__ bf16x8 pack8(float a0, float a1, float a2, float a3, float a4, float a5, float a6, float a7) {
    u32x4 w; w.x = pkbf(a0, a1); w.y = pkbf(a2, a3); w.z = pkbf(a4, a5); w.w = pkbf(a6, a7); return __builtin_bit_cast(bf16x8, w); }
__device__ __forceinline__ int t5_bucket(int d) {
    if (d < 16) return d;
    int b = 15; b += (d >= 16); b += (d >= 19); b += (d >= 21); b += (d >= 24); b += (d >= 27); b += (d >= 31); b += (d >= 35); b += (d >= 40);
    b += (d >= 46); b += (d >= 52); b += (d >= 59); b += (d >= 67); b += (d >= 77); b += (d >= 87); b += (d >= 99); b += (d >= 113); return b;
}


__device__ __forceinline__ void attn_epilogue(const f32x16 (&O)[2], float rl, const bf16* gate0, int gpitch, bf16* out0, LAS unsigned char* stg, int lane) {
    const int r32 = lane & 31, hi = lane >> 5, srow = lane >> 3, sch = lane & 7;
#pragma unroll
    for (int i = 0; i < 4; ++i) { const int row = i * 8 + srow; *(LAS u32x4*)(stg + row * 128 + sch * 16) = *(const GAS u32x4*)(gate0 + (size_t)row * gpitch + sch * 8); }
#pragma unroll
    for (int db = 0; db < 2; ++db)
#pragma unroll
        for (int g4 = 0; g4 < 4; ++g4) { const int d0 = db * 32 + 8 * g4 + 4 * hi;
            LAS u32x2* sp = (LAS u32x2*)(stg + r32 * 128 + d0 * 2);
            const u32x2 gv = *sp;
            const float o0 = O[db][4 * g4 + 0] * rl * siluf(bflo(gv.x)), o1 = O[db][4 * g4 + 1] * rl * siluf(bfhi(gv.x));
            const float o2 = O[db][4 * g4 + 2] * rl * siluf(bflo(gv.y)), o3 = O[db][4 * g4 + 3] * rl * siluf(bfhi(gv.y));
            u32x2 w; w.x = pkbf(o0, o1); w.y = pkbf(o2, o3); *sp = w; }
#pragma unroll
    for (int i = 0; i < 4; ++i) { const int row = i * 8 + srow; *(GAS u32x4*)(out0 + (size_t)row * 2048 + sch * 8) = *(const LAS u32x4*)(stg + row * 128 + sch * 16); }
}

__device__ __forceinline__ void phase_swa(Frame& F, const bf16* proj, const float* q_gain, const float* k_gain, const float* sinks, const float* rel, bf16* og) {
    LAS unsigned char* KS = F.lds;
    LAS unsigned char* VS = F.lds + 36864;
    LAS float* BT = (LAS float*)(F.lds + 36864 + 32768) + F.wave * 128;
    LAS unsigned char* STG = F.lds + 36864 + 32768 + 4096 + F.wave * 4096;
    const int lane0 = F.lane, wave = F.wave;
    for (int u = F.vcu; u < 1024; u += F.G) {
        int lane = lane0; asm volatile("" : "+v"(lane)); const int tid = wave * 64 + lane;
        const int b = u >> 6, kvh = (u >> 4) & 3, j = u & 15;
        const size_t rowbase = (size_t)b * SEQ;
        const int head = kvh * 8 + wave;
        __syncthreads();
#pragma unroll
        for (int i = 0; i < 4; ++i) {
            const int s = (tid >> 3) + 64 * i, ch = tid & 7, t = j * 128 - 128 + s;
            u32x4 kv = {0u, 0u, 0u, 0u}, vv = {0u, 0u, 0u, 0u};
            if (t >= 0) { const bf16* rp = proj + (rowbase + t) * P0 + kvh * 64 + ch * 8; kv = *(const GAS u32x4*)(rp + 2048); vv = *(const GAS u32x4*)(rp + 2304); }
            float kf[8] = {bflo(kv.x), bfhi(kv.x), bflo(kv.y), bfhi(kv.y), bflo(kv.z), bfhi(kv.z), bflo(kv.w), bfhi(kv.w)};
            float ss = 0.f;
#pragma unroll
            for (int e = 0; e < 8; ++e) ss += kf[e] * kf[e];
            ss += __shfl_xor(ss, 1); ss += __shfl_xor(ss, 2); ss += __shfl_xor(ss, 4);
            const float rstd = 1.0f / sqrtf(ss * (1.0f / 64.0f) + RMS_EPS);
            const f32x4 g0 = *(const f32x4*)(k_gain + ch * 8), g1 = *(const f32x4*)(k_gain + ch * 8 + 4);
            u32x4 ko; ko.x = pkbf(kf[0] * rstd * g0.x, kf[1] * rstd * g0.y); ko.y = pkbf(kf[2] * rstd * g0.z, kf[3] * rstd * g0.w);
            ko.z = pkbf(kf[4] * rstd * g1.x, kf[5] * rstd * g1.y); ko.w = pkbf(kf[6] * rstd * g1.z, kf[7] * rstd * g1.w);
            *(LAS u32x4*)(KS + s * 144 + ch * 16) = ko;
            *(LAS u32x4*)(VS + (ch >> 2) * 16384 + s * 64 + (ch & 3) * 16) = vv;
        }
        for (int dd = lane; dd < 128; dd += 64) BT[dd] = rel[t5_bucket(dd) * 32 + head] * LOG2E;
        const float sink2 = sinks[head] * LOG2E;
        __syncthreads();
        const int ktmin = (j == 0) ? 4 : 0;
        for (int qs = 0; qs < 4; ++qs) {
            int lq = lane0; asm volatile("" : "+v"(lq)); const int r32 = lq & 31, hi = lq >> 5, g16 = lq >> 4, q4 = (lq & 15) >> 2, p4 = lq & 3;
            const size_t qrow = rowbase + j * 128 + qs * 32 + r32;
            const bf16* qp = proj + qrow * P0 + head * 64 + hi * 8;
            u32x4 qraw[4]; float ss = 0.f;
#pragma unroll
            for (int s4 = 0; s4 < 4; ++s4) { qraw[s4] = *(const GAS u32x4*)(qp + s4 * 16);
#pragma unroll
                for (int e = 0; e < 4; ++e) { const float a = bflo(qraw[s4][e]), c = bfhi(qraw[s4][e]); ss += a * a + c * c; } }
            ss += __shfl_xor(ss, 32);
            const float qsc = (0.125f * LOG2E) / sqrtf(ss * (1.0f / 64.0f) + RMS_EPS);
            bf16x8 qfr[4];
#pragma unroll
            for (int s4 = 0; s4 < 4; ++s4) { const f32x4 g0 = *(const f32x4*)(q_gain + s4 * 16 + hi * 8), g1 = *(const f32x4*)(q_gain + s4 * 16 + hi * 8 + 4);
                qfr[s4] = pack8(bflo(qraw[s4].x) * qsc * g0.x, bfhi(qraw[s4].x) * qsc * g0.y, bflo(qraw[s4].y) * qsc * g0.z, bfhi(qraw[s4].y) * qsc * g0.w,
                                bflo(qraw[s4].z) * qsc * g1.x, bfhi(qraw[s4].z) * qsc * g1.y, bflo(qraw[s4].w) * qsc * g1.z, bfhi(qraw[s4].w) * qsc * g1.w); }
            f32x16 S[5];
#pragma unroll
            for (int tt = 0; tt < 5; ++tt) {
                const int kt = qs + tt;
                if (kt >= ktmin) {
                    f32x16 acc;
#pragma unroll
                    for (int r = 0; r < 16; ++r) acc[r] = 0.f;
                    const LAS unsigned char* kp = KS + (32 * kt + r32) * 144 + hi * 16;
#pragma unroll
                    for (int s4 = 0; s4 < 4; ++s4) acc = __builtin_amdgcn_mfma_f32_32x32x16_bf16(*(const LAS bf16x8*)(kp + s4 * 32), qfr[s4], acc, 0, 0, 0);
#pragma unroll
                    for (int r = 0; r < 16; ++r) { const int c = crow(r, hi); const int dist = r32 + 128 - 32 * tt - c;
                        const bool valid = (tt == 0) ? (c > r32) : ((tt == 4) ? (c <= r32) : true);
                        const float bsv = BT[dist & 127];
                        acc[r] = valid ? acc[r] + bsv : -INFINITY; }
                    S[tt] = acc;
                } else {
#pragma unroll
                    for (int r = 0; r < 16; ++r) S[tt][r] = -INFINITY;
                }
            }
            float mx = sink2;
#pragma unroll
            for (int tt = 0; tt < 5; ++tt)
#pragma unroll
                for (int r = 0; r < 16; ++r) mx = fmaxf(mx, S[tt][r]);
            mx = fmaxf(mx, __shfl_xor(mx, 32));
            float l = 0.f;
#pragma unroll
            for (int tt = 0; tt < 5; ++tt)
#pragma unroll
                for (int r = 0; r < 16; ++r) { const float p = __builtin_amdgcn_exp2f(S[tt][r] - mx); S[tt][r] = p; l += p; }
            l += __shfl_xor(l, 32); l += __builtin_amdgcn_exp2f(sink2 - mx);
            const float rl = 1.0f / l;
            f32x16 O[2];
#pragma unroll
            for (int r = 0; r < 16; ++r) { O[0][r] = 0.f; O[1][r] = 0.f; }
#pragma unroll
            for (int tt = 0; tt < 5; ++tt) {
                const int kt = qs + tt;
                if (kt >= ktmin) {
#pragma unroll
                    for (int s2 = 0; s2 < 2; ++s2) {
                        const bf16x8 pf = pack8(S[tt][8 * s2 + 0], S[tt][8 * s2 + 1], S[tt][8 * s2 + 2], S[tt][8 * s2 + 3], S[tt][8 * s2 + 4], S[tt][8 * s2 + 5], S[tt][8 * s2 + 6], S[tt][8 * s2 + 7]);
#pragma unroll
                        for (int db = 0; db < 2; ++db) {
                            const LAS unsigned char* va = VS + db * 16384 + (32 * kt + 16 * s2 + 4 * (g16 >> 1) + q4) * 64 + (g16 & 1) * 32 + p4 * 8;
                            const v4i16_t lo = ldtr(va), hh = ldtr(va + 512);
                            O[db] = __builtin_amdgcn_mfma_f32_32x32x16_bf16(mk8(lo, hh), pf, O[db], 0, 0, 0);
                        }
                    }
                }
            }
            { const size_t row0 = rowbase + j * 128 + qs * 32;
              attn_epilogue(O, rl, proj + row0 * P0 + 2560 + head * 64, P0, og + row0 * 2048 + head * 64, STG, lq); }
        }
    }
}

__device__ __forceinline__ void phase_mix_from_x(Frame& F, const float* x, const float* gain, const float* mixA, const float* mixB, bf16* hout, bf16* xa, bf16* xb) {
    const int gw = F.vcu * NWAVES + F.wave, NGW = F.G * NWAVES;
    for (int run = gw; run < MROWS / 8; run += NGW) {
        const int m0 = run * 8;
        f32x4 prev[8];
        if ((m0 & (SEQ - 1)) == 0) {
#pragma unroll
            for (int j = 0; j < 8; ++j) prev[j] = (f32x4){0.f, 0.f, 0.f, 0.f};
        } else {
            float s = 0.f;
#pragma unroll
            for (int j = 0; j < 8; ++j) { prev[j] = xrow_load<true>(x, (size_t)(m0 - 1), F.lane, j); s += (prev[j].x * prev[j].x + prev[j].y * prev[j].y) + (prev[j].z * prev[j].z + prev[j].w * prev[j].w); }
            const float rstd = 1.0f / sqrtf(wave_sum(s) * (1.0f / DM) + RMS_EPS);
#pragma unroll
            for (int j = 0; j < 8; ++j) prev[j] = prev[j] * rstd * *(const f32x4*)(gain + (F.lane + 64 * j) * 4);
        }
        for (int r = 0; r < 8; ++r) {
            const size_t m = (size_t)(m0 + r);
            const GAS f32x4* xr = (const GAS f32x4*)(x + m * DM) + F.lane;
            f32x4 v[8]; float s = 0.f;
#pragma unroll
            for (int j = 0; j < 8; ++j) { v[j] = xr[64 * j]; s += (v[j].x * v[j].x + v[j].y * v[j].y) + (v[j].z * v[j].z + v[j].w * v[j].w); }
            const float rstd = 1.0f / sqrtf(wave_sum(s) * (1.0f / DM) + RMS_EPS);
            GAS unsigned long long* oh = (GAS unsigned long long*)(hout + m * DM) + F.lane;
            GAS unsigned long long* oa = (GAS unsigned long long*)(xa + m * DM) + F.lane;
            GAS unsigned long long* ob = (GAS unsigned long long*)(xb + m * DM) + F.lane;
#pragma unroll
            for (int j = 0; j < 8; ++j) {
                const int c = (F.lane + 64 * j) * 4;
                const f32x4 hcur = v[j] * rstd * *(const f32x4*)(gain + c);
                const f32x4 d = prev[j] - hcur;
                const f32x4 ya = hcur + d * *(const f32x4*)(mixA + c), yb = hcur + d * *(const f32x4*)(mixB + c);
                oh[64 * j] = (unsigned long long)pkbf(hcur.x, hcur.y) | ((unsigned long long)pkbf(hcur.z, hcur.w) << 32);
                oa[64 * j] = (unsigned long long)pkbf(ya.x, ya.y) | ((unsigned long long)pkbf(ya.z, ya.w) << 32);
                ob[64 * j] = (unsigned long long)pkbf(yb.x, yb.y) | ((unsigned long long)pkbf(yb.z, yb.w) << 32);
                prev[j] = hcur;
            }
        }
    }
}
__device__ __forceinline__ void phase_mix_from_h(Frame& F, const bf16* h, const float* mixA, bf16* xa, const float* mixB, bf16* xb) {
    const int gw = F.vcu * NWAVES + F.wave, NGW = F.G * NWAVES;
    for (int run = gw; run < MROWS / 8; run += NGW) {
        const int m0 = run * 8;
        u32x4 prev[4];
        if ((m0 & (SEQ - 1)) == 0) {
#pragma unroll
            for (int j = 0; j < 4; ++j) prev[j] = (u32x4){0u, 0u, 0u, 0u};
        } else {
            const GAS u32x4* hr = (const GAS u32x4*)(h + (size_t)(m0 - 1) * DM) + F.lane;
#pragma unroll
            for (int j = 0; j < 4; ++j) prev[j] = hr[64 * j];
        }
        for (int r = 0; r < 8; ++r) {
            const size_t m = (size_t)(m0 + r);
            const GAS u32x4* hr = (const GAS u32x4*)(h + m * DM) + F.lane;
            u32x4 cur[4];
#pragma unroll
            for (int j = 0; j < 4; ++j) cur[j] = hr[64 * j];
#pragma unroll
            for (int j = 0; j < 4; ++j) {
                const int c = (F.lane + 64 * j) * 8;
                const f32x4 ma0 = *(const f32x4*)(mixA + c), ma1 = *(const f32x4*)(mixA + c + 4);
                float hc[8], hp[8];
#pragma unroll
                for (int e = 0; e < 4; ++e) { hc[2 * e] = bflo(cur[j][e]); hc[2 * e + 1] = bfhi(cur[j][e]); hp[2 * e] = bflo(prev[j][e]); hp[2 * e + 1] = bfhi(prev[j][e]); }
                const float ma[8] = {ma0.x, ma0.y, ma0.z, ma0.w, ma1.x, ma1.y, ma1.z, ma1.w};
                u32x4 o;
#pragma unroll
                for (int e = 0; e < 4; ++e) o[e] = pkbf(hc[2 * e] + (hp[2 * e] - hc[2 * e]) * ma[2 * e], hc[2 * e + 1] + (hp[2 * e + 1] - hc[2 * e + 1]) * ma[2 * e + 1]);
                *((GAS u32x4*)(xa + m * DM) + F.lane + 64 * j) = o;
                if (xb) {
                    const f32x4 mb0 = *(const f32x4*)(mixB + c), mb1 = *(const f32x4*)(mixB + c + 4);
                    const float mb[8] = {mb0.x, mb0.y, mb0.z, mb0.w, mb1.x, mb1.y, mb1.z, mb1.w};
#pragma unroll
                    for (int e = 0; e < 4; ++e) o[e] = pkbf(hc[2 * e] + (hp[2 * e] - hc[2 * e]) * mb[2 * e], hc[2 * e + 1] + (hp[2 * e + 1] - hc[2 * e + 1]) * mb[2 * e + 1]);
                    *((GAS u32x4*)(xb + m * DM) + F.lane + 64 * j) = o;
                }
            }
#pragma unroll
            for (int j = 0; j < 4; ++j) prev[j] = cur[j];
        }
    }
}
__device__ __forceinline__ void phase_mix6(Frame& F, const bf16* x, const float* gain, const float* mix, bf16* o0, bf16* o1, bf16* o2, bf16* o3, bf16* o4, bf16* o5) {
    LAS float* GL = (LAS float*)F.lds;
    for (int i = F.tid; i < 2048 / 4; i += 512) *(LAS f32x4*)(GL + 4 * i) = *(const f32x4*)(gain + 4 * i);
    for (int i = F.tid; i < 6 * 2048 / 4; i += 512) *(LAS f32x4*)(GL + 2048 + 4 * i) = *(const f32x4*)(mix + 4 * i);
    __syncthreads();
    const int gw = F.vcu * NWAVES + F.wave, NGW = F.G * NWAVES;
    for (int run = gw; run < MROWS / 8; run += NGW) {
        const int m0 = run * 8;
        f32x4 prev[8];
        if ((m0 & (SEQ - 1)) == 0) {
#pragma unroll
            for (int j = 0; j < 8; ++j) prev[j] = (f32x4){0.f, 0.f, 0.f, 0.f};
        } else {
            float s = 0.f;
#pragma unroll
            for (int j = 0; j < 8; ++j) { prev[j] = xrow_load<true>(x, (size_t)(m0 - 1), F.lane, j); s += (prev[j].x * prev[j].x + prev[j].y * prev[j].y) + (prev[j].z * prev[j].z + prev[j].w * prev[j].w); }
            const float rstd = 1.0f / sqrtf(wave_sum(s) * (1.0f / DM) + RMS_EPS);
#pragma unroll
            for (int j = 0; j < 8; ++j) prev[j] = prev[j] * rstd * *(const LAS f32x4*)(GL + (F.lane + 64 * j) * 4);
        }
        f32x4 vn[8];
        {
#pragma unroll
          for (int j = 0; j < 8; ++j) vn[j] = xrow_load<true>(x, (size_t)m0, F.lane, j); }
        for (int r = 0; r < 8; ++r) {
            const size_t m = (size_t)(m0 + r);
            f32x4 v[8]; float s = 0.f;
#pragma unroll
            for (int j = 0; j < 8; ++j) { v[j] = vn[j]; s += (v[j].x * v[j].x + v[j].y * v[j].y) + (v[j].z * v[j].z + v[j].w * v[j].w); }
            if (r + 1 < 8) {
#pragma unroll
                for (int j = 0; j < 8; ++j) vn[j] = xrow_load<true>(x, m + 1, F.lane, j); }
            const float rstd = 1.0f / sqrtf(wave_sum(s) * (1.0f / DM) + RMS_EPS);
#pragma unroll
            for (int j = 0; j < 8; ++j) {
                const int c = (F.lane + 64 * j) * 4;
                const f32x4 hcur = v[j] * rstd * *(const LAS f32x4*)(GL + c);
                const f32x4 d = prev[j] - hcur;
#define MIX6_ST(ci, op) do { const f32x4 y = hcur + d * *(const LAS f32x4*)(GL + 2048 * ((ci) + 1) + c); \
                    *((GAS unsigned long long*)((op) + m * DM) + F.lane + 64 * j) = (unsigned long long)pkbf(y.x, y.y) | ((unsigned long long)pkbf(y.z, y.w) << 32); } while (0)
                MIX6_ST(0, o0); MIX6_ST(1, o1); MIX6_ST(2, o2); MIX6_ST(3, o3); MIX6_ST(4, o4); MIX6_ST(5, o5);
#undef MIX6_ST
                prev[j] = hcur;
            }
        }
    }
}
__device__ __forceinline__ void convert_lora2(Frame& F, const float* wl2, const float* al2, bf16* WT) {
    const int total = 4096 * 256;
    for (int i = F.cvi * 512 + F.tid; i < total; i += F.cvn * 512) {
        const int k = i >> 12, n = i & 4095;
        float v = 0.f;
        if (n < 2048) { if (k < 96) v = wl2[(size_t)k * 2048 + n]; } else { if (k >= 128 && k < 224) v = al2[(size_t)(k - 128) * 2048 + (n - 2048)]; }
        WT[(size_t)n * 256 + k] = (bf16)f2bf(v);
    }
}

constexpr int RW_T = 16;
constexpr int RW_MS = 144;
constexpr int RW_MAT = 16 * RW_MS;
constexpr int RW_O_AL = 0, RW_O_NB = RW_MAT, RW_O_KA = 2 * RW_MAT, RW_O_RH = 3 * RW_MAT, RW_O_PL = 4 * RW_MAT, RW_OPS = 4 * RW_MAT + 256;
constexpr int RW_OFF_OPS = 0;
constexpr int RW_OFF_VV = 3 * RW_OPS;
constexpr int RW_OFF_BON = RW_OFF_VV + 4 * RW_MAT;
constexpr int RW_OFF_GR = RW_OFF_BON + 4 * 64;
constexpr int RW_GRS = 1024 + 3 * 512 + 1024;
constexpr int RW_OFF_YB = RW_OFF_GR + 2 * RW_GRS;
constexpr int RW_OFF_LWS = RW_OFF_YB + 2 * 4096;
constexpr int RW_SEQ_BYTES = RW_OFF_LWS + 2 * 4096;
static_assert(2 * RW_SEQ_BYTES <= RING_BYTES, "rwkv LDS");
template <int CTRL> __device__ __forceinline__ float dppmov(float v) { return __builtin_bit_cast(float, __builtin_amdgcn_mov_dpp(__builtin_bit_cast(int, v), CTRL, 0xf, 0xf, true)); }
__device__ __forceinline__ float red16(float v) {
    v += dppmov<0xB1>(v); v += dppmov<0x4E>(v); v += dppmov<0x141>(v); v += dppmov<0x140>(v); return v;
}
__device__ __forceinline__ int rw_tau(int p) { return ((p & 3) << 2) | (p >> 2); }
__device__ __forceinline__ void red16x2(float& a, float& b) {
    a += dppmov<0xB1>(a); b += dppmov<0xB1>(b); asm("" : "+v"(a), "+v"(b));
    a += dppmov<0x4E>(a); b += dppmov<0x4E>(b); asm("" : "+v"(a), "+v"(b));
    a += dppmov<0x141>(a); b += dppmov<0x141>(b); asm("" : "+v"(a), "+v"(b));
    a += dppmov<0x140>(a); b += dppmov<0x140>(b);
}
__device__ __forceinline__ void phase_rwkv(Frame& F, const bf16* Rb, const bf16* Kb, const bf16* Vb, const bf16* Gb, const bf16* LWb, const bf16* Ab,
                                           const float* k_k, const float* k_a, const float* r_k, const float* gn_w, const float* gn_b, bf16* out) {
    const int lane = F.lane, sq = F.wave >> 2, wq = F.wave & 3, tid4 = wq * 64 + lane;
    const int pt = tid4 >> 4, pq = tid4 & 15;
    const int l15 = lane & 15, g = lane >> 4, q4 = l15 >> 2, p4 = lane & 3;
    LAS unsigned char* base = F.lds + sq * RW_SEQ_BYTES;
    constexpr int NB = SEQ / RW_T;
    for (int s0 = 2 * F.vcu; s0 < BATCH * 32; s0 += 2 * F.G) {
        const int seq = s0 + sq, b = seq >> 5, hd = seq & 31;
        const size_t rowbase = (size_t)b * SEQ; const int cb = hd * 64 + 4 * pq;
        const f32x4 kkc = *(const f32x4*)(k_k + cb), kac = *(const f32x4*)(k_a + cb), rkc = *(const f32x4*)(r_k + cb), gwc = *(const f32x4*)(gn_w + cb), gbc = *(const f32x4*)(gn_b + cb);
        f32x4 st[4]; bf16x8 sb[2];
#pragma unroll
        for (int kb = 0; kb < 4; ++kb) st[kb] = (f32x4){0.f, 0.f, 0.f, 0.f};
        sb[0] = (bf16x8){0, 0, 0, 0, 0, 0, 0, 0}; sb[1] = sb[0];
        __syncthreads();
        u32x2 pr_r, pr_k, pr_v, pr_a, pg_g = {0u, 0u};
        unsigned short pw0, pw1, pw2, pw3;
        const size_t wofs = (size_t)hd * 64 + lane;
#define RW_LWLOAD(blk) do { const bf16* p_ = LWb + (rowbase + (size_t)(blk) * RW_T + 4 * wq) * DM + wofs; pw0 = p_[0]; pw1 = p_[DM]; pw2 = p_[2 * DM]; pw3 = p_[3 * DM]; } while (0)
#define RW_LWSCAN(stage) do { LAS float* q_ = (LAS float*)(base + RW_OFF_LWS + (stage) * 4096) + (4 * wq) * 64 + lane; const float c0_ = bf2f(pw0), c1_ = c0_ + bf2f(pw1), c2_ = c1_ + bf2f(pw2), c3_ = c2_ + bf2f(pw3); \
            q_[0] = c0_; q_[64] = c1_; q_[128] = c2_; q_[192] = c3_; } while (0)
        { const size_t o = (rowbase + pt) * DM + cb; pr_r = *(const GAS u32x2*)(Rb + o); pr_k = *(const GAS u32x2*)(Kb + o); pr_v = *(const GAS u32x2*)(Vb + o); pr_a = *(const GAS u32x2*)(Ab + o); }
        RW_LWLOAD(0);
        RW_LWSCAN(0);
        __syncthreads();
        for (int it = 0; it < NB + 3; ++it) {
            if (it < NB) {
                LAS unsigned char* OPS = base + RW_OFF_OPS + (it % 3) * RW_OPS;
                LAS unsigned char* VV = base + RW_OFF_VV + (it & 3) * RW_MAT;
                const f32x4 r = {bflo(pr_r.x), bfhi(pr_r.x), bflo(pr_r.y), bfhi(pr_r.y)}, k = {bflo(pr_k.x), bfhi(pr_k.x), bflo(pr_k.y), bfhi(pr_k.y)};
                const f32x4 a = {bflo(pr_a.x), bfhi(pr_a.x), bflo(pr_a.y), bfhi(pr_a.y)};
                const LAS float* lws = (const LAS float*)(base + RW_OFF_LWS + (it & 1) * 4096) + 4 * pq;
                f32x4 tot = {0.f, 0.f, 0.f, 0.f};
                for (int w2 = 0; w2 < wq; ++w2) tot += *(const LAS f32x4*)(lws + (4 * w2 + 3) * 64);
                const f32x4 cum = tot + *(const LAS f32x4*)(lws + pt * 64);
                f32x4 cprev = tot; if (pt & 3) cprev += *(const LAS f32x4*)(lws + (pt - 1) * 64);
                const f32x4 Pp = {__builtin_amdgcn_exp2f(cprev.x), __builtin_amdgcn_exp2f(cprev.y), __builtin_amdgcn_exp2f(cprev.z), __builtin_amdgcn_exp2f(cprev.w)};
                const f32x4 P = {__builtin_amdgcn_exp2f(cum.x), __builtin_amdgcn_exp2f(cum.y), __builtin_amdgcn_exp2f(cum.z), __builtin_amdgcn_exp2f(cum.w)};
                const f32x4 iP = {__builtin_amdgcn_exp2f(-cum.x), __builtin_amdgcn_exp2f(-cum.y), __builtin_amdgcn_exp2f(-cum.z), __builtin_amdgcn_exp2f(-cum.w)};
                const f32x4 kkv = k * kkc;
                const f32x4 kp = k * (1.0f + (a - 1.0f) * kac);
                const f32x4 rk = r * kp * rkc;
                float ss = (kkv.x * kkv.x + kkv.y * kkv.y) + (kkv.z * kkv.z + kkv.w * kkv.w), bon = (rk.x + rk.y) + (rk.z + rk.w);
                red16x2(ss, bon);
                const f32x4 kkn = kkv * __builtin_amdgcn_rcpf(fmaxf(__builtin_amdgcn_sqrtf(ss), 1e-12f));
                const f32x4 al = Pp * kkn, nb = -(kkn * a) * iP, ka = kp * iP, rh = P * r;
                const int mo = rw_tau(pt) * RW_MS + pq * 8;
                u32x2 w2;
                w2.x = pkbf(al.x, al.y); w2.y = pkbf(al.z, al.w); *(LAS u32x2*)(OPS + RW_O_AL + mo) = w2;
                w2.x = pkbf(nb.x, nb.y); w2.y = pkbf(nb.z, nb.w); *(LAS u32x2*)(OPS + RW_O_NB + mo) = w2;
                w2.x = pkbf(ka.x, ka.y); w2.y = pkbf(ka.z, ka.w); *(LAS u32x2*)(OPS + RW_O_KA + mo) = w2;
                w2.x = pkbf(rh.x, rh.y); w2.y = pkbf(rh.z, rh.w); *(LAS u32x2*)(OPS + RW_O_RH + mo) = w2;
                *(LAS u32x2*)(VV + mo) = pr_v;
                if (pt == 15) *(LAS f32x4*)(OPS + RW_O_PL + pq * 16) = P;
                if (pq == 0) *(LAS float*)(base + RW_OFF_BON + (it & 3) * 64 + pt * 4) = bon;
            }
            if (it + 1 < NB) { const size_t o = (rowbase + (it + 1) * RW_T + pt) * DM + cb; pr_r = *(const GAS u32x2*)(Rb + o); pr_k = *(const GAS u32x2*)(Kb + o); pr_v = *(const GAS u32x2*)(Vb + o); pr_a = *(const GAS u32x2*)(Ab + o); RW_LWLOAD(it + 1); }
            if (it >= 3) pg_g = *(const GAS u32x2*)(Gb + (rowbase + (it - 3) * RW_T + pt) * DM + cb);
            if (it >= 1 && it <= NB) {
                const int bi = it - 1;
                const LAS unsigned char* OPS = base + RW_OFF_OPS + (bi % 3) * RW_OPS;
                LAS unsigned char* GR = base + RW_OFF_GR + (bi & 1) * RW_GRS;
                const LAS unsigned char* X = OPS + ((wq & 1) ? RW_O_KA : RW_O_NB) + l15 * RW_MS + g * 16;
                const LAS unsigned char* Yt = OPS + ((wq & 2) ? RW_O_RH : RW_O_AL) + l15 * RW_MS + g * 16;
                f32x4 acc = {0.f, 0.f, 0.f, 0.f};
#pragma unroll
                for (int m = 0; m < 2; ++m) acc = __builtin_amdgcn_mfma_f32_16x16x32_bf16(*(const LAS bf16x8*)(X + m * 64), *(const LAS bf16x8*)(Yt + m * 64), acc, 0, 0, 0);
                const int tt = rw_tau(l15);
#pragma unroll
                for (int r = 0; r < 4; ++r) { const int ts = 4 * r + g; const bool keep = (wq & 2) ? (ts <= tt) : (ts < tt); acc[r] = keep ? acc[r] : 0.f; }
                if (wq == 0) {
                    LAS float* GT = (LAS float*)GR;
#pragma unroll
                    for (int r = 0; r < 4; ++r) GT[tt * 16 + 4 * r + g] = acc[r];
                    const int t = l15, B = g;
                    const f32x4 g4 = *(const LAS f32x4*)(GT + t * 16 + 4 * B);
                    const f32x4 r1 = *(const LAS f32x4*)(GT + (4 * B + 1) * 16 + 4 * B), r2 = *(const LAS f32x4*)(GT + (4 * B + 2) * 16 + 4 * B), r3 = *(const LAS f32x4*)(GT + (4 * B + 3) * 16 + 4 * B);
                    const float N10 = r1.x, N21 = r2.y, N32 = r3.z, N20 = fmaf(r2.y, N10, r2.x), N31 = fmaf(r3.z, N21, r3.y), N30 = fmaf(r3.z, N20, fmaf(r3.y, N10, r3.x));
                    const int i = t - 4 * B;
                    f32x4 E;
                    if (i >= 4) { E.x = fmaf(g4.w, N30, fmaf(g4.z, N20, fmaf(g4.y, N10, g4.x))); E.y = fmaf(g4.w, N31, fmaf(g4.z, N21, g4.y)); E.z = fmaf(g4.w, N32, g4.z); E.w = g4.w; }
                    else { E.x = i == 1 ? N10 : i == 2 ? N20 : i == 3 ? N30 : 0.f; E.y = i == 2 ? N21 : i == 3 ? N31 : 0.f; E.z = i == 3 ? N32 : 0.f; E.w = 0.f; }
                    *(LAS f32x4*)(GR + 2560 + B * 256 + rw_tau(t) * 16) = E;
                }
                else { u32x2 w2; w2.x = pkbf(acc.x, acc.y); w2.y = pkbf(acc.z, acc.w); *(LAS u32x2*)(GR + 1024 + (wq - 1) * 512 + l15 * 32 + g * 8) = w2; }
            }
            if (it >= 2 && it <= NB + 1) {
                const int bi = it - 2;
                const LAS unsigned char* OPS = base + RW_OFF_OPS + (bi % 3) * RW_OPS;
                const LAS unsigned char* VV = base + RW_OFF_VV + (bi & 3) * RW_MAT;
                const LAS unsigned char* GR = base + RW_OFF_GR + (bi & 1) * RW_GRS;
                LAS float* YB = (LAS float*)(base + RW_OFF_YB + (bi & 1) * 4096);
                const v4i16_t vq = ldtr(VV + (4 * g + q4) * RW_MS + (16 * wq + 4 * p4) * 2);
                const v4i16_t zq0 = {0, 0, 0, 0};
                f32x4 racc = {0.f, 0.f, 0.f, 0.f};
#pragma unroll
                for (int m = 0; m < 2; ++m) { const LAS unsigned char* ap = OPS + RW_O_AL + l15 * RW_MS + m * 64 + g * 8;
                    const u32x2 lo = *(const LAS u32x2*)ap, hh = *(const LAS u32x2*)(ap + 32); const u32x4 aw = {lo.x, lo.y, hh.x, hh.y};
                    racc = __builtin_amdgcn_mfma_f32_16x16x32_bf16(__builtin_bit_cast(bf16x8, aw), sb[m], racc, 0, 0, 0); }
                { const v4i16_t b1 = *(const LAS v4i16_t*)(GR + 1024 + 0 * 512 + l15 * 32 + g * 8);
                  racc = __builtin_amdgcn_mfma_f32_16x16x32_bf16(mk8(zq0, b1), mk8(zq0, vq), racc, 0, 0, 0); }
#pragma unroll
                for (int B = 0; B < 4; ++B) { const float e = *(const LAS float*)(GR + 2560 + B * 256 + l15 * 16 + g * 4);
                    racc = __builtin_amdgcn_mfma_f32_16x16x4f32(e, racc[B], racc, 0, 0, 0); }
                u32x2 zw; zw.x = pkbf(racc[0], racc[1]); zw.y = pkbf(racc[2], racc[3]);
                const bf16x8 zv = mk8(__builtin_bit_cast(v4i16_t, zw), vq);
                f32x4 yacc = {0.f, 0.f, 0.f, 0.f};
#pragma unroll
                for (int m = 0; m < 2; ++m) { const LAS unsigned char* ap = OPS + RW_O_RH + l15 * RW_MS + m * 64 + g * 8;
                    const u32x2 lo = *(const LAS u32x2*)ap, hh = *(const LAS u32x2*)(ap + 32); const u32x4 aw = {lo.x, lo.y, hh.x, hh.y};
                    yacc = __builtin_amdgcn_mfma_f32_16x16x32_bf16(__builtin_bit_cast(bf16x8, aw), sb[m], yacc, 0, 0, 0); }
                { const v4i16_t a2 = *(const LAS v4i16_t*)(GR + 1024 + 1 * 512 + l15 * 32 + g * 8), b2 = *(const LAS v4i16_t*)(GR + 1024 + 2 * 512 + l15 * 32 + g * 8);
                  yacc = __builtin_amdgcn_mfma_f32_16x16x32_bf16(mk8(a2, b2), zv, yacc, 0, 0, 0); }
#pragma unroll
                for (int r = 0; r < 4; ++r) YB[(4 * r + g) * 64 + 16 * wq + l15] = yacc[r];
                const LAS unsigned char* ua = OPS + RW_O_NB + (4 * g + q4) * RW_MS + 4 * p4 * 2;
#pragma unroll
                for (int kb = 0; kb < 4; ++kb) {
                    const v4i16_t lo = ldtr(ua + kb * 32), hh = ldtr(ua + (RW_O_KA - RW_O_NB) + kb * 32);
                    const f32x4 d = __builtin_amdgcn_mfma_f32_16x16x32_bf16(mk8(lo, hh), zv, st[kb], 0, 0, 0);
                    st[kb] = d * *(const LAS f32x4*)(OPS + RW_O_PL + (16 * kb + 4 * g) * 4);
                }
#pragma unroll
                for (int m = 0; m < 2; ++m) sb[m] = pack8(st[2 * m][0], st[2 * m][1], st[2 * m][2], st[2 * m][3], st[2 * m + 1][0], st[2 * m + 1][1], st[2 * m + 1][2], st[2 * m + 1][3]);
            }
            if (it >= 3) {
                const int bi = it - 3;
                const LAS float* YB = (const LAS float*)(base + RW_OFF_YB + (bi & 1) * 4096);
                const u32x2 vw = *(const LAS u32x2*)(base + RW_OFF_VV + (bi & 3) * RW_MAT + rw_tau(pt) * RW_MS + pq * 8);
                const f32x4 v = {bflo(vw.x), bfhi(vw.x), bflo(vw.y), bfhi(vw.y)};
                const float bon = *(const LAS float*)(base + RW_OFF_BON + (bi & 3) * 64 + pt * 4);
                const size_t o = (rowbase + bi * RW_T + pt) * DM + cb;
                const u32x2 gg = pg_g;
                const f32x4 y = *(const LAS f32x4*)(YB + pt * 64 + 4 * pq);
                float s1 = (y.x + y.y) + (y.z + y.w), s2 = (y.x * y.x + y.y * y.y) + (y.z * y.z + y.w * y.w);
                red16x2(s1, s2);
                const float mu = s1 * (1.0f / 64.0f);
                const f32x4 d = y - mu;
                const float var = fmaxf(s2 * (1.0f / 64.0f) - mu * mu, 0.f);
                const f32x4 oo = d * __builtin_amdgcn_rsqf(var + GN_EPS) * gwc + gbc + bon * v;
                u32x2 w; w.x = pkbf(oo.x * siluf(bflo(gg.x)), oo.y * siluf(bfhi(gg.x))); w.y = pkbf(oo.z * siluf(bflo(gg.y)), oo.w * siluf(bfhi(gg.y)));
                *(GAS u32x2*)(out + o) = w;
            }
            if (it + 1 < NB) RW_LWSCAN((it + 1) & 1);
            __syncthreads();
        }
    }
#undef RW_LWSCAN
#undef RW_LWLOAD
}

typedef float f32x4v __attribute__((ext_vector_type(4)));
typedef float f32x2v __attribute__((ext_vector_type(2)));
__device__ __forceinline__ int sw_off(int row, int chunk) { return row * 256 + ((chunk ^ (row & 15)) << 4); }
constexpr int ML_QS = 0, ML_KS = 32768, ML_VS = 65536, ML_SW = 98304;
constexpr int ML_GA2 = MISC_OFF + 256, ML_GM2 = ML_GA2 + 512, ML_GBL = ML_GM2 + 512, ML_DEN = ML_GBL + 512, ML_NQ = ML_DEN + 512, ML_NV = ML_NQ + 512, ML_WSV = ML_NV + 512, ML_SC = ML_WSV + 512;
static_assert(ML_SC + 64 <= LDS_BYTES, "mlstm LDS");
constexpr int ML_SSQ = MISC_OFF + 4096, ML_RSTD = MISC_OFF + 6144;
static_assert(ML_SC + 64 <= ML_SSQ && ML_RSTD + 512 <= LDS_BYTES, "mlstm LDS (fused head norm)");
__device__ __forceinline__ void phase_mlstm(Frame& F, const bf16* proj, const float* GXp, const float* b_i, const float* b_f, bf16* hs, const float* h_gain, bf16* out, float* xch, unsigned* flags) {
    const int lane0 = F.lane, wave = F.wave;
    LAS unsigned char* L = F.lds;
#define ML_LANES() int lane = lane0; asm volatile("" : "+v"(lane)); const int tid = wave * 64 + lane, l15 = lane & 15, g = lane >> 4, q4 = l15 >> 2, p4 = lane & 3; (void)tid; (void)q4; (void)p4; (void)l15; (void)g
    LAS float* GA2 = (LAS float*)(L + ML_GA2); LAS float* GM2 = (LAS float*)(L + ML_GM2); LAS float* GBL = (LAS float*)(L + ML_GBL); LAS float* DEN = (LAS float*)(L + ML_DEN);
    LAS float* NQ = (LAS float*)(L + ML_NQ); LAS float* NV = (LAS float*)(L + ML_NV); LAS float* WSV = (LAS float*)(L + ML_WSV); LAS float* SC = (LAS float*)(L + ML_SC);
    constexpr float LOG2SC = -3.5f;
    LAS float* SSQ = (LAS float*)(L + ML_SSQ); LAS float* RSTD = (LAS float*)(L + ML_RSTD);
    for (int item = F.vcu; item < BATCH * 8 * 2; item += F.G) {
        const int b = item >> 4, h = (item >> 1) & 7, vh = item & 1;
        const size_t rowbase = (size_t)b * SEQ;
        const float bi = b_i[h], bfv = b_f[h];
        f32x4v st[8], nst;
#pragma unroll
        for (int kb = 0; kb < 8; ++kb) st[kb] = (f32x4v){0.f, 0.f, 0.f, 0.f};
        nst = (f32x4v){0.f, 0.f, 0.f, 0.f};
        __syncthreads();
        { ML_LANES(); if (tid < 128) NV[tid] = 0.f;
          if (tid == 0) { SC[0] = 0.f; SC[1] = 0.f; } }
        { ML_LANES(); SSQ[tid] = 0.f; }
        float* const xmine = xch + (size_t)item * 2048; const float* const xpart = xch + (size_t)(item ^ 1) * 2048;
        unsigned* const fmine = flags + item * 64; unsigned* const fpart = flags + (item ^ 1) * 64;
        u32x4 fh[4], fo[4], fg[4];
#define ML_FIN_LOAD(cf) do { ML_LANES(); const size_t r0_ = rowbase + (size_t)(cf) * 128; \
            _Pragma("unroll") for (int i = 0; i < 4; ++i) { const int idx = tid + 512 * i, row = idx >> 4, col = h * 256 + vh * 128 + (idx & 15) * 8; \
                fh[i] = *(const GAS u32x4*)(hs + (r0_ + row) * 2048 + col); fo[i] = *(const GAS u32x4*)(proj + (r0_ + row) * P2 + 4096 + col); fg[i] = *(const GAS u32x4*)(proj + (r0_ + row) * P2 + 6144 + col); } } while (0)
#define ML_FIN_DO(cf) do { ML_LANES(); const size_t r0_ = rowbase + (size_t)(cf) * 128; \
            _Pragma("unroll") for (int i = 0; i < 4; ++i) { const int idx = tid + 512 * i, row = idx >> 4, col = h * 256 + vh * 128 + (idx & 15) * 8; \
                const float rs_ = RSTD[row]; const f32x4 g0_ = *(const f32x4*)(h_gain + col), g1_ = *(const f32x4*)(h_gain + col + 4); u32x4 y_; \
                y_.x = pkbf(bflo(fh[i].x) * rs_ * g0_.x * sigmf(bflo(fo[i].x)) * siluf(bflo(fg[i].x)), bfhi(fh[i].x) * rs_ * g0_.y * sigmf(bfhi(fo[i].x)) * siluf(bfhi(fg[i].x))); \
                y_.y = pkbf(bflo(fh[i].y) * rs_ * g0_.z * sigmf(bflo(fo[i].y)) * siluf(bflo(fg[i].y)), bfhi(fh[i].y) * rs_ * g0_.w * sigmf(bfhi(fo[i].y)) * siluf(bfhi(fg[i].y))); \
                y_.z = pkbf(bflo(fh[i].z) * rs_ * g1_.x * sigmf(bflo(fo[i].z)) * siluf(bflo(fg[i].z)), bfhi(fh[i].z) * rs_ * g1_.y * sigmf(bfhi(fo[i].z)) * siluf(bfhi(fg[i].z))); \
                y_.w = pkbf(bflo(fh[i].w) * rs_ * g1_.z * sigmf(bflo(fo[i].w)) * siluf(bflo(fg[i].w)), bfhi(fh[i].w) * rs_ * g1_.w * sigmf(bfhi(fo[i].w)) * siluf(bfhi(fg[i].w))); \
                *(GAS u32x4*)(out + (r0_ + row) * 2048 + col) = y_; } } while (0)
#define ML_PUBLISH(cp) do { ML_LANES(); const f32x2v v_ = *(const LAS f32x2v*)(SSQ + ((cp) & 3) * 128 + 2 * lane); \
            __hip_atomic_store(xmine + (cp) * 128 + 2 * lane, v_.x, __ATOMIC_RELAXED, __HIP_MEMORY_SCOPE_AGENT); __hip_atomic_store(xmine + (cp) * 128 + 2 * lane + 1, v_.y, __ATOMIC_RELAXED, __HIP_MEMORY_SCOPE_AGENT); \
            asm volatile("s_waitcnt vmcnt(0)" ::: "memory"); \
            if (lane == 0) __hip_atomic_store(fmine, (unsigned)((cp) + 1), __ATOMIC_RELAXED, __HIP_MEMORY_SCOPE_AGENT); } while (0)
#define ML_RSTD(cf) do { ML_LANES(); int spins_ = 0; \
            while (__hip_atomic_load(fpart, __ATOMIC_RELAXED, __HIP_MEMORY_SCOPE_AGENT) < (unsigned)((cf) + 1) && ++spins_ < (1 << 22)) __builtin_amdgcn_s_sleep(2); \
            asm volatile("" ::: "memory"); \
            const float p0_ = __hip_atomic_load(xpart + (cf) * 128 + 2 * lane, __ATOMIC_RELAXED, __HIP_MEMORY_SCOPE_AGENT), p1_ = __hip_atomic_load(xpart + (cf) * 128 + 2 * lane + 1, __ATOMIC_RELAXED, __HIP_MEMORY_SCOPE_AGENT); \
            const f32x2v m_ = *(const LAS f32x2v*)(SSQ + ((cf) & 3) * 128 + 2 * lane); \
            RSTD[2 * lane] = __builtin_amdgcn_rsqf((m_.x + p0_) * (1.0f / 256.0f) + RMS_EPS); RSTD[2 * lane + 1] = __builtin_amdgcn_rsqf((m_.y + p1_) * (1.0f / 256.0f) + RMS_EPS); } while (0)
        u32x4 pfq[4], pfk[4], pfv[4];
#define ML_PREFETCH(cc) do { ML_LANES(); const bf16* qg_ = proj + (rowbase + (size_t)(cc) * 128) * P2 + h * 128; const bf16* vg_ = qg_ + 2048 + h * 128 + vh * 128; \
            _Pragma("unroll") for (int i = 0; i < 4; ++i) { const int idx = tid + 512 * i, row = idx >> 4, ch = idx & 15; \
                pfq[i] = *(const GAS u32x4*)(qg_ + (size_t)row * P2 + ch * 8); pfk[i] = *(const GAS u32x4*)(qg_ + (size_t)row * P2 + 1024 + ch * 8); pfv[i] = *(const GAS u32x4*)(vg_ + (size_t)row * P2 + ch * 8); } } while (0)
        ML_PREFETCH(0);
        float gpi0 = 0.f, gpi1 = 0.f, gpf0 = 0.f, gpf1 = 0.f;
        if (wave == 0) { ML_LANES(); const size_t rn = rowbase + 2 * lane; gpi0 = GXp[rn * 32 + h]; gpi1 = GXp[(rn + 1) * 32 + h]; gpf0 = GXp[rn * 32 + 8 + h]; gpf1 = GXp[(rn + 1) * 32 + 8 + h]; }
        for (int c = 0; c < 16; ++c) {
            const int par = c & 1;
            const size_t row0 = rowbase + (size_t)c * 128;
            {
                ML_LANES();
#pragma unroll
                for (int i = 0; i < 4; ++i) { const int idx = tid + 512 * i, row = idx >> 4, ch = idx & 15;
                    const int o = sw_off(row, ch);
                    *(LAS u32x4*)(L + ML_QS + o) = pfq[i]; *(LAS u32x4*)(L + ML_KS + o) = pfk[i]; *(LAS u32x4*)(L + ML_VS + o) = pfv[i]; }
            }
            if (c >= 2) ML_FIN_LOAD(c - 2);
            if (wave == 0) {
                ML_LANES();
                const int t0 = 2 * lane;
                const float i0 = gpi0 + bi, i1 = gpi1 + bi;
                const float f0 = logsigf(gpf0 + bfv), f1 = logsigf(gpf1 + bfv);
                if (c + 1 < 16) { const size_t rn = row0 + 128 + t0; gpi0 = GXp[rn * 32 + h]; gpi1 = GXp[(rn + 1) * 32 + h]; gpf0 = GXp[rn * 32 + 8 + h]; gpf1 = GXp[(rn + 1) * 32 + 8 + h]; }
                const float pr = f0 + f1; float incl = pr;
#pragma unroll
                for (int o = 1; o < 64; o <<= 1) { const float y = __shfl_up(incl, o); if (lane >= o) incl += y; }
                const float excl = incl - pr, b0 = excl + f0, b1 = excl + pr;
                const float a0 = i0 - b0, a1 = i1 - b1;
                float im = fmaxf(a0, a1);
#pragma unroll
                for (int o = 1; o < 64; o <<= 1) { const float y = __shfl_up(im, o); if (lane >= o) im = fmaxf(im, y); }
                float exm = __shfl_up(im, 1); if (lane == 0) exm = -INFINITY;
                const float mprev = SC[par];
                const float M0 = fmaxf(mprev, fmaxf(exm, a0)), M1 = fmaxf(mprev, im);
                const float M127 = __shfl(M1, 63), g127 = __shfl(b1, 63);
                GA2[t0] = a0 * LOG2E; GA2[t0 + 1] = a1 * LOG2E; GM2[t0] = M0 * LOG2E; GM2[t0 + 1] = M1 * LOG2E;
                GBL[t0] = (b0 + M0) * LOG2E; GBL[t0 + 1] = (b1 + M1) * LOG2E; DEN[t0] = 0.f; DEN[t0 + 1] = 0.f;
                WSV[t0] = __builtin_amdgcn_exp2f((a0 - M127) * LOG2E); WSV[t0 + 1] = __builtin_amdgcn_exp2f((a1 - M127) * LOG2E);
                if (lane == 0) { SC[par ^ 1] = g127 + M127; SC[2] = M127 * LOG2E; }
            }
            else if (wave == 1) { if (c >= 1) ML_PUBLISH(c - 1); { ML_LANES(); *(LAS f32x2v*)(SSQ + ((c + 1) & 3) * 128 + 2 * lane) = (f32x2v){0.f, 0.f}; } }
            else if (wave == 2) { if (c >= 2) ML_RSTD(c - 2); }
            __syncthreads();
            const float m2 = SC[par] * LOG2E, M2_127 = SC[2];
            {
            ML_LANES();
            for (int idx = wave; idx < 40; idx += 8) {
                int tb, bs; if (idx < 2) { tb = 0; bs = 0; } else if (idx < 4) { tb = 1; bs = 2; } else if (idx < 8) { tb = 2; bs = 4; } else if (idx < 12) { tb = 3; bs = 8; }
                else if (idx < 18) { tb = 4; bs = 12; } else if (idx < 24) { tb = 5; bs = 18; } else if (idx < 32) { tb = 6; bs = 24; } else { tb = 7; bs = 32; }
                const int sb = idx - bs;
                f32x4v acc = (f32x4v){0.f, 0.f, 0.f, 0.f};
                const int srow = 16 * sb + l15, trow = 16 * tb + l15;
#pragma unroll
                for (int ks = 0; ks < 4; ++ks) {
                    const bf16x8 af = *(const LAS bf16x8*)(L + ML_KS + sw_off(srow, 4 * ks + g)), bfr = *(const LAS bf16x8*)(L + ML_QS + sw_off(trow, 4 * ks + g));
                    acc = __builtin_amdgcn_mfma_f32_16x16x32_bf16(af, bfr, acc, 0, 0, 0); }
                const float M2t = GM2[trow]; const f32x4v a2 = *(const LAS f32x4v*)(GA2 + 16 * sb + 4 * g);
                float val[4];
#pragma unroll
                for (int r = 0; r < 4; ++r) { const int s = 16 * sb + 4 * g + r; const float w = (s <= trow) ? __builtin_amdgcn_exp2f(a2[r] - M2t + LOG2SC) : 0.f; val[r] = acc[r] * w; }
                float d = (val[0] + val[1]) + (val[2] + val[3]); d += __shfl_xor(d, 16); d += __shfl_xor(d, 32);
                if (g == 0) __hip_atomic_fetch_add(DEN + trow, d, __ATOMIC_RELAXED, __HIP_MEMORY_SCOPE_WORKGROUP);
                u32x2 pk; pk.x = pkbf(val[0], val[1]); pk.y = pkbf(val[2], val[3]);
                *(LAS u32x2*)(L + ML_SW + sw_off(trow, 2 * sb + (g >> 1)) + (g & 1) * 8) = pk;
            }
            {
                const int trow = 16 * wave + l15; float s = 0.f;
#pragma unroll
                for (int i = 0; i < 4; ++i) { const u32x4 qv = *(const LAS u32x4*)(L + ML_QS + sw_off(trow, 4 * g + i));
                    const f32x4v n0 = *(const LAS f32x4v*)(NV + 32 * g + 8 * i), n1 = *(const LAS f32x4v*)(NV + 32 * g + 8 * i + 4);
                    s += bflo(qv.x) * n0.x + bfhi(qv.x) * n0.y + bflo(qv.y) * n0.z + bfhi(qv.y) * n0.w + bflo(qv.z) * n1.x + bfhi(qv.z) * n1.y + bflo(qv.w) * n1.z + bfhi(qv.w) * n1.w; }
                s += __shfl_xor(s, 16); s += __shfl_xor(s, 32);
                if (g == 0) NQ[trow] = s;
            }
            }
            if (c >= 2) ML_FIN_DO(c - 2);
            __syncthreads();
            f32x4v num[8];
            {
                ML_LANES();
                bf16x8 cf[4];
#pragma unroll
                for (int kp = 0; kp < 4; ++kp) cf[kp] = pack8(st[2 * kp][0], st[2 * kp][1], st[2 * kp][2], st[2 * kp][3], st[2 * kp + 1][0], st[2 * kp + 1][1], st[2 * kp + 1][2], st[2 * kp + 1][3]);
#pragma unroll
                for (int tb = 0; tb < 8; ++tb) {
                    const int trow = 16 * tb + l15; f32x4v acc = (f32x4v){0.f, 0.f, 0.f, 0.f};
#pragma unroll
                    for (int kp = 0; kp < 4; ++kp) {
                        const u32x2 lo = *(const LAS u32x2*)(L + ML_QS + sw_off(trow, 4 * kp + (g >> 1)) + (g & 1) * 8), hh = *(const LAS u32x2*)(L + ML_QS + sw_off(trow, 4 * kp + 2 + (g >> 1)) + (g & 1) * 8);
                        const u32x4 bw = {lo.x, lo.y, hh.x, hh.y};
                        acc = __builtin_amdgcn_mfma_f32_16x16x32_bf16(cf[kp], __builtin_bit_cast(bf16x8, bw), acc, 0, 0, 0); }
                    const float wi = __builtin_amdgcn_exp2f(m2 - GM2[trow] + LOG2SC);
                    num[tb] = acc * wi;
                    asm volatile("" ::: "memory");
                }
            }
            bf16x8 vfr[4];
            {
            ML_LANES();
#pragma unroll
            for (int sc = 0; sc < 4; ++sc) {
                const int rA = 32 * sc + 8 * g + q4, rB = rA + 4;
                const v4i16_t lo = ldtr(L + ML_VS + sw_off(rA, 2 * wave + (p4 >> 1)) + (p4 & 1) * 8), hh = ldtr(L + ML_VS + sw_off(rB, 2 * wave + (p4 >> 1)) + (p4 & 1) * 8);
                vfr[sc] = mk8(lo, hh);
#pragma unroll
                for (int tb = 0; tb < 8; ++tb) if (tb >= 2 * sc) {
                    const int trow = 16 * tb + l15;
                    const bf16x8 bfr = *(const LAS bf16x8*)(L + ML_SW + sw_off(trow, 4 * sc + g));
                    num[tb] = __builtin_amdgcn_mfma_f32_16x16x32_bf16(vfr[sc], bfr, num[tb], 0, 0, 0); }
                asm volatile("" ::: "memory");
            }
            float hsq[8];
#pragma unroll
            for (int tb = 0; tb < 8; ++tb) {
                const int trow = 16 * tb + l15;
                const float den = __builtin_amdgcn_exp2f(m2 - GM2[trow] + LOG2SC) * NQ[trow] + DEN[trow];
                const float rd = 1.0f / fmaxf(fabsf(den), __builtin_amdgcn_exp2f(-GBL[trow]));
                const f32x4v hv = num[tb] * rd; u32x2 hw; hw.x = pkbf(hv.x, hv.y); hw.y = pkbf(hv.z, hv.w);
                *(GAS u32x2*)(hs + (row0 + trow) * 2048 + h * 256 + vh * 128 + 16 * wave + 4 * g) = hw;
                hsq[tb] = (hv.x * hv.x + hv.y * hv.y) + (hv.z * hv.z + hv.w * hv.w);
            }
#pragma unroll
            for (int tb = 0; tb < 8; ++tb) hsq[tb] += __shfl_xor(hsq[tb], 16);
#pragma unroll
            for (int tb = 0; tb < 8; ++tb) hsq[tb] += __shfl_xor(hsq[tb], 32);
            if (g == 0) {
#pragma unroll
                for (int tb = 0; tb < 8; ++tb) __hip_atomic_fetch_add(SSQ + (c & 3) * 128 + 16 * tb + l15, hsq[tb], __ATOMIC_RELAXED, __HIP_MEMORY_SCOPE_WORKGROUP);
            }
            }
            if (c + 1 < 16) ML_PREFETCH(c + 1);
            {
                ML_LANES();
                const float cs = __builtin_amdgcn_exp2f(m2 - M2_127);
#pragma unroll
                for (int sc = 0; sc < 4; ++sc) {
                    const f32x4v wa = *(const LAS f32x4v*)(WSV + 32 * sc + 8 * g), wb = *(const LAS f32x4v*)(WSV + 32 * sc + 8 * g + 4);
                    const u32x4 vw = __builtin_bit_cast(u32x4, vfr[sc]);
                    vfr[sc] = pack8(bflo(vw.x) * wa.x, bfhi(vw.x) * wa.y, bflo(vw.y) * wa.z, bfhi(vw.y) * wa.w, bflo(vw.z) * wb.x, bfhi(vw.z) * wb.y, bflo(vw.w) * wb.z, bfhi(vw.w) * wb.w);
                }
#pragma unroll
                for (int kb = 0; kb < 8; ++kb) {
                    f32x4v acc = st[kb] * cs;
#pragma unroll
                    for (int sc = 0; sc < 4; ++sc) {
                        const int rA = 32 * sc + 8 * g + q4, rB = rA + 4;
                        const v4i16_t lo = ldtr(L + ML_KS + sw_off(rA, 2 * kb + (p4 >> 1)) + (p4 & 1) * 8), hh = ldtr(L + ML_KS + sw_off(rB, 2 * kb + (p4 >> 1)) + (p4 & 1) * 8);
                        acc = __builtin_amdgcn_mfma_f32_16x16x32_bf16(mk8(lo, hh), vfr[sc], acc, 0, 0, 0);
                    }
                    st[kb] = acc;
                    asm volatile("" ::: "memory");
                }
                f32x4v nacc = nst * cs;
#pragma unroll
                for (int sc = 0; sc < 4; ++sc) {
                    const int rA = 32 * sc + 8 * g + q4, rB = rA + 4;
                    const v4i16_t lo = ldtr(L + ML_KS + sw_off(rA, 2 * wave + (p4 >> 1)) + (p4 & 1) * 8), hh = ldtr(L + ML_KS + sw_off(rB, 2 * wave + (p4 >> 1)) + (p4 & 1) * 8);
                    const f32x4v wa = *(const LAS f32x4v*)(WSV + 32 * sc + 8 * g), wb = *(const LAS f32x4v*)(WSV + 32 * sc + 8 * g + 4);
                    nacc = __builtin_amdgcn_mfma_f32_16x16x32_bf16(mk8(lo, hh), pack8(wa.x, wa.y, wa.z, wa.w, wb.x, wb.y, wb.z, wb.w), nacc, 0, 0, 0);
                }
                nst = nacc;
                if (l15 == 0) *(LAS f32x4v*)(NV + 16 * wave + 4 * g) = nst;
            }
            __syncthreads();
        }
        if (wave == 1) ML_PUBLISH(15); else if (wave == 2) ML_RSTD(14);
        ML_FIN_LOAD(14);
        __syncthreads();
        ML_FIN_DO(14);
        __syncthreads();
        if (wave == 2) ML_RSTD(15);
        ML_FIN_LOAD(15);
        __syncthreads();
        ML_FIN_DO(15);
    }
}
#undef ML_FIN_LOAD
#undef ML_FIN_DO
#undef ML_PUBLISH
#undef ML_RSTD
#undef ML_PREFETCH
#undef ML_LANES
__device__ __forceinline__ void phase_mlstm_post(Frame& F, const bf16* hs, const bf16* proj, const float* h_gain, bf16* out) {
    const int gw = F.vcu * NWAVES + F.wave, NGW = F.G * NWAVES;
    for (int m = gw; m < MROWS; m += NGW) {
        const GAS u32x2* xr = (const GAS u32x2*)(hs + (size_t)m * DM) + F.lane;
        const bf16* pr = proj + (size_t)m * P2;
        GAS unsigned long long* o8 = (GAS unsigned long long*)(out + (size_t)m * DM) + F.lane;
        u32x2 vw[8], ov[8], gv[8]; float ss[8];
#pragma unroll
        for (int j = 0; j < 8; ++j) { const int c = (F.lane + 64 * j) * 4; vw[j] = xr[64 * j]; ov[j] = *(const GAS u32x2*)(pr + 4096 + c); gv[j] = *(const GAS u32x2*)(pr + 6144 + c); }
#pragma unroll
        for (int j = 0; j < 8; ++j) { const float a = bflo(vw[j].x), b = bfhi(vw[j].x), c = bflo(vw[j].y), e = bfhi(vw[j].y); ss[j] = (a * a + b * b) + (c * c + e * e); }
#pragma unroll
        for (int o = 1; o < 64; o <<= 1)
#pragma unroll
            for (int j = 0; j < 8; ++j) ss[j] += __shfl_xor(ss[j], o);
#pragma unroll
        for (int j = 0; j < 8; ++j) {
            const float rstd = 1.0f / sqrtf(ss[j] * (1.0f / 256.0f) + RMS_EPS);
            const int c = (F.lane + 64 * j) * 4;
            const f32x4 hg = *(const f32x4*)(h_gain + c);
            const float y0 = bflo(vw[j].x) * rstd * hg.x * sigmf(bflo(ov[j].x)) * siluf(bflo(gv[j].x)), y1 = bfhi(vw[j].x) * rstd * hg.y * sigmf(bfhi(ov[j].x)) * siluf(bfhi(gv[j].x));
            const float y2 = bflo(vw[j].y) * rstd * hg.z * sigmf(bflo(ov[j].y)) * siluf(bflo(gv[j].y)), y3 = bfhi(vw[j].y) * rstd * hg.w * sigmf(bfhi(ov[j].y)) * siluf(bfhi(gv[j].y));
            o8[64 * j] = (unsigned long long)pkbf(y0, y1) | ((unsigned long long)pkbf(y2, y3) << 32);
        }
    }
}

constexpr int FX_KS = 0, FX_VS = 9216, FX_FB = 9216 + 8192, FX_BUF = 9216 + 8192 + 256;
__device__ __forceinline__ u32x4 fox_knorm(u32x4 kv, f32x4 g0, f32x4 g1) {
    float e[8] = {bflo(kv.x), bfhi(kv.x), bflo(kv.y), bfhi(kv.y), bflo(kv.z), bfhi(kv.z), bflo(kv.w), bfhi(kv.w)}; float ss = 0.f;
#pragma unroll
    for (int i = 0; i < 8; ++i) ss += e[i] * e[i];
    ss += __builtin_bit_cast(float, __builtin_amdgcn_mov_dpp(__builtin_bit_cast(int, ss), 0xB1, 0xf, 0xf, true));
    ss += __builtin_bit_cast(float, __builtin_amdgcn_mov_dpp(__builtin_bit_cast(int, ss), 0x4E, 0xf, 0xf, true));
    ss += __builtin_bit_cast(float, __builtin_amdgcn_mov_dpp(__builtin_bit_cast(int, ss), 0x141, 0xf, 0xf, true));
    const float r = __builtin_amdgcn_rsqf(ss * (1.0f / 64.0f) + RMS_EPS);
    u32x4 o; o.x = pkbf(e[0] * r * g0.x, e[1] * r * g0.y); o.y = pkbf(e[2] * r * g0.z, e[3] * r * g0.w); o.z = pkbf(e[4] * r * g1.x, e[5] * r * g1.y); o.w = pkbf(e[6] * r * g1.z, e[7] * r * g1.w); return o;
}
constexpr int FX_FL = 2 * FX_BUF;
__device__ __forceinline__ void phase_fox_attn(Frame& F, const bf16* proj, const float* GXp, const float* b_f, const float* q_gain, const float* k_gain, bf16* og, unsigned* qctr) {
    const int lane = F.lane, r32 = lane & 31, hi = lane >> 5, wave = F.wave, tid = F.tid;
    const int g16 = lane >> 4, q4 = (lane & 15) >> 2, p4 = lane & 3;
    LAS unsigned char* L = F.lds;
    const int srow = tid >> 3, sch = tid & 7;
    LAS float* KG = (LAS float*)(L + FX_FL + 8192 + 32768 + 256);
    if (tid < 64) KG[tid] = k_gain[tid];
#define kg0 (*(const LAS f32x4*)(KG + sch * 8))
#define kg1 (*(const LAS f32x4*)(KG + sch * 8 + 4))
    float gqm = fabsf(q_gain[lane]), gkm = fabsf(k_gain[lane]);
#pragma unroll
    for (int o = 1; o < 64; o <<= 1) { gqm = fmaxf(gqm, __shfl_xor(gqm, o)); gkm = fmaxf(gkm, __shfl_xor(gkm, o)); }
    const float QKB = 64.0f * gqm * gkm * (0.125f * LOG2E) * 1.03f;
    LAS unsigned* DN = (LAS unsigned*)(L + FX_FL + 8192 + 32768);
    LAS unsigned* QW = DN + 16;
    if (wave == 0 && lane < 32) { const float mine = b_f[lane]; int rank = 0;
        for (int o = 0; o < 32; ++o) { const float other = b_f[o]; rank += (other > mine || (other == mine && o < lane)) ? 1 : 0; }
        QW[1 + rank] = (unsigned)lane; }
    const int lane_o = lane;
    for (;;) {
        int lane = lane_o; asm volatile("" : "+v"(lane));
        const int r32 = lane & 31, hi = lane >> 5, tid = wave * 64 + lane, g16 = lane >> 4, q4 = (lane & 15) >> 2, p4 = lane & 3, srow = tid >> 3, sch = tid & 7;
        __syncthreads();
        if (tid == 0) QW[0] = __hip_atomic_fetch_add(qctr, 1u, __ATOMIC_RELAXED, __HIP_MEMORY_SCOPE_AGENT);
        __syncthreads();
        const unsigned unit = QW[0];
        if (unit >= (unsigned)(BATCH * 32)) break;
        const int h = (int)QW[1 + (unit >> 4)], b = (int)(unit & 15u), bh = b * 32 + h; (void)bh;
        const size_t rowbase = (size_t)b * SEQ;
        const LAS float* Fp = (const LAS float*)(L + FX_FL);
        if (wave == 0) {
            const float bf = b_f[h];
            const float* gp = GXp + (rowbase + lane * 32) * 32 + h;
            float acc[32]; float run = 0.f;
#pragma unroll
            for (int i = 0; i < 32; ++i) { run += logsigf(gp[i * 32] + bf); acc[i] = run; }
            float incl = run;
            int ln = lane; asm volatile("" : "+v"(ln));
#pragma unroll
            for (int o = 1; o < 64; o <<= 1) { const float y = __builtin_bit_cast(float, __builtin_amdgcn_ds_bpermute((ln - o) << 2, __builtin_bit_cast(int, incl))); if (ln >= o) incl += y; }
            const float excl = incl - run;
            LAS float* op = (LAS float*)(L + FX_FL) + lane * 32;
#pragma unroll
            for (int i = 0; i < 32; i += 4) *(LAS f32x4*)(op + i) = (f32x4){(acc[i] + excl) * LOG2E, (acc[i + 1] + excl) * LOG2E, (acc[i + 2] + excl) * LOG2E, (acc[i + 3] + excl) * LOG2E};
        }
        __syncthreads();
        const bf16* kbase = proj + rowbase * P3 + 2048 + h * 64 + sch * 8;
        u32x4 nq[4], nkv, nvv;
#define FX_PRELOAD(qbn) do { const size_t qr_ = rowbase + (qbn) * 256 + wave * 32 + r32; \
            _Pragma("unroll") for (int s4 = 0; s4 < 4; ++s4) nq[s4] = *(const GAS u32x4*)(proj + qr_ * P3 + h * 64 + s4 * 16 + hi * 8); \
            const size_t kr_ = (size_t)((4 * ((qbn) + 1) - 1) * 64 + srow) * P3; nkv = *(const GAS u32x4*)(kbase + kr_); nvv = *(const GAS u32x4*)(kbase + kr_ + 2048); } while (0)
        FX_PRELOAD(7);
        for (int qb = 7; qb >= 0; --qb) {
            const int q0 = qb * 256, NT = 4 * (qb + 1);
            bf16x8 qfr[4];
            {
                u32x4 qraw[4]; float ss = 0.f;
#pragma unroll
                for (int s4 = 0; s4 < 4; ++s4) { qraw[s4] = nq[s4];
#pragma unroll
                    for (int i = 0; i < 4; ++i) { const float a = bflo(qraw[s4][i]), c = bfhi(qraw[s4][i]); ss += a * a + c * c; } }
                ss += __shfl_xor(ss, 32);
                const float qsc = (0.125f * LOG2E) * __builtin_amdgcn_rsqf(ss * (1.0f / 64.0f) + RMS_EPS);
#pragma unroll
                for (int s4 = 0; s4 < 4; ++s4) { const f32x4 g0 = *(const f32x4*)(q_gain + s4 * 16 + hi * 8), g1 = *(const f32x4*)(q_gain + s4 * 16 + hi * 8 + 4);
                    qfr[s4] = pack8(bflo(qraw[s4].x) * qsc * g0.x, bfhi(qraw[s4].x) * qsc * g0.y, bflo(qraw[s4].y) * qsc * g0.z, bfhi(qraw[s4].y) * qsc * g0.w,
                                    bflo(qraw[s4].z) * qsc * g1.x, bfhi(qraw[s4].z) * qsc * g1.y, bflo(qraw[s4].w) * qsc * g1.z, bfhi(qraw[s4].w) * qsc * g1.w); }
            }
            const float Fref = Fp[q0];
            const int qpos = q0 + wave * 32 + r32;
            float mrun = -1e30f, lsum = 0.f;
            f32x16 O[2];
#pragma unroll
            for (int r = 0; r < 16; ++r) { O[0][r] = 0.f; O[1][r] = 0.f; }
            __syncthreads();
            {
                const u32x4 kv = nkv, vv = nvv;
                *(LAS u32x4*)(L + FX_KS + srow * 144 + sch * 16) = fox_knorm(kv, kg0, kg1);
                *(LAS u32x4*)(L + FX_VS + (sch >> 2) * 4096 + srow * 64 + (sch & 3) * 16) = vv;
                if (tid < 64) *(LAS float*)(L + FX_FB + tid * 4) = Fref - Fp[(NT - 1) * 64 + tid];
            }
            __syncthreads();
            bool wdone = false;
            u32x4 kvA = {0u, 0u, 0u, 0u}, vvA = {0u, 0u, 0u, 0u}, kvB = {0u, 0u, 0u, 0u}, vvB = {0u, 0u, 0u, 0u};
            { const size_t kr = (size_t)((NT - 2) * 64 + srow) * P3; kvA = *(const GAS u32x4*)(kbase + kr); vvA = *(const GAS u32x4*)(kbase + kr + 2048); }
            auto step = [&](const int tt, const u32x4& kvS, const u32x4& vvS, u32x4& kvL, u32x4& vvL) -> bool {
                const int t = NT - 1 - tt;
                LAS unsigned char* cur = L + (tt & 1) * FX_BUF; LAS unsigned char* nxt = L + ((tt + 1) & 1) * FX_BUF;
                if (tt + 2 < NT) { const size_t kr = (size_t)((t - 2) * 64 + srow) * P3; kvL = *(const GAS u32x4*)(kbase + kr); vvL = *(const GAS u32x4*)(kbase + kr + 2048); }
                const int k0 = t * 64;
                if (k0 <= q0 + wave * 32 + 31 && !wdone) {
                    f32x16 S[2];
                    const bool diag = (k0 + 63 > q0 + wave * 32);
                    {
                        bf16x8 kf[2][4];
#pragma unroll
                        for (int kb = 0; kb < 2; ++kb) { const LAS unsigned char* kp = cur + FX_KS + (32 * kb + r32) * 144 + hi * 16;
#pragma unroll
                            for (int s4 = 0; s4 < 4; ++s4) kf[kb][s4] = *(const LAS bf16x8*)(kp + s4 * 32); }
#pragma unroll
                        for (int kb = 0; kb < 2; ++kb)
#pragma unroll
                            for (int g4 = 0; g4 < 4; ++g4) { const f32x4 fbv = *(const LAS f32x4*)(cur + FX_FB + (32 * kb + 8 * g4 + 4 * hi) * 4);
                                S[kb][4 * g4 + 0] = fbv.x; S[kb][4 * g4 + 1] = fbv.y; S[kb][4 * g4 + 2] = fbv.z; S[kb][4 * g4 + 3] = fbv.w; }
                        __builtin_amdgcn_sched_barrier(0);
#pragma unroll
                        for (int s4 = 0; s4 < 4; ++s4) { S[0] = __builtin_amdgcn_mfma_f32_32x32x16_bf16(kf[0][s4], qfr[s4], S[0], 0, 0, 0); S[1] = __builtin_amdgcn_mfma_f32_32x32x16_bf16(kf[1][s4], qfr[s4], S[1], 0, 0, 0); }
                        __builtin_amdgcn_sched_barrier(0);
                        if (diag) {
#pragma unroll
                            for (int kb = 0; kb < 2; ++kb)
#pragma unroll
                                for (int r = 0; r < 16; ++r) { const int kpos = k0 + 32 * kb + crow(r, hi); S[kb][r] = (kpos <= qpos) ? S[kb][r] : -INFINITY; } }
                    }
                    float mx = fmaxf(S[0][0], S[1][0]);
#pragma unroll
                    for (int r = 1; r < 16; ++r) mx = fmaxf(mx, fmaxf(S[0][r], S[1][r]));
                    mx = fmaxf(mx, __shfl_xor(mx, 32));
                    if (__any(mx > mrun)) {
                        mx = fmaxf(mx, mrun);
                        const float alpha = __builtin_amdgcn_exp2f(mrun - mx);
                        mrun = mx; lsum *= alpha;
#pragma unroll
                        for (int r = 0; r < 16; ++r) { O[0][r] *= alpha; O[1][r] *= alpha; }
                    }
                    float ps = 0.f;
#pragma unroll
                    for (int r = 0; r < 16; ++r) { const float p0 = __builtin_amdgcn_exp2f(S[0][r] - mrun), p1 = __builtin_amdgcn_exp2f(S[1][r] - mrun); S[0][r] = p0; S[1][r] = p1; ps += p0 + p1; }
                    lsum += ps;
#pragma unroll
                    for (int kb = 0; kb < 2; ++kb)
#pragma unroll
                        for (int s2 = 0; s2 < 2; ++s2) {
                            const bf16x8 pf = pack8(S[kb][8 * s2 + 0], S[kb][8 * s2 + 1], S[kb][8 * s2 + 2], S[kb][8 * s2 + 3], S[kb][8 * s2 + 4], S[kb][8 * s2 + 5], S[kb][8 * s2 + 6], S[kb][8 * s2 + 7]);
#pragma unroll
                            for (int db = 0; db < 2; ++db) {
                                const LAS unsigned char* va = cur + FX_VS + db * 4096 + (32 * kb + 16 * s2 + 4 * (g16 >> 1) + q4) * 64 + (g16 & 1) * 32 + p4 * 8;
                                const v4i16_t lo = ldtr(va), hh = ldtr(va + 512);
                                O[db] = __builtin_amdgcn_mfma_f32_32x32x16_bf16(mk8(lo, hh), pf, O[db], 0, 0, 0);
                            }
                        }
                }
                if (tt + 1 < NT) {
                    *(LAS u32x4*)(nxt + FX_KS + srow * 144 + sch * 16) = fox_knorm(kvS, kg0, kg1);
                    *(LAS u32x4*)(nxt + FX_VS + (sch >> 2) * 4096 + srow * 64 + (sch & 3) * 16) = vvS;
                    if (tid < 64) *(LAS float*)(nxt + FX_FB + tid * 4) = Fref - Fp[(t - 1) * 64 + tid];
                    const float nb = Fref - Fp[(t - 1) * 64 + 63];
                    wdone = wdone || __all(nb + QKB <= mrun - 40.0f);
                    if (lane == 0) DN[(tt & 1) * 8 + wave] = wdone ? 1u : 0u;
                }
                __syncthreads();
                if (tt + 1 < NT) { const u32x4 d0 = *(const LAS u32x4*)(DN + (tt & 1) * 8), d1 = *(const LAS u32x4*)(DN + (tt & 1) * 8 + 4);
                    if ((d0.x & d0.y & d0.z & d0.w & d1.x & d1.y & d1.z & d1.w) != 0u) return true; }
                return false;
            };
            for (int tt = 0; tt < NT; tt += 2) {
                if (step(tt, kvA, vvA, kvB, vvB)) break;
                if (step(tt + 1, kvB, vvB, kvA, vvA)) break;
            }
            lsum += __shfl_xor(lsum, 32);
            const float rl = 1.0f / lsum;
            FX_PRELOAD(qb > 0 ? qb - 1 : 0);
            { const size_t row0 = rowbase + q0 + wave * 32;
              attn_epilogue(O, rl, proj + row0 * P3 + 6144 + h * 64, P3, og + row0 * 2048 + h * 64, L + FX_FL + 8192 + wave * 4096, lane); }
        }
#undef FX_PRELOAD
    }
#undef kg0
#undef kg1
}

#ifndef MK_SINGLE
#define MK_SINGLE 1
#endif
#ifndef MK_LAYERS
#define MK_LAYERS 4
#endif
#ifndef MK_DUP
#define MK_DUP 0
#endif
#ifndef MK_AMP
#define MK_AMP 1.0f
#endif
enum { I_X = 0, I_REL, I_SWA_NORM, I_SWA_WIN, I_SWA_QG, I_SWA_KG, I_SWA_SINK, I_SWA_WOUT,
       I_RW_NORM, I_RW_MIX, I_RW_WIN, I_RW_W0, I_RW_WL1, I_RW_WL2, I_RW_A0, I_RW_AL1, I_RW_AL2, I_RW_KK, I_RW_KA, I_RW_RK, I_RW_GNW, I_RW_GNB, I_RW_WOUT,
       I_ML_NORM, I_ML_WIN, I_ML_BI, I_ML_BF, I_ML_HG, I_ML_WOUT,
       I_FX_NORM, I_FX_WIN, I_FX_BF, I_FX_QG, I_FX_KG, I_FX_WOUT, N_IN };
struct Args { const float* in[N_IN]; float* out; unsigned char* ws; int ph_lo, ph_hi; };
constexpr int NPH_L0 = 4;
constexpr int NPH_L1 = 6;
constexpr int NPH_L2 = 4;
constexpr int NPH_L3 = 4;
constexpr int NPH = (MK_LAYERS >= 1 ? NPH_L0 : 0) + (MK_LAYERS >= 2 ? NPH_L1 : 0) + (MK_LAYERS >= 3 ? NPH_L2 : 0) + (MK_LAYERS >= 4 ? NPH_L3 : 0);

__global__ void __launch_bounds__(NWAVES * 64, 2) fwd(Args args) {
    extern __shared__ __attribute__((aligned(16))) unsigned char lds_raw[];
    Frame F;
    F.lds = (LAS unsigned char*)lds_raw;
    F.tid = threadIdx.x; F.lane = F.tid & 63; F.wave = __builtin_amdgcn_readfirstlane(F.tid >> 6);
    F.G = gridDim.x; { const int bx = blockIdx.x; F.vcu = (F.G % 8 == 0) ? (bx % 8) * (F.G / 8) + bx / 8 : bx; }
    F.cvi = F.vcu; F.cvn = F.G;
    unsigned char* ws = args.ws;
    gu32* ctl = (gu32*)(ws + WS_CTL);
    if (F.tid < 16) ((LAS unsigned*)(F.lds + MISC_OFF))[F.tid] = 0u;
    __syncthreads();
    const int lo = args.ph_lo, hi = args.ph_hi;
    XcdBarrier bar; bar.bar = (unsigned*)(ctl + CW_BAR); bar.x = 0; bar.st = nullptr;
    if (hi - lo > 1) bar = xcd_barrier_post((unsigned*)(ctl + CW_BAR), (volatile LAS unsigned*)(F.lds + MISC_OFF + 32));
#define IN(k) (lo <= (k) && (k) < hi)
#define SEAM(k) do { if (IN(k) && IN((k) + 1)) xcd_barrier(bar, F.wave); F.lane = fresh_lane(); F.tid = F.wave * 64 + F.lane; } while (0)
    bf16* const WB = (bf16*)(ws + WS_W); bf16* const WB3 = (bf16*)(ws + WS_W3);
    bf16* const S0 = (bf16*)(ws + WS_SLOT(0)); bf16* const S1 = (bf16*)(ws + WS_SLOT(1)); bf16* const S2 = (bf16*)(ws + WS_SLOT(2)); bf16* const S3 = (bf16*)(ws + WS_SLOT(3));
    bf16* const S4 = (bf16*)(ws + WS_SLOT(4)); bf16* const S5 = (bf16*)(ws + WS_SLOT(5)); bf16* const S6 = (bf16*)(ws + WS_SLOT(6));
    bf16* const L1B = (bf16*)(ws + WS_L1); float* const GX = (float*)(ws + WS_GX); float* const FB = (float*)(ws + WS_F); float* const RSB = (float*)(ws + WS_F + 2 * MiB);
    const float* const x_in = args.in[I_X]; float* const xo = args.out; bf16* const xb = (bf16*)args.out;
    int ph = 0;

    if (IN(ph)) {
        convert_matrix(F, args.in[I_SWA_WIN], 4608, 0, 2048, 4608, WB + W0_IN, 0);
        convert_matrix(F, args.in[I_SWA_WOUT], 2048, 0, 2048, 2048, WB + W0_OUT, 0);
        for (int rep = 0; rep < ((MK_DUP & 32) ? 2 : 1); ++rep) phase_norm<false>(F, x_in, args.in[I_SWA_NORM], S0);
    } SEAM(ph); ++ph;
    if (IN(ph)) {
        pg8::Gemm g{S0, WB + W0_IN, MROWS, 4608, 2048}; pg8::StaticOrder S; S.init(MROWS, 4608, F.G, (int)blockIdx.x);
        pg8::EpiStore E{S1, P0, 18, nullptr};
        for (int rep = 0; rep < ((MK_DUP & 16) ? 2 : 1); ++rep) pg8::gemm_phase<pg8::EpiStore, pg8::StaticOrder, false, true>(F.lds, g, S, E, F.wave);
    } SEAM(ph); ++ph;
    if (IN(ph)) { for (int rep = 0; rep < ((MK_DUP & 1) ? 2 : 1); ++rep) phase_swa(F, S1, args.in[I_SWA_QG], args.in[I_SWA_KG], args.in[I_SWA_SINK], args.in[I_REL], S0); } SEAM(ph); ++ph;
    if (IN(ph)) {
        pg8::Gemm g{S0, WB + W0_OUT, MROWS, 2048, 2048}; pg8::StaticOrder S; S.init(MROWS, 2048, F.G, (int)blockIdx.x);
        pg8::EpiResidX<false, true> E{x_in, xb, 2048};
        pg8::gemm_phase<pg8::EpiResidX<false, true>, pg8::StaticOrder, false, true>(F.lds, g, S, E, F.wave);
    } SEAM(ph); ++ph;

#if MK_LAYERS >= 2
    {
    const float* mix = args.in[I_RW_MIX];
    if (IN(ph)) {
        for (int c = 0; c < 4; ++c) convert_matrix(F, args.in[I_RW_WIN] + (size_t)c * 2048 * 2048, 2048, 0, 2048, 2048, WB + W1_IN + (size_t)c * 2048 * 2048, 0);
        convert_matrix(F, args.in[I_RW_WL1], 96, 0, 2048, 96, WB + W1_LA, 0);   zero_rows(F, WB + W1_LA, 2048, 96, 256);
        convert_matrix(F, args.in[I_RW_AL1], 96, 0, 2048, 96, WB + W1_LB, 128); zero_rows(F, WB + W1_LB, 2048, 0, 128); zero_rows(F, WB + W1_LB, 2048, 224, 256);
        convert_lora2(F, args.in[I_RW_WL2], args.in[I_RW_AL2], WB + W1_L2);
        convert_matrix(F, args.in[I_RW_WOUT], 2048, 0, 2048, 2048, WB + W1_OUT, 0);
        __syncthreads();
        phase_mix6(F, xb, args.in[I_RW_NORM], mix, S0, S1, S2, S3, S4, S5);
    } SEAM(ph); ++ph;
    if (IN(ph)) {
        { pg8::Gemm g{S4, WB + W1_LA, MROWS, 256, 2048}; pg8::StaticOrder S; S.init(MROWS, 256, F.G, (int)blockIdx.x); pg8::EpiLora1<0> E{L1B};
          pg8::gemm_phase<pg8::EpiLora1<0>, pg8::StaticOrder, false, true>(F.lds, g, S, E, F.wave); }
        { pg8::Gemm g{S5, WB + W1_LB, MROWS, 256, 2048}; pg8::StaticOrder S; S.init(MROWS, 256, F.G, (int)((blockIdx.x + F.G / 2) % F.G)); pg8::EpiLora1<1> E{L1B};
          pg8::gemm_phase<pg8::EpiLora1<1>, pg8::StaticOrder, false, true>(F.lds, g, S, E, F.wave); }
    } SEAM(ph); ++ph;
    if (IN(ph)) {
        { pg8::Gemm g{S0, WB + W1_IN, MROWS, 2048, 2048}; pg8::StaticOrder S; S.init(MROWS, 2048, F.G, (int)blockIdx.x); pg8::EpiStore E{S6, 2048, 8, nullptr};
          pg8::gemm_phase<pg8::EpiStore, pg8::StaticOrder, false, true>(F.lds, g, S, E, F.wave); }
        { pg8::Gemm g{S1, WB + W1_IN + (size_t)2048 * 2048, MROWS, 2048, 2048}; pg8::StaticOrder S; S.init(MROWS, 2048, F.G, (int)blockIdx.x); pg8::EpiStore E{S4, 2048, 8, nullptr};
          pg8::gemm_phase<pg8::EpiStore, pg8::StaticOrder, false, true>(F.lds, g, S, E, F.wave); }
        { pg8::Gemm g{S2, WB + W1_IN + (size_t)2 * 2048 * 2048, MROWS, 2048, 2048}; pg8::StaticOrder S; S.init(MROWS, 2048, F.G, (int)blockIdx.x); pg8::EpiStore E{S5, 2048, 8, nullptr};
          pg8::gemm_phase<pg8::EpiStore, pg8::StaticOrder, false, true>(F.lds, g, S, E, F.wave); }
    } SEAM(ph); ++ph;
    if (IN(ph)) {
        { pg8::Gemm g{L1B, WB + W1_L2, MROWS, 4096, 256}; pg8::StaticOrder S; S.init(MROWS, 4096, F.G, (int)blockIdx.x);
          pg8::EpiLora2 E{S0, S1, args.in[I_RW_W0], args.in[I_RW_A0]};
          pg8::gemm_phase<pg8::EpiLora2, pg8::StaticOrder, false, true>(F.lds, g, S, E, F.wave); }
        { pg8::Gemm g{S3, WB + W1_IN + (size_t)3 * 2048 * 2048, MROWS, 2048, 2048}; pg8::StaticOrder S; S.init(MROWS, 2048, F.G, (int)blockIdx.x); pg8::EpiStore E{S2, 2048, 8, nullptr};
          pg8::gemm_phase<pg8::EpiStore, pg8::StaticOrder, false, true>(F.lds, g, S, E, F.wave); }
    } SEAM(ph); ++ph;
    if (IN(ph)) { for (int rep = 0; rep < ((MK_DUP & 2) ? 2 : 1); ++rep) phase_rwkv(F, S6, S4, S5, S2, S0, S1, args.in[I_RW_KK], args.in[I_RW_KA], args.in[I_RW_RK], args.in[I_RW_GNW], args.in[I_RW_GNB], S3); } SEAM(ph); ++ph;
    if (IN(ph)) {
        pg8::Gemm g{S3, WB + W1_OUT, MROWS, 2048, 2048}; pg8::StaticOrder S; S.init(MROWS, 2048, F.G, (int)blockIdx.x);
        pg8::EpiResidX<true, true> E{xb, xb, 2048};
        pg8::gemm_phase<pg8::EpiResidX<true, true>, pg8::StaticOrder, false, true>(F.lds, g, S, E, F.wave);
    } SEAM(ph); ++ph;
    }
#endif

#if MK_LAYERS >= 3
    if (IN(ph)) {
        convert_matrix(F, args.in[I_ML_WIN], 8208, 0, 2048, 8192, WB + W2_IN, 0, args.in[I_ML_NORM]);
        convert_cols_small(F, args.in[I_ML_WIN], 8208, 8192, 2048, 16, WB + W2_IN, 8192, args.in[I_ML_NORM]); zero_rows(F, WB + W2_IN, 2048, 8208, 8448);
        convert_matrix(F, args.in[I_ML_WOUT], 2048, 0, 2048, 2048, WB + W2_OUT, 0);
        phase_rstd(F, xb, RSB);
    } SEAM(ph); ++ph;
    if (IN(ph)) {
        pg8::Gemm g{xb, WB + W2_IN, MROWS, 8448, 2048}; pg8::StaticOrder S; S.init(MROWS, 8448, F.G, (int)blockIdx.x);
        pg8::EpiStore E{S1, P2, 32, GX, RSB};
        pg8::gemm_phase<pg8::EpiStore, pg8::StaticOrder, false, true>(F.lds, g, S, E, F.wave);
        {
            const int rem = (int)(((size_t)(MROWS / 256) * (8448 / 256)) % (size_t)F.G), bx = (int)blockIdx.x;
            if (rem == 0 || bx >= rem) {
                F.lane = fresh_lane(); F.tid = F.wave * 64 + F.lane;
                F.cvi = rem == 0 ? bx : bx - rem; F.cvn = rem == 0 ? F.G : F.G - rem;
                convert_matrix(F, args.in[I_FX_WIN], 8224, 0, 2048, 8192, WB3 + W2_IN, 0, args.in[I_FX_NORM]);
                convert_cols_small(F, args.in[I_FX_WIN], 8224, 8192, 2048, 32, WB3 + W2_IN, 8192, args.in[I_FX_NORM]); zero_rows(F, WB3 + W2_IN, 2048, 8224, 8448);
                convert_matrix(F, args.in[I_FX_WOUT], 2048, 0, 2048, 2048, WB3 + W2_OUT, 0);
                F.cvi = F.vcu; F.cvn = F.G;
            }
        }
    } SEAM(ph); ++ph;
    if (IN(ph)) { phase_mlstm(F, S1, GX, args.in[I_ML_BI], args.in[I_ML_BF], S5, args.in[I_ML_HG], S0, FB, (unsigned*)(ctl + CW_MLF)); } SEAM(ph); ++ph;
    if (IN(ph)) {
        pg8::Gemm g{S0, WB + W2_OUT, MROWS, 2048, 2048}; pg8::StaticOrder S; S.init(MROWS, 2048, F.G, (int)blockIdx.x);
        pg8::EpiResidX<true, true> E{xb, S5, 2048};
        pg8::gemm_phase<pg8::EpiResidX<true, true>, pg8::StaticOrder, false, true>(F.lds, g, S, E, F.wave);
    } SEAM(ph); ++ph;
#endif

#if MK_LAYERS >= 4
    if (IN(ph)) {
#if MK_LAYERS < 3
#error "L3's weights are converted inside L2's projection phase"
#endif
        phase_rstd(F, S5, RSB);
    } SEAM(ph); ++ph;
    if (IN(ph)) {
        pg8::Gemm g{S5, WB3 + W2_IN, MROWS, 8448, 2048}; pg8::StaticOrder S; S.init(MROWS, 8448, F.G, (int)blockIdx.x);
        pg8::EpiStore E{S1, P3, 32, GX, RSB};
        pg8::gemm_phase<pg8::EpiStore, pg8::StaticOrder, false, true>(F.lds, g, S, E, F.wave);
    } SEAM(ph); ++ph;
    if (IN(ph)) { for (int rep = 0; rep < ((MK_DUP & 8) ? 2 : 1); ++rep) phase_fox_attn(F, S1, GX, args.in[I_FX_BF], args.in[I_FX_QG], args.in[I_FX_KG], S0, (unsigned*)(ctl + CW_QUEUE) + rep * 64); } SEAM(ph); ++ph;
    if (IN(ph)) {
        pg8::Gemm g{S0, WB3 + W2_OUT, MROWS, 2048, 2048}; pg8::StaticOrder S; S.init(MROWS, 2048, F.G, (int)blockIdx.x);
        pg8::EpiResidX<true, false> E{S5, xo, 2048};
        pg8::gemm_phase<pg8::EpiResidX<true, false>, pg8::StaticOrder, false, true>(F.lds, g, S, E, F.wave);
    } SEAM(ph); ++ph;
#endif
#undef IN
#undef SEAM
}

extern "C" void kernel_launch(void* const* d_in, const int* in_sizes, int n_in, void* d_out, int out_size, void* d_ws, size_t ws_size, hipStream_t stream) {
    static int grid = 0;
    if (grid == 0) {
        if (n_in != N_IN || out_size != MROWS * DM || ws_size < WS_END) { fprintf(stderr, "kernel_launch: unexpected shapes (n_in %d out %d ws %zu)\n", n_in, out_size, ws_size); grid = -1; return; }
        int dev = 0, cus = 0, per_cu = 0;
        if (hipGetDevice(&dev) != hipSuccess || hipDeviceGetAttribute(&cus, hipDeviceAttributeMultiprocessorCount, dev) != hipSuccess) { grid = -1; return; }
        if (hipFuncSetAttribute((const void*)fwd, hipFuncAttributeMaxDynamicSharedMemorySize, LDS_BYTES) != hipSuccess) { grid = -1; return; }
        if (hipOccupancyMaxActiveBlocksPerMultiprocessor(&per_cu, (const void*)fwd, NWAVES * 64, LDS_BYTES) != hipSuccess || per_cu < 1) per_cu = 1;
        (void)hipGetLastError();
        grid = cus & ~1;
    }
    if (grid < 0) return;
    (void)hipMemsetAsync((char*)d_ws + WS_CTL, 0, CTL_ZERO_BYTES, stream);
    Args a{};
    for (int i = 0; i < N_IN; ++i) a.in[i] = (const float*)d_in[i];
    a.out = (float*)d_out; a.ws = (unsigned char*)d_ws;
#if MK_SINGLE
    a.ph_lo = 0; a.ph_hi = NPH;
    hipLaunchKernelGGL(fwd, dim3(grid), dim3(NWAVES * 64), LDS_BYTES, stream, a);
#else
    for (int p = 0; p < NPH; ++p) { a.ph_lo = p; a.ph_hi = p + 1; hipLaunchKernelGGL(fwd, dim3(grid), dim3(NWAVES * 64), LDS_BYTES, stream, a); }
#endif
}
```

```cpp
#include <hip/hip_runtime.h>
#include <cstdio>
#include <cstdint>
__device__ __forceinline__ int fresh_lane() { int l; asm volatile("v_mbcnt_lo_u32_b32 %0, -1, 0\n\tv_mbcnt_hi_u32_b32 %0, -1, %0" : "=v"(l)); return l; }
namespace pg8 {
#define PG8_LAS __attribute__((address_space(3)))
typedef unsigned short bf16_t;
typedef short bf16x8 __attribute__((ext_vector_type(8)));
typedef float f32x4 __attribute__((ext_vector_type(4)));
typedef unsigned u32x4 __attribute__((ext_vector_type(4)));
constexpr int BM = 256, BK = 64, HALF = 128, HTB = HALF * BK * 2  , STAGE_BYTES = 8 * HTB, NXCD = 8, WGM = 8;

__host__ __device__ __forceinline__ int lds_byte(int r, int c) { const int st = (r >> 4) * 2 + (c >> 5), rr = r & 15, cc = c & 31, ob = rr * 64 + cc * 2; return st * 1024 + (ob ^ (((ob >> 9) & 1) << 5)); }
__host__ __device__ __forceinline__ void stage_rc(int b, int& R, int& C) { const int st = b / 1024, sb = b % 1024, swz = sb ^ (((sb >> 9) & 1) << 5); R = (st >> 1) * 16 + swz / 64; C = (st & 1) * 32 + (swz % 64) / 2; }
__host__ __device__ __forceinline__ int perm32(int rho) { const int n = rho >> 4, i = rho & 15; return 8 * (i >> 2) + 4 * n + (i & 3); }

struct Unit { int pm, pn; };
struct Gemm { const bf16_t* A; const bf16_t* Bt; int M, N, K; };

struct StaticOrder {
    int nM, nN, nwg, G, c;
    __host__ __device__ void init(int M, int N, int G_, int c_) { nM = M / BM; nN = N / BM; nwg = nM * nN; G = G_; c = c_; }
    __host__ __device__ bool next(int i, Unit& u) const {
        const long L = (long)i * G + c; if (L >= nwg) return false;
        int wgid = (int)L; { const int q = nwg / NXCD, r = nwg % NXCD, xcd = wgid % NXCD, off = wgid / NXCD; wgid = (xcd < r ? xcd * (q + 1) : r * (q + 1) + (xcd - r) * q) + off; }
        const int nig = WGM * nN, gid = wgid / nig, fm = gid * WGM, gsz = (nM - fm) < WGM ? (nM - fm) : WGM;
        u.pm = fm + ((wgid % nig) % gsz); u.pn = (wgid % nig) / gsz; return true;
    }
    __device__ __forceinline__ void a_ready(const Unit&) const {}
    __device__ __forceinline__ void done(const Unit&) const {}
};
__device__ __forceinline__ unsigned cvt_pk_bf16(float lo, float hi) { unsigned r; asm volatile("v_cvt_pk_bf16_f32 %0, %1, %2" : "=v"(r) : "v"(lo), "v"(hi)); return r; }
typedef float f32x2 __attribute__((ext_vector_type(2)));
struct EpiStore {
    static constexpr bool PERM = true, AFTER_DRAIN = false;
    bf16_t* O; int ldc; int n_main; float* X;
    __device__ __forceinline__ void operator()(const f32x4 (&acc)[2][2][4][2], const Unit& u, int wr, int wc, int fr, int fq) const {
        const int row0 = u.pm * BM + wr * 64 + fr;
        if (u.pn < n_main) {
            const int col0 = u.pn * BM + wc * 32 + 8 * fq;
#pragma unroll
            for (int ai = 0; ai < 2; ++ai)
#pragma unroll
                for (int m = 0; m < 4; ++m) { bf16_t* rowp = O + (size_t)(row0 + ai * HALF + m * 16) * ldc + col0;
#pragma unroll
                    for (int bj = 0; bj < 2; ++bj) { const f32x4 v0 = acc[ai][bj][m][0], v1 = acc[ai][bj][m][1];
                        u32x4 w; w.x = cvt_pk_bf16(v0[0], v0[1]); w.y = cvt_pk_bf16(v0[2], v0[3]); w.z = cvt_pk_bf16(v1[0], v1[1]); w.w = cvt_pk_bf16(v1[2], v1[3]);
                        *(u32x4*)(rowp + bj * HALF) = w; } }
        } else if (wc == 0) {
#pragma unroll
            for (int ai = 0; ai < 2; ++ai)
#pragma unroll
                for (int m = 0; m < 4; ++m) { float* rp = X + (size_t)(row0 + ai * HALF + m * 16) * 32 + 8 * fq;
                    *(f32x4*)rp = acc[ai][0][m][0]; *(f32x4*)(rp + 4) = acc[ai][0][m][1]; }
        }
    }
};
template <int SEL> struct EpiLora1 {
    static constexpr bool PERM = true, AFTER_DRAIN = false;
    bf16_t* O;
    __device__ __forceinline__ void operator()(const f32x4 (&acc)[2][2][4][2], const Unit& u, int wr, int wc, int fr, int fq) const {
        const int row0 = u.pm * BM + wr * 64 + fr, col0 = SEL * HALF + wc * 32 + 8 * fq;
#pragma unroll
        for (int ai = 0; ai < 2; ++ai)
#pragma unroll
            for (int m = 0; m < 4; ++m) { bf16_t* rowp = O + (size_t)(row0 + ai * HALF + m * 16) * 256 + col0;
                f32x4 v0 = acc[ai][SEL][m][0], v1 = acc[ai][SEL][m][1];
                if (SEL == 0) {
#pragma unroll
                    for (int j = 0; j < 4; ++j) { v0[j] = tanhf(v0[j]); v1[j] = tanhf(v1[j]); } }
                u32x4 w; w.x = cvt_pk_bf16(v0[0], v0[1]); w.y = cvt_pk_bf16(v0[2], v0[3]); w.z = cvt_pk_bf16(v1[0], v1[1]); w.w = cvt_pk_bf16(v1[2], v1[3]);
                *(u32x4*)rowp = w; }
    }
};
struct EpiLora2 {
    static constexpr bool PERM = true, AFTER_DRAIN = false;
    bf16_t* LW; bf16_t* AA; const float* w0; const float* a0;
    __device__ __forceinline__ void operator()(const f32x4 (&acc)[2][2][4][2], const Unit& u, int wr, int wc, int fr, int fq) const {
        const int row0 = u.pm * BM + wr * 64 + fr;
        const bool isw = u.pn < 8;
        const int col0 = (isw ? u.pn : u.pn - 8) * BM + wc * 32 + 8 * fq;
        const float* bsrc = isw ? w0 : a0; bf16_t* dst = isw ? LW : AA;
        const f32x4 bv00 = *(const f32x4*)(bsrc + col0), bv01 = *(const f32x4*)(bsrc + col0 + 4), bv10 = *(const f32x4*)(bsrc + col0 + HALF), bv11 = *(const f32x4*)(bsrc + col0 + HALF + 4);
#pragma unroll
        for (int ai = 0; ai < 2; ++ai)
#pragma unroll
            for (int m = 0; m < 4; ++m) { bf16_t* rowp = dst + (size_t)(row0 + ai * HALF + m * 16) * 2048 + col0;
#pragma unroll
                for (int bj = 0; bj < 2; ++bj) { f32x4 v0 = acc[ai][bj][m][0] + (bj ? bv10 : bv00), v1 = acc[ai][bj][m][1] + (bj ? bv11 : bv01);
                    if (isw) {
#pragma unroll
                        for (int j = 0; j < 4; ++j) {
                            v0[j] = -0.875038775f * __builtin_amdgcn_rcpf(1.0f + __expf(-v0[j])); v1[j] = -0.875038775f * __builtin_amdgcn_rcpf(1.0f + __expf(-v1[j])); }
                    } else {
#pragma unroll
                        for (int j = 0; j < 4; ++j) { v0[j] = __builtin_amdgcn_rcpf(1.0f + __expf(-v0[j])); v1[j] = __builtin_amdgcn_rcpf(1.0f + __expf(-v1[j])); }
                    }
                    u32x4 w; w.x = cvt_pk_bf16(v0[0], v0[1]); w.y = cvt_pk_bf16(v0[2], v0[3]); w.z = cvt_pk_bf16(v1[0], v1[1]); w.w = cvt_pk_bf16(v1[2], v1[3]);
                    *(u32x4*)(rowp + bj * HALF) = w; } }
    }
};
struct EpiResid {
    static constexpr bool PERM = false, AFTER_DRAIN = false;
    const float* R; float* O; int ldc; float amp;
    __device__ __forceinline__ void operator()(const f32x4 (&acc)[2][2][4][2], const Unit& u, int wr, int wc, int fr, int fq) const {
        const int row0 = u.pm * BM + wr * 64 + fr, col0 = u.pn * BM + wc * 32 + 4 * fq;
        const float* __restrict__ Rr = R; float* __restrict__ Oo = O;
        f32x4 rv[2][4];
#define ER_LOAD(g, buf) do { const size_t off_ = (size_t)(row0 + ((g) >> 2) * HALF + ((g) & 3) * 16) * ldc + col0; \
            _Pragma("unroll") for (int bj = 0; bj < 2; ++bj) _Pragma("unroll") for (int n = 0; n < 2; ++n) rv[buf][bj * 2 + n] = *(const f32x4*)(Rr + off_ + bj * HALF + n * 16); } while (0)
        ER_LOAD(0, 0);
#pragma unroll
        for (int g = 0; g < 8; ++g) {
            if (g + 1 < 8) ER_LOAD(g + 1, (g + 1) & 1);
            const int ai = g >> 2, m = g & 3; const size_t off = (size_t)(row0 + ai * HALF + m * 16) * ldc + col0;
#pragma unroll
            for (int bj = 0; bj < 2; ++bj)
#pragma unroll
                for (int n = 0; n < 2; ++n) *(f32x4*)(Oo + off + bj * HALF + n * 16) = rv[g & 1][bj * 2 + n] + amp * acc[ai][bj][m][n];
        }
#undef ER_LOAD
    }
};
template <bool RBF, bool OBF> struct EpiResidX {
    static constexpr bool PERM = true, AFTER_DRAIN = false;
    const void* R; void* O; int ldc;
    __device__ __forceinline__ void operator()(const f32x4 (&acc)[2][2][4][2], const Unit& u, int wr, int wc, int fr, int fq) const {
        const int row0 = u.pm * BM + wr * 64 + fr, col0 = u.pn * BM + wc * 32 + 8 * fq;
        f32x4 rv[2][2][2];
#define ERX_LOAD(g, buf) do { const size_t off_ = (size_t)(row0 + ((g) >> 2) * HALF + ((g) & 3) * 16) * ldc + col0; \
            _Pragma("unroll") for (int bj = 0; bj < 2; ++bj) { \
                if constexpr (RBF) { const u32x4 w_ = *(const u32x4*)((const bf16_t*)R + off_ + bj * HALF); \
                    rv[buf][bj][0] = (f32x4){__builtin_bit_cast(float, w_.x << 16), __builtin_bit_cast(float, w_.x & 0xffff0000u), __builtin_bit_cast(float, w_.y << 16), __builtin_bit_cast(float, w_.y & 0xffff0000u)}; \
                    rv[buf][bj][1] = (f32x4){__builtin_bit_cast(float, w_.z << 16), __builtin_bit_cast(float, w_.z & 0xffff0000u), __builtin_bit_cast(float, w_.w << 16), __builtin_bit_cast(float, w_.w & 0xffff0000u)}; } \
                else { rv[buf][bj][0] = *(const f32x4*)((const float*)R + off_ + bj * HALF); rv[buf][bj][1] = *(const f32x4*)((const float*)R + off_ + bj * HALF + 4); } } } while (0)
        ERX_LOAD(0, 0);
#pragma unroll
        for (int g = 0; g < 8; ++g) {
            if (g + 1 < 8) ERX_LOAD(g + 1, (g + 1) & 1);
            const int ai = g >> 2, m = g & 3; const size_t off = (size_t)(row0 + ai * HALF + m * 16) * ldc + col0;
#pragma unroll
            for (int bj = 0; bj < 2; ++bj) { const f32x4 v0 = rv[g & 1][bj][0] + acc[ai][bj][m][0], v1 = rv[g & 1][bj][1] + acc[ai][bj][m][1];
                if constexpr (OBF) { u32x4 w; w.x = cvt_pk_bf16(v0[0], v0[1]); w.y = cvt_pk_bf16(v0[2], v0[3]); w.z = cvt_pk_bf16(v1[0], v1[1]); w.w = cvt_pk_bf16(v1[2], v1[3]);
                    *(u32x4*)((bf16_t*)O + off + bj * HALF) = w; }
                else { *(f32x4*)((float*)O + off + bj * HALF) = v0; *(f32x4*)((float*)O + off + bj * HALF + 4) = v1; } }
        }
#undef ERX_LOAD
    }
};
template <class Epi, class Sched, bool ALIGN_EPI = false, bool SP2 = false>
__device__ __forceinline__ void gemm_phase(PG8_LAS unsigned char* lds, const Gemm g, const Sched& S, const Epi& E, const int wid) {
    const int lane = fresh_lane(), tid = wid * 64 + lane, wr = wid >> 2, wc = wid & 3, fr = lane & 15, fq = lane >> 4;
    const int K = g.K, nt = K / BK;
    unsigned voffA[2], voffB[2];
#pragma unroll
    for (int i = 0; i < 2; ++i) { int R, C; stage_rc(tid * 16 + i * 8192, R, C); const int Rb = Epi::PERM ? ((R & ~31) + perm32(R & 31)) : R;
        voffA[i] = (unsigned)(R * K + C) * 2u; voffB[i] = (unsigned)(Rb * K + C) * 2u; }
    const size_t kstep = (size_t)(BK * 2);
    const size_t hstep = (size_t)HALF * K * 2;
    const size_t tstep = 2 * hstep;
    const unsigned ldsw = (unsigned)wid * 1024u;
    const int aoff = lds_byte(wr * 64 + fr, fq * 8), boff = lds_byte(wc * 32 + fr, fq * 8);
#define PG8_SA(b, h) (((b) * 2 + (h)) * HTB)
#define PG8_SB(b, h) ((4 + (b) * 2 + (h)) * HTB)
#define PG8_STAGE(bufoff, gbase, voff) do { _Pragma("unroll") for (int _i = 0; _i < 2; ++_i) \
        __builtin_amdgcn_global_load_lds((const unsigned*)((const char*)(gbase) + (voff)[_i]), (PG8_LAS unsigned*)(lds + (bufoff) + ldsw + _i * 8192), 16, 0, 0); } while (0)
#define PG8_LDA(dst, b, h) do { _Pragma("unroll") for (int m = 0; m < 4; ++m) _Pragma("unroll") for (int k = 0; k < 2; ++k) dst[m][k] = *(const PG8_LAS bf16x8*)(lds + PG8_SA(b, h) + aoff + m * 2048 + k * 1024); } while (0)
#define PG8_LDB(dst, b, h) do { _Pragma("unroll") for (int n = 0; n < 2; ++n) _Pragma("unroll") for (int k = 0; k < 2; ++k) dst[n][k] = *(const PG8_LAS bf16x8*)(lds + PG8_SB(b, h) + boff + n * 2048 + k * 1024); } while (0)
#define PG8_MMA(ai, bj, At, Bt) do { __builtin_amdgcn_s_setprio(1); _Pragma("unroll") for (int m = 0; m < 4; ++m) _Pragma("unroll") for (int n = 0; n < 2; ++n) _Pragma("unroll") for (int k = 0; k < 2; ++k) \
        acc[ai][bj][m][n] = __builtin_amdgcn_mfma_f32_16x16x32_bf16(Bt[n][k], At[m][k], acc[ai][bj][m][n], 0, 0, 0); __builtin_amdgcn_s_setprio(0); } while (0)
#define PG8_WAIT_V(n) asm volatile("s_waitcnt vmcnt(" #n ")" ::: "memory")
#define PG8_WAIT_L(n) asm volatile("s_waitcnt lgkmcnt(" #n ")" ::: "memory")
#define PG8_BAR __builtin_amdgcn_s_barrier()
#define PG8_SCHED __builtin_amdgcn_sched_barrier(0)
    Unit cur, nxt; int ui = 0;
    if (!S.next(0, cur)) return;
    f32x4 acc[2][2][4][2];
#pragma unroll
    for (int a = 0; a < 2; ++a)
#pragma unroll
        for (int b = 0; b < 2; ++b)
#pragma unroll
            for (int m = 0; m < 4; ++m)
#pragma unroll
                for (int n = 0; n < 2; ++n) acc[a][b][m][n] = (f32x4){0.f, 0.f, 0.f, 0.f};
    bf16x8 At[4][2], B0[2][2], B1[2][2];
    const char* cA = (const char*)g.A + (size_t)cur.pm * tstep; const char* cB = (const char*)g.Bt + (size_t)cur.pn * tstep;
    S.a_ready(cur);
    if constexpr (SP2) {
        PG8_STAGE(PG8_SB(0, 0), cB, voffB); PG8_STAGE(PG8_SB(0, 1), cB + hstep, voffB); PG8_STAGE(PG8_SA(0, 0), cA, voffA); PG8_STAGE(PG8_SA(0, 1), cA + hstep, voffA);
        if (wr == 1) PG8_BAR;
        PG8_WAIT_V(2); PG8_BAR;
        PG8_STAGE(PG8_SB(1, 0), cB + kstep, voffB); PG8_STAGE(PG8_SA(1, 0), cA + kstep, voffA); PG8_STAGE(PG8_SB(1, 1), cB + hstep + kstep, voffB);
        PG8_WAIT_V(6); PG8_BAR;
    } else {
        PG8_STAGE(PG8_SB(0, 0), cB, voffB); PG8_STAGE(PG8_SA(0, 0), cA, voffA); PG8_STAGE(PG8_SB(0, 1), cB + hstep, voffB); PG8_STAGE(PG8_SA(0, 1), cA + hstep, voffA);
        if (wr == 1) PG8_BAR;
        PG8_WAIT_V(4); PG8_BAR;
        PG8_STAGE(PG8_SB(1, 0), cB + kstep, voffB); PG8_STAGE(PG8_SA(1, 0), cA + kstep, voffA); PG8_STAGE(PG8_SB(1, 1), cB + hstep + kstep, voffB);
        PG8_WAIT_V(6); PG8_BAR;
    }
    for (;;) {
        const bool has_next = S.next(ui + 1, nxt);
        const char* nA = has_next ? (const char*)g.A + (size_t)nxt.pm * tstep : cA; const char* nB = has_next ? (const char*)g.Bt + (size_t)nxt.pn * tstep : cB;
        asm volatile(".p2align 6");
        for (int t = 0; t < nt; t += 2) {
            const bool last = (t == nt - 2);
            const char* a1 = cA + (size_t)(t + 1) * kstep;
            const char* a2 = last ? nA : cA + (size_t)(t + 2) * kstep; const char* b2 = last ? nB : cB + (size_t)(t + 2) * kstep;
            const char* a3 = a2 + kstep; const char* b3 = b2 + kstep;
            if (last && has_next) S.a_ready(nxt);
            if constexpr (SP2) {
            PG8_LDB(B0, 0, 0); PG8_LDB(B1, 0, 1); PG8_SCHED; PG8_LDA(At, 0, 0); PG8_STAGE(PG8_SA(1, 1), a1 + hstep, voffA);
            PG8_WAIT_V(8); PG8_WAIT_L(0); PG8_BAR; PG8_MMA(0, 0, At, B0); PG8_MMA(0, 1, At, B1); PG8_BAR; PG8_SCHED;
            PG8_LDA(At, 0, 1); PG8_STAGE(PG8_SB(0, 0), b2, voffB); PG8_STAGE(PG8_SB(0, 1), b2 + hstep, voffB); PG8_STAGE(PG8_SA(0, 0), a2, voffA);
            PG8_WAIT_V(8); PG8_WAIT_L(0); PG8_BAR; PG8_MMA(1, 0, At, B0); PG8_MMA(1, 1, At, B1); PG8_BAR; PG8_SCHED;
            PG8_LDB(B0, 1, 0); PG8_LDB(B1, 1, 1); PG8_SCHED; PG8_LDA(At, 1, 0); PG8_STAGE(PG8_SA(0, 1), a2 + hstep, voffA);
            PG8_WAIT_V(8); PG8_WAIT_L(0); PG8_BAR; PG8_MMA(0, 0, At, B0); PG8_MMA(0, 1, At, B1); PG8_BAR; PG8_SCHED;
            PG8_LDA(At, 1, 1); PG8_STAGE(PG8_SB(1, 0), b3, voffB); PG8_STAGE(PG8_SB(1, 1), b3 + hstep, voffB); PG8_STAGE(PG8_SA(1, 0), a3, voffA);
            PG8_WAIT_V(8); PG8_WAIT_L(0); PG8_BAR; PG8_MMA(1, 0, At, B0); PG8_MMA(1, 1, At, B1); PG8_BAR; PG8_SCHED;
            } else {
            PG8_LDB(B0, 0, 0); PG8_SCHED; PG8_LDA(At, 0, 0); PG8_STAGE(PG8_SA(1, 1), a1 + hstep, voffA);
            PG8_WAIT_L(8); PG8_BAR; PG8_WAIT_L(0); PG8_MMA(0, 0, At, B0); PG8_BAR; PG8_SCHED;
            PG8_LDB(B1, 0, 1); PG8_STAGE(PG8_SB(0, 0), b2, voffB);
            PG8_BAR; PG8_WAIT_L(0); PG8_MMA(0, 1, At, B1); PG8_BAR;
            PG8_LDA(At, 0, 1); PG8_STAGE(PG8_SA(0, 0), a2, voffA);
            PG8_BAR; PG8_WAIT_L(0); PG8_MMA(1, 0, At, B0); PG8_BAR; PG8_SCHED;
            PG8_STAGE(PG8_SB(0, 1), b2 + hstep, voffB);
            PG8_WAIT_V(6); PG8_BAR; PG8_MMA(1, 1, At, B1); PG8_BAR;
            PG8_LDB(B0, 1, 0); PG8_SCHED; PG8_LDA(At, 1, 0); PG8_STAGE(PG8_SA(0, 1), a2 + hstep, voffA);
            PG8_WAIT_L(8); PG8_BAR; PG8_WAIT_L(0); PG8_MMA(0, 0, At, B0); PG8_BAR; PG8_SCHED;
            PG8_LDB(B1, 1, 1); PG8_STAGE(PG8_SB(1, 0), b3, voffB);
            PG8_BAR; PG8_WAIT_L(0); PG8_MMA(0, 1, At, B1); PG8_BAR;
            PG8_LDA(At, 1, 1); PG8_STAGE(PG8_SA(1, 0), a3, voffA);
            PG8_BAR; PG8_WAIT_L(0); PG8_MMA(1, 0, At, B0); PG8_BAR; PG8_SCHED;
            PG8_STAGE(PG8_SB(1, 1), b3 + hstep, voffB);
            PG8_WAIT_V(6); PG8_BAR; PG8_MMA(1, 1, At, B1); PG8_BAR;
            }
        }
        if constexpr (ALIGN_EPI) { if (wr == 0) PG8_BAR; }
        if constexpr (!Epi::AFTER_DRAIN) { E(acc, cur, wr, wc, fr, fq); S.done(cur); }
        if (!has_next) break;
#pragma unroll
        for (int a = 0; a < 2; ++a)
#pragma unroll
            for (int b = 0; b < 2; ++b)
#pragma unroll
                for (int m = 0; m < 4; ++m)
#pragma unroll
                    for (int n = 0; n < 2; ++n) acc[a][b][m][n] = (f32x4){0.f, 0.f, 0.f, 0.f};
        cur = nxt; cA = nA; cB = nB; ++ui;
        if constexpr (ALIGN_EPI) { if (wr == 1) PG8_BAR; }
    }
    PG8_WAIT_V(0);
    if constexpr (!ALIGN_EPI) { if (wr == 0) PG8_BAR; }
    PG8_BAR;
    if constexpr (Epi::AFTER_DRAIN) { E.fused(acc, cur, wr, wc, fr, fq, lds, wid, lane); S.done(cur); }
#undef PG8_SA
#undef PG8_SB
#undef PG8_STAGE
#undef PG8_LDA
#undef PG8_LDB
#undef PG8_MMA
#undef PG8_WAIT_V
#undef PG8_WAIT_L
#undef PG8_BAR
#undef PG8_SCHED
}
}

#define GAS __attribute__((address_space(1)))
#define LAS __attribute__((address_space(3)))
typedef unsigned short bf16;
typedef unsigned v4u __attribute__((ext_vector_type(4)));
typedef float f32x4 __attribute__((ext_vector_type(4)));
typedef short bf16x8 __attribute__((ext_vector_type(8)));
typedef GAS unsigned gu32;
typedef GAS unsigned long long gu64;
#define RLX_AGENT __ATOMIC_RELAXED, __HIP_MEMORY_SCOPE_AGENT
#define LDS_WAIT() asm volatile("s_waitcnt lgkmcnt(0)" ::: "memory")
#define VM_WAIT() asm volatile("s_waitcnt vmcnt(0)" ::: "memory")
__device__ __forceinline__ unsigned long long rt() { return __builtin_amdgcn_s_memrealtime(); }
__device__ __forceinline__ unsigned f2bf(float f) { unsigned u = __builtin_bit_cast(unsigned, f); return (u + 0x7fffu + ((u >> 16) & 1u)) >> 16; }
__device__ __forceinline__ unsigned pk2(float lo, float hi) { return f2bf(lo) | (f2bf(hi) << 16); }
#define XB_TMO      128
#define XB_XCNT(j)  (256  + 64 * (j))
#define XB_XSUB(j)  (1280 + 64 * (j))
#define XB_XGEN(j)  (2304 + 64 * (j))
#define XB_TOP      3328
#define XB_TOPGEN   3392
#define XCD_BAR_WORDS 3456
#define XB_SPIN_CAP (1u << 18)

__device__ __forceinline__ unsigned xb_ld(unsigned* p)              { return __hip_atomic_load(p, __ATOMIC_RELAXED, __HIP_MEMORY_SCOPE_AGENT); }
__device__ __forceinline__ unsigned xb_add(unsigned* p, unsigned v) { return __hip_atomic_fetch_add(p, v, __ATOMIC_RELAXED, __HIP_MEMORY_SCOPE_AGENT); }
__device__ __forceinline__ unsigned xb_xcc_id() { return (unsigned)__builtin_amdgcn_s_getreg((3 << 11) | 20) & 0xFu; }
#define XB_SPIN(cond, bar) do { unsigned _sp = 0; while (cond) { __builtin_amdgcn_s_sleep(1); \
    if ((++_sp & 255u) == 0u) { if (xb_ld(&(bar)[XB_TMO])) break; if (_sp > XB_SPIN_CAP) { atomicAdd(&(bar)[XB_TMO], 1u); break; } } } } while (0)

struct XcdBarrier {
    unsigned* bar; unsigned x;
    volatile LAS unsigned* st;
};

__device__ __forceinline__ XcdBarrier xcd_barrier_post(unsigned* bar, volatile LAS unsigned* st) {
    XcdBarrier b; b.bar = bar; b.x = xb_xcc_id(); b.st = st;
    if (threadIdx.x == 0) (void)xb_add(&bar[XB_XCNT(b.x)], 1u);
    return b;
}
__device__ __forceinline__ void xcd_barrier_complete(unsigned* bar, unsigned x, unsigned& nloc, unsigned& nx) {
    const unsigned G = gridDim.x * gridDim.y * gridDim.z;
    unsigned sum, cnt, mine, sp = 0u;
    for (;;) {
        sum = 0u; cnt = 0u; mine = 0u;
#pragma unroll
        for (unsigned j = 0; j < 16; ++j) { const unsigned c = xb_ld(&bar[XB_XCNT(j)]); sum += c; cnt += (c > 0u) ? 1u : 0u; mine = (j == x) ? c : mine; }
        if (sum == G) break;
        __builtin_amdgcn_s_sleep(1);
        if ((++sp & 255u) == 0u) { if (xb_ld(&bar[XB_TMO])) break; if (sp > XB_SPIN_CAP) { atomicAdd(&bar[XB_TMO], 1u); break; } }
    }
    nloc = mine > 0u ? mine : 1u; nx = cnt > 0u ? cnt : 1u;
}

__device__ __forceinline__ void xcd_barrier(const XcdBarrier& b, const int wave_sgpr) {
    const bool xb_t0 = (wave_sgpr == 0) && (fresh_lane() == 0);
    asm volatile("s_waitcnt vmcnt(0)" ::: "memory");
    __syncthreads();
    if (xb_t0) {
        unsigned* bar = b.bar;
        __builtin_amdgcn_s_waitcnt(0);
        unsigned nloc = b.st[0], nx = b.st[1];
        if (nloc == 0u) { xcd_barrier_complete(bar, b.x, nloc, nx); b.st[0] = nloc; b.st[1] = nx; }
        const unsigned old = xb_add(&bar[XB_XSUB(b.x)], 1u);
        const unsigned gen = old / nloc;
        if (old + 1u == (gen + 1u) * nloc) {
            __builtin_amdgcn_fence(__ATOMIC_RELEASE, "agent");
            asm volatile("s_waitcnt vmcnt(0)" ::: "memory");
            const unsigned og = xb_add(&bar[XB_TOP], 1u);
            const unsigned tg = og / nx;
            if (og + 1u == (tg + 1u) * nx) xb_add(&bar[XB_TOPGEN], 1u);
            else XB_SPIN(xb_ld(&bar[XB_TOPGEN]) == tg, bar);
            __builtin_amdgcn_fence(__ATOMIC_ACQUIRE, "agent");
            xb_add(&bar[XB_XGEN(b.x)], 1u);
            asm volatile("s_waitcnt vmcnt(0)" ::: "memory");
        } else {
            XB_SPIN(xb_ld(&bar[XB_XGEN(b.x)]) == gen, bar);
            __builtin_amdgcn_fence(__ATOMIC_ACQUIRE, "agent");
            asm volatile("s_waitcnt vmcnt(0)" ::: "memory");
        }
    }
    __syncthreads();
}

constexpr int NWAVES = 8;
constexpr int BATCH = 16, SEQ = 2048, DM = 2048, MROWS = BATCH * SEQ;
constexpr float RMS_EPS = 1e-6f, GN_EPS = 64e-5f, LOG2E = 1.4426950408889634f;
constexpr int P0 = 4608;
constexpr int P2 = 8192;
constexpr int P3 = 8192;
constexpr size_t MiB = 1u << 20;
constexpr size_t WS_CTL = 0, CTL_ZERO_BYTES = 1 * MiB;
constexpr size_t WS_W = 1 * MiB;
constexpr size_t WS_S0 = 48 * MiB, SLOT = 128 * MiB;
#define WS_SLOT(i) (WS_S0 + (size_t)(i) * SLOT)
constexpr size_t WS_SMALL = WS_S0 + 7 * SLOT;
constexpr size_t WS_L1 = WS_SMALL;
constexpr size_t WS_GX = WS_SMALL + 16 * MiB;
constexpr size_t WS_F = WS_SMALL + 20 * MiB;
constexpr size_t WS_W3 = WS_SMALL + 24 * MiB;
constexpr size_t WS_END = WS_W3 + 42 * MiB;
constexpr int CW_TMO = 0;
constexpr int CW_BAR = 4096;
constexpr int CW_MLF = 8192;
constexpr int CW_QUEUE = 2048;
constexpr size_t W0_IN = 0, W0_OUT = (size_t)4608 * 2048;
constexpr size_t W1_IN = 0, W1_LA = (size_t)4 * 2048 * 2048, W1_LB = W1_LA + (size_t)256 * 2048, W1_L2 = W1_LB + (size_t)256 * 2048, W1_OUT = W1_L2 + (size_t)4096 * 256;
constexpr size_t W2_IN = 0, W2_OUT = (size_t)8448 * 2048;
static_assert((W1_OUT + (size_t)2048 * 2048) * 2 <= 47 * MiB && (W2_OUT + (size_t)2048 * 2048) * 2 <= 47 * MiB, "weight region");
constexpr int RING_BYTES = 131072;
constexpr int MISC_OFF = RING_BYTES;
constexpr int LDS_BYTES = 147456;

typedef float f32x2 __attribute__((ext_vector_type(2)));
struct Frame {
    LAS unsigned char* lds;
    int tid, lane, wave, vcu, G;
    int cvi, cvn;
};
__device__ __forceinline__ float wave_sum(float v) {
#pragma unroll
    for (int o = 1; o < 64; o <<= 1) v += __shfl_xor(v, o);
    return v;
}
__device__ __forceinline__ float bf2f(unsigned short b) { return __builtin_bit_cast(float, (unsigned)b << 16); }
__device__ __forceinline__ float bflo(unsigned w) { return __builtin_bit_cast(float, w << 16); }
__device__ __forceinline__ float bfhi(unsigned w) { return __builtin_bit_cast(float, w & 0xffff0000u); }
__device__ __forceinline__ unsigned pkbf(float lo, float hi) { return pg8::cvt_pk_bf16(lo, hi); }
__device__ __forceinline__ float siluf(float x) { return x * __builtin_amdgcn_rcpf(1.0f + __expf(-x)); }
__device__ __forceinline__ float sigmf(float x) { return __builtin_amdgcn_rcpf(1.0f + __expf(-x)); }
__device__ __forceinline__ float logsigf(float z) { return fminf(z, 0.f) - log1pf(__expf(-fabsf(z))); }

__device__ __forceinline__ void transpose_item(const float* W, int ldw, int n0w, int K, int N, bf16* WT, int row_off, LAS float* scr, int item, int lane) {
    const int nblk = N / 32, kb = item / nblk, nb = item % nblk, k0 = 64 * kb, n0 = 32 * nb;
#pragma unroll 8
    for (int i = 0; i < 32; ++i) { const int kk = 2 * i + (lane >> 5); scr[kk * 33 + (lane & 31)] = W[(size_t)(k0 + kk) * ldw + n0w + n0 + (lane & 31)]; }
    LDS_WAIT(); asm volatile("" ::: "memory");
    const int c = lane & 7;
#pragma unroll
    for (int j = 0; j < 4; ++j) { const int n = (lane >> 3) + 8 * j; const LAS float* s = scr + (8 * c) * 33 + n;
        v4u o; o.x = pkbf(s[0 * 33], s[1 * 33]); o.y = pkbf(s[2 * 33], s[3 * 33]); o.z = pkbf(s[4 * 33], s[5 * 33]); o.w = pkbf(s[6 * 33], s[7 * 33]);
        *(GAS v4u*)(WT + (size_t)(row_off + n0 + n) * K + k0 + 8 * c) = o; }
    LDS_WAIT(); asm volatile("" ::: "memory");
}
__device__ __forceinline__ void convert_matrix(Frame& F, const float* W, int ldw, int n0w, int K, int N, bf16* WT, int row_off) {
    LAS float* scr = (LAS float*)(F.lds + F.wave * 16384);
    const int gw = F.cvi * NWAVES + F.wave, NGW = F.cvn * NWAVES, nitems = (K / 64) * (N / 32);
    for (int it = gw; it < nitems; it += NGW) transpose_item(W, ldw, n0w, K, N, WT, row_off, scr, it, F.lane);
}
__device__ __forceinline__ void zero_rows(Frame& F, bf16* WT, int K, int r0, int r1) {
    const size_t n16 = (size_t)(r1 - r0) * K / 8; GAS v4u* p = (GAS v4u*)(WT + (size_t)r0 * K);
    for (size_t i = (size_t)F.cvi * 512 + F.tid; i < n16; i += (size_t)F.cvn * 512) p[i] = (v4u){0u, 0u, 0u, 0u};
}
__device__ __forceinline__ void convert_cols_small(Frame& F, const float* W, int ldw, int n0w, int K, int N, bf16* WT, int row_off) {
    const int total = K * N;
    for (int i = F.cvi * 512 + F.tid; i < total; i += F.cvn * 512) { const int n = i / K, k = i % K; WT[(size_t)(row_off + n) * K + k] = (bf16)f2bf(W[(size_t)k * ldw + n0w + n]); }
}

template <bool XBF> __device__ __forceinline__ f32x4 xrow_load(const void* x, size_t m, int lane, int j) {
    typedef unsigned u32x2_t __attribute__((ext_vector_type(2)));
    if constexpr (XBF) { const u32x2_t w = *((const GAS u32x2_t*)((const bf16*)x + m * DM) + lane + 64 * j); return (f32x4){bflo(w.x), bfhi(w.x), bflo(w.y), bfhi(w.y)}; }
    else return *((const GAS f32x4*)((const float*)x + m * DM) + lane + 64 * j);
}
template <bool XBF> __device__ __forceinline__ void phase_norm(Frame& F, const void* x, const float* gain, bf16* out) {
    const int gw = F.vcu * NWAVES + F.wave, NGW = F.G * NWAVES;
    f32x4 g[8];
#pragma unroll
    for (int j = 0; j < 8; ++j) g[j] = *(const f32x4*)(gain + (F.lane + 64 * j) * 4);
    f32x4 vn[8];
    if (gw < MROWS) {
#pragma unroll
        for (int j = 0; j < 8; ++j) vn[j] = xrow_load<XBF>(x, (size_t)gw, F.lane, j); }
    for (int m = gw; m < MROWS; m += NGW) {
        f32x4 v[8]; float s = 0.f;
#pragma unroll
        for (int j = 0; j < 8; ++j) { v[j] = vn[j]; s += (v[j].x * v[j].x + v[j].y * v[j].y) + (v[j].z * v[j].z + v[j].w * v[j].w); }
        if (m + NGW < MROWS) {
#pragma unroll
            for (int j = 0; j < 8; ++j) vn[j] = xrow_load<XBF>(x, (size_t)(m + NGW), F.lane, j); }
        const float rstd = 1.0f / sqrtf(wave_sum(s) * (1.0f / DM) + RMS_EPS);
        GAS unsigned long long* o8 = (GAS unsigned long long*)(out + (size_t)m * DM) + F.lane;
#pragma unroll
        for (int j = 0; j < 8; ++j) { const f32x4 y = v[j] * rstd * g[j]; o8[64 * j] = (unsigned long long)pkbf(y.x, y.y) | ((unsigned long long)pkbf(y.z, y.w) << 32); }
    }
}

typedef float f32x16 __attribute__((ext_vector_type(16)));
typedef short v4i16_t __attribute__((ext_vector_type(4)));
typedef unsigned u32x4 __attribute__((ext_vector_type(4)));
typedef unsigned u32x2 __attribute__((ext_vector_type(2)));
__device__ __forceinline__ int crow(int r, int hi) { return (r & 3) + 8 * (r >> 2) + 4 * hi; }
__device__ __forceinline__ bf16x8 mk8(v4i16_t lo, v4i16_t hi) { return (bf16x8){lo[0], lo[1], lo[2], lo[3], hi[0], hi[1], hi[2], hi[3]}; }
__device__ __forceinline__ v4i16_t ldtr(const LAS unsigned char* p) { return __builtin_amdgcn_ds_read_tr16_b64_v4i16((LAS v4i16_t*)p); }
__device__ __forceinline__ bf16x8 pack8(float a0, float a1, float a2, float a3, float a4, float a5, float a6, float a7) {
    u32x4 w; w.x = pkbf(a0, a1); w.y = pkbf(a2, a3); w.z = pkbf(a4, a5); w.w = pkbf(a6, a7); return __builtin_bit_cast(bf16x8, w); }
__device__ __forceinline__ int t5_bucket(int d) {
    if (d < 16) return d;
    int b = 15; b += (d >= 16); b += (d >= 19); b += (d >= 21); b += (d >= 24); b += (d >= 27); b += (d >= 31); b += (d >= 35); b += (d >= 40);
    b += (d >= 46); b += (d >= 52); b += (d >= 59); b += (d >= 67); b += (d >= 77); b += (d >= 87); b += (d >= 99); b += (d >= 113); return b;
}


__device__ __forceinline__ void attn_epilogue(const f32x16 (&O)[2], float rl, const bf16* gate0, int gpitch, bf16* out0, LAS unsigned char* stg, int lane) {
    const int r32 = lane & 31, hi = lane >> 5, srow = lane >> 3, sch = lane & 7;
#pragma unroll
    for (int i = 0; i < 4; ++i) { const int row = i * 8 + srow; *(LAS u32x4*)(stg + row * 128 + sch * 16) = *(const GAS u32x4*)(gate0 + (size_t)row * gpitch + sch * 8); }
#pragma unroll
    for (int db = 0; db < 2; ++db)
#pragma unroll
        for (int g4 = 0; g4 < 4; ++g4) { const int d0 = db * 32 + 8 * g4 + 4 * hi;
            LAS u32x2* sp = (LAS u32x2*)(stg + r32 * 128 + d0 * 2);
            const u32x2 gv = *sp;
            const float o0 = O[db][4 * g4 + 0] * rl * siluf(bflo(gv.x)), o1 = O[db][4 * g4 + 1] * rl * siluf(bfhi(gv.x));
            const float o2 = O[db][4 * g4 + 2] * rl * siluf(bflo(gv.y)), o3 = O[db][4 * g4 + 3] * rl * siluf(bfhi(gv.y));
            u32x2 w; w.x = pkbf(o0, o1); w.y = pkbf(o2, o3); *sp = w; }
#pragma unroll
    for (int i = 0; i < 4; ++i) { const int row = i * 8 + srow; *(GAS u32x4*)(out0 + (size_t)row * 2048 + sch * 8) = *(const LAS u32x4*)(stg + row * 128 + sch * 16); }
}

__device__ __forceinline__ void phase_swa(Frame& F, const bf16* proj, const float* q_gain, const float* k_gain, const float* sinks, const float* rel, bf16* og) {
    LAS unsigned char* KS = F.lds;
    LAS unsigned char* VS = F.lds + 36864;
    LAS float* BT = (LAS float*)(F.lds + 36864 + 32768) + F.wave * 128;
    LAS unsigned char* STG = F.lds + 36864 + 32768 + 4096 + F.wave * 4096;
    const int lane0 = F.lane, wave = F.wave;
    for (int u = F.vcu; u < 1024; u += F.G) {
        int lane = lane0; asm volatile("" : "+v"(lane)); const int tid = wave * 64 + lane;
        const int b = u >> 6, kvh = (u >> 4) & 3, j = u & 15;
        const size_t rowbase = (size_t)b * SEQ;
        const int head = kvh * 8 + wave;
        __syncthreads();
#pragma unroll
        for (int i = 0; i < 4; ++i) {
            const int s = (tid >> 3) + 64 * i, ch = tid & 7, t = j * 128 - 128 + s;
            u32x4 kv = {0u, 0u, 0u, 0u}, vv = {0u, 0u, 0u, 0u};
            if (t >= 0) { const bf16* rp = proj + (rowbase + t) * P0 + kvh * 64 + ch * 8; kv = *(const GAS u32x4*)(rp + 2048); vv = *(const GAS u32x4*)(rp + 2304); }
            float kf[8] = {bflo(kv.x), bfhi(kv.x), bflo(kv.y), bfhi(kv.y), bflo(kv.z), bfhi(kv.z), bflo(kv.w), bfhi(kv.w)};
            float ss = 0.f;
#pragma unroll
            for (int e = 0; e < 8; ++e) ss += kf[e] * kf[e];
            ss += __shfl_xor(ss, 1); ss += __shfl_xor(ss, 2); ss += __shfl_xor(ss, 4);
            const float rstd = 1.0f / sqrtf(ss * (1.0f / 64.0f) + RMS_EPS);
            const f32x4 g0 = *(const f32x4*)(k_gain + ch * 8), g1 = *(const f32x4*)(k_gain + ch * 8 + 4);
            u32x4 ko; ko.x = pkbf(kf[0] * rstd * g0.x, kf[1] * rstd * g0.y); ko.y = pkbf(kf[2] * rstd * g0.z, kf[3] * rstd * g0.w);
            ko.z = pkbf(kf[4] * rstd * g1.x, kf[5] * rstd * g1.y); ko.w = pkbf(kf[6] * rstd * g1.z, kf[7] * rstd * g1.w);
            *(LAS u32x4*)(KS + s * 144 + ch * 16) = ko;
            *(LAS u32x4*)(VS + (ch >> 2) * 16384 + s * 64 + (ch & 3) * 16) = vv;
        }
        for (int dd = lane; dd < 128; dd += 64) BT[dd] = rel[t5_bucket(dd) * 32 + head] * LOG2E;
        const float sink2 = sinks[head] * LOG2E;
        __syncthreads();
        const int ktmin = (j == 0) ? 4 : 0;
        for (int qs = 0; qs < 4; ++qs) {
            int lq = lane0; asm volatile("" : "+v"(lq)); const int r32 = lq & 31, hi = lq >> 5, g16 = lq >> 4, q4 = (lq & 15) >> 2, p4 = lq & 3;
            const size_t qrow = rowbase + j * 128 + qs * 32 + r32;
            const bf16* qp = proj + qrow * P0 + head * 64 + hi * 8;
            u32x4 qraw[4]; float ss = 0.f;
#pragma unroll
            for (int s4 = 0; s4 < 4; ++s4) { qraw[s4] = *(const GAS u32x4*)(qp + s4 * 16);
#pragma unroll
                for (int e = 0; e < 4; ++e) { const float a = bflo(qraw[s4][e]), c = bfhi(qraw[s4][e]); ss += a * a + c * c; } }
            ss += __shfl_xor(ss, 32);
            const float qsc = (0.125f * LOG2E) / sqrtf(ss * (1.0f / 64.0f) + RMS_EPS);
            bf16x8 qfr[4];
#pragma unroll
            for (int s4 = 0; s4 < 4; ++s4) { const f32x4 g0 = *(const f32x4*)(q_gain + s4 * 16 + hi * 8), g1 = *(const f32x4*)(q_gain + s4 * 16 + hi * 8 + 4);
                qfr[s4] = pack8(bflo(qraw[s4].x) * qsc * g0.x, bfhi(qraw[s4].x) * qsc * g0.y, bflo(qraw[s4].y) * qsc * g0.z, bfhi(qraw[s4].y) * qsc * g0.w,
                                bflo(qraw[s4].z) * qsc * g1.x, bfhi(qraw[s4].z) * qsc * g1.y, bflo(qraw[s4].w) * qsc * g1.z, bfhi(qraw[s4].w) * qsc * g1.w); }
            f32x16 S[5];
#pragma unroll
            for (int tt = 0; tt < 5; ++tt) {
                const int kt = qs + tt;
                if (kt >= ktmin) {
                    f32x16 acc;
#pragma unroll
                    for (int r = 0; r < 16; ++r) acc[r] = 0.f;
                    const LAS unsigned char* kp = KS + (32 * kt + r32) * 144 + hi * 16;
#pragma unroll
                    for (int s4 = 0; s4 < 4; ++s4) acc = __builtin_amdgcn_mfma_f32_32x32x16_bf16(*(const LAS bf16x8*)(kp + s4 * 32), qfr[s4], acc, 0, 0, 0);
#pragma unroll
                    for (int r = 0; r < 16; ++r) { const int c = crow(r, hi); const int dist = r32 + 128 - 32 * tt - c;
                        const bool valid = (tt == 0) ? (c > r32) : ((tt == 4) ? (c <= r32) : true);
                        const float bsv = BT[dist & 127];
                        acc[r] = valid ? acc[r] + bsv : -INFINITY; }
                    S[tt] = acc;
                } else {
#pragma unroll
                    for (int r = 0; r < 16; ++r) S[tt][r] = -INFINITY;
                }
            }
            float mx = sink2;
#pragma unroll
            for (int tt = 0; tt < 5; ++tt)
#pragma unroll
                for (int r = 0; r < 16; ++r) mx = fmaxf(mx, S[tt][r]);
            mx = fmaxf(mx, __shfl_xor(mx, 32));
            float l = 0.f;
#pragma unroll
            for (int tt = 0; tt < 5; ++tt)
#pragma unroll
                for (int r = 0; r < 16; ++r) { const float p = __builtin_amdgcn_exp2f(S[tt][r] - mx); S[tt][r] = p; l += p; }
            l += __shfl_xor(l, 32); l += __builtin_amdgcn_exp2f(sink2 - mx);
            const float rl = 1.0f / l;
            f32x16 O[2];
#pragma unroll
            for (int r = 0; r < 16; ++r) { O[0][r] = 0.f; O[1][r] = 0.f; }
#pragma unroll
            for (int tt = 0; tt < 5; ++tt) {
                const int kt = qs + tt;
                if (kt >= ktmin) {
#pragma unroll
                    for (int s2 = 0; s2 < 2; ++s2) {
                        const bf16x8 pf = pack8(S[tt][8 * s2 + 0], S[tt][8 * s2 + 1], S[tt][8 * s2 + 2], S[tt][8 * s2 + 3], S[tt][8 * s2 + 4], S[tt][8 * s2 + 5], S[tt][8 * s2 + 6], S[tt][8 * s2 + 7]);
#pragma unroll
                        for (int db = 0; db < 2; ++db) {
                            const LAS unsigned char* va = VS + db * 16384 + (32 * kt + 16 * s2 + 4 * (g16 >> 1) + q4) * 64 + (g16 & 1) * 32 + p4 * 8;
                            const v4i16_t lo = ldtr(va), hh = ldtr(va + 512);
                            O[db] = __builtin_amdgcn_mfma_f32_32x32x16_bf16(mk8(lo, hh), pf, O[db], 0, 0, 0);
                        }
                    }
                }
            }
            { const size_t row0 = rowbase + j * 128 + qs * 32;
              attn_epilogue(O, rl, proj + row0 * P0 + 2560 + head * 64, P0, og + row0 * 2048 + head * 64, STG, lq); }
        }
    }
}

__device__ __forceinline__ void phase_mix_from_x(Frame& F, const float* x, const float* gain, const float* mixA, const float* mixB, bf16* hout, bf16* xa, bf16* xb) {
    const int gw = F.vcu * NWAVES + F.wave, NGW = F.G * NWAVES;
    for (int run = gw; run < MROWS / 8; run += NGW) {
        const int m0 = run * 8;
        f32x4 prev[8];
        if ((m0 & (SEQ - 1)) == 0) {
#pragma unroll
            for (int j = 0; j < 8; ++j) prev[j] = (f32x4){0.f, 0.f, 0.f, 0.f};
        } else {
            float s = 0.f;
#pragma unroll
            for (int j = 0; j < 8; ++j) { prev[j] = xrow_load<true>(x, (size_t)(m0 - 1), F.lane, j); s += (prev[j].x * prev[j].x + prev[j].y * prev[j].y) + (prev[j].z * prev[j].z + prev[j].w * prev[j].w); }
            const float rstd = 1.0f / sqrtf(wave_sum(s) * (1.0f / DM) + RMS_EPS);
#pragma unroll
            for (int j = 0; j < 8; ++j) prev[j] = prev[j] * rstd * *(const f32x4*)(gain + (F.lane + 64 * j) * 4);
        }
        for (int r = 0; r < 8; ++r) {
            const size_t m = (size_t)(m0 + r);
            const GAS f32x4* xr = (const GAS f32x4*)(x + m * DM) + F.lane;
            f32x4 v[8]; float s = 0.f;
#pragma unroll
            for (int j = 0; j < 8; ++j) { v[j] = xr[64 * j]; s += (v[j].x * v[j].x + v[j].y * v[j].y) + (v[j].z * v[j].z + v[j].w * v[j].w); }
            const float rstd = 1.0f / sqrtf(wave_sum(s) * (1.0f / DM) + RMS_EPS);
            GAS unsigned long long* oh = (GAS unsigned long long*)(hout + m * DM) + F.lane;
            GAS unsigned long long* oa = (GAS unsigned long long*)(xa + m * DM) + F.lane;
            GAS unsigned long long* ob = (GAS unsigned long long*)(xb + m * DM) + F.lane;
#pragma unroll
            for (int j = 0; j < 8; ++j) {
                const int c = (F.lane + 64 * j) * 4;
                const f32x4 hcur = v[j] * rstd * *(const f32x4*)(gain + c);
                const f32x4 d = prev[j] - hcur;
                const f32x4 ya = hcur + d * *(const f32x4*)(mixA + c), yb = hcur + d * *(const f32x4*)(mixB + c);
                oh[64 * j] = (unsigned long long)pkbf(hcur.x, hcur.y) | ((unsigned long long)pkbf(hcur.z, hcur.w) << 32);
                oa[64 * j] = (unsigned long long)pkbf(ya.x, ya.y) | ((unsigned long long)pkbf(ya.z, ya.w) << 32);
                ob[64 * j] = (unsigned long long)pkbf(yb.x, yb.y) | ((unsigned long long)pkbf(yb.z, yb.w) << 32);
                prev[j] = hcur;
            }
        }
    }
}
__device__ __forceinline__ void phase_mix_from_h(Frame& F, const bf16* h, const float* mixA, bf16* xa, const float* mixB, bf16* xb) {
    const int gw = F.vcu * NWAVES + F.wave, NGW = F.G * NWAVES;
    for (int run = gw; run < MROWS / 8; run += NGW) {
        const int m0 = run * 8;
        u32x4 prev[4];
        if ((m0 & (SEQ - 1)) == 0) {
#pragma unroll
            for (int j = 0; j < 4; ++j) prev[j] = (u32x4){0u, 0u, 0u, 0u};
        } else {
            const GAS u32x4* hr = (const GAS u32x4*)(h + (size_t)(m0 - 1) * DM) + F.lane;
#pragma unroll
            for (int j = 0; j < 4; ++j) prev[j] = hr[64 * j];
        }
        for (int r = 0; r < 8; ++r) {
            const size_t m = (size_t)(m0 + r);
            const GAS u32x4* hr = (const GAS u32x4*)(h + m * DM) + F.lane;
            u32x4 cur[4];
#pragma unroll
            for (int j = 0; j < 4; ++j) cur[j] = hr[64 * j];
#pragma unroll
            for (int j = 0; j < 4; ++j) {
                const int c = (F.lane + 64 * j) * 8;
                const f32x4 ma0 = *(const f32x4*)(mixA + c), ma1 = *(const f32x4*)(mixA + c + 4);
                float hc[8], hp[8];
#pragma unroll
                for (int e = 0; e < 4; ++e) { hc[2 * e] = bflo(cur[j][e]); hc[2 * e + 1] = bfhi(cur[j][e]); hp[2 * e] = bflo(prev[j][e]); hp[2 * e + 1] = bfhi(prev[j][e]); }
                const float ma[8] = {ma0.x, ma0.y, ma0.z, ma0.w, ma1.x, ma1.y, ma1.z, ma1.w};
                u32x4 o;
#pragma unroll
                for (int e = 0; e < 4; ++e) o[e] = pkbf(hc[2 * e] + (hp[2 * e] - hc[2 * e]) * ma[2 * e], hc[2 * e + 1] + (hp[2 * e + 1] - hc[2 * e + 1]) * ma[2 * e + 1]);
                *((GAS u32x4*)(xa + m * DM) + F.lane + 64 * j) = o;
                if (xb) {
                    const f32x4 mb0 = *(const f32x4*)(mixB + c), mb1 = *(const f32x4*)(mixB + c + 4);
                    const float mb[8] = {mb0.x, mb0.y, mb0.z, mb0.w, mb1.x, mb1.y, mb1.z, mb1.w};
#pragma unroll
                    for (int e = 0; e < 4; ++e) o[e] = pkbf(hc[2 * e] + (hp[2 * e] - hc[2 * e]) * mb[2 * e], hc[2 * e + 1] + (hp[2 * e + 1] - hc[2 * e + 1]) * mb[2 * e + 1]);
                    *((GAS u32x4*)(xb + m * DM) + F.lane + 64 * j) = o;
                }
            }
#pragma unroll
            for (int j = 0; j < 4; ++j) prev[j] = cur[j];
        }
    }
}
__device__ __forceinline__ void phase_mix6(Frame& F, const bf16* x, const float* gain, const float* mix, bf16* o0, bf16* o1, bf16* o2, bf16* o3, bf16* o4, bf16* o5) {
    LAS float* GL = (LAS float*)F.lds;
    for (int i = F.tid; i < 2048 / 4; i += 512) *(LAS f32x4*)(GL + 4 * i) = *(const f32x4*)(gain + 4 * i);
    for (int i = F.tid; i < 6 * 2048 / 4; i += 512) *(LAS f32x4*)(GL + 2048 + 4 * i) = *(const f32x4*)(mix + 4 * i);
    __syncthreads();
    const int gw = F.vcu * NWAVES + F.wave, NGW = F.G * NWAVES;
    for (int run = gw; run < MROWS / 8; run += NGW) {
        const int m0 = run * 8;
        f32x4 prev[8];
        if ((m0 & (SEQ - 1)) == 0) {
#pragma unroll
            for (int j = 0; j < 8; ++j) prev[j] = (f32x4){0.f, 0.f, 0.f, 0.f};
        } else {
            float s = 0.f;
#pragma unroll
            for (int j = 0; j < 8; ++j) { prev[j] = xrow_load<true>(x, (size_t)(m0 - 1), F.lane, j); s += (prev[j].x * prev[j].x + prev[j].y * prev[j].y) + (prev[j].z * prev[j].z + prev[j].w * prev[j].w); }
            const float rstd = 1.0f / sqrtf(wave_sum(s) * (1.0f / DM) + RMS_EPS);
#pragma unroll
            for (int j = 0; j < 8; ++j) prev[j] = prev[j] * rstd * *(const LAS f32x4*)(GL + (F.lane + 64 * j) * 4);
        }
        f32x4 vn[8];
        {
#pragma unroll
          for (int j = 0; j < 8; ++j) vn[j] = xrow_load<true>(x, (size_t)m0, F.lane, j); }
        for (int r = 0; r < 8; ++r) {
            const size_t m = (size_t)(m0 + r);
            f32x4 v[8]; float s = 0.f;
#pragma unroll
            for (int j = 0; j < 8; ++j) { v[j] = vn[j]; s += (v[j].x * v[j].x + v[j].y * v[j].y) + (v[j].z * v[j].z + v[j].w * v[j].w); }
            if (r + 1 < 8) {
#pragma unroll
                for (int j = 0; j < 8; ++j) vn[j] = xrow_load<true>(x, m + 1, F.lane, j); }
            const float rstd = 1.0f / sqrtf(wave_sum(s) * (1.0f / DM) + RMS_EPS);
#pragma unroll
            for (int j = 0; j < 8; ++j) {
                const int c = (F.lane + 64 * j) * 4;
                const f32x4 hcur = v[j] * rstd * *(const LAS f32x4*)(GL + c);
                const f32x4 d = prev[j] - hcur;
#define MIX6_ST(ci, op) do { const f32x4 y = hcur + d * *(const LAS f32x4*)(GL + 2048 * ((ci) + 1) + c); \
                    *((GAS unsigned long long*)((op) + m * DM) + F.lane + 64 * j) = (unsigned long long)pkbf(y.x, y.y) | ((unsigned long long)pkbf(y.z, y.w) << 32); } while (0)
                MIX6_ST(0, o0); MIX6_ST(1, o1); MIX6_ST(2, o2); MIX6_ST(3, o3); MIX6_ST(4, o4); MIX6_ST(5, o5);
#undef MIX6_ST
                prev[j] = hcur;
            }
        }
    }
}
__device__ __forceinline__ void convert_lora2(Frame& F, const float* wl2, const float* al2, bf16* WT) {
    const int total = 4096 * 256;
    for (int i = F.cvi * 512 + F.tid; i < total; i += F.cvn * 512) {
        const int k = i >> 12, n = i & 4095;
        float v = 0.f;
        if (n < 2048) { if (k < 96) v = wl2[(size_t)k * 2048 + n]; } else { if (k >= 128 && k < 224) v = al2[(size_t)(k - 128) * 2048 + (n - 2048)]; }
        WT[(size_t)n * 256 + k] = (bf16)f2bf(v);
    }
}

constexpr int RW_T = 16;
constexpr int RW_MS = 144;
constexpr int RW_MAT = 16 * RW_MS;
constexpr int RW_O_AL = 0, RW_O_NB = RW_MAT, RW_O_KA = 2 * RW_MAT, RW_O_RH = 3 * RW_MAT, RW_O_PL = 4 * RW_MAT, RW_OPS = 4 * RW_MAT + 256;
constexpr int RW_OFF_OPS = 0;
constexpr int RW_OFF_VV = 3 * RW_OPS;
constexpr int RW_OFF_BON = RW_OFF_VV + 4 * RW_MAT;
constexpr int RW_OFF_GR = RW_OFF_BON + 4 * 64;
constexpr int RW_GRS = 1024 + 3 * 512 + 1024;
constexpr int RW_OFF_YB = RW_OFF_GR + 2 * RW_GRS;
constexpr int RW_OFF_LWS = RW_OFF_YB + 2 * 4096;
constexpr int RW_SEQ_BYTES = RW_OFF_LWS + 2 * 4096;
static_assert(2 * RW_SEQ_BYTES <= RING_BYTES, "rwkv LDS");
template <int CTRL> __device__ __forceinline__ float dppmov(float v) { return __builtin_bit_cast(float, __builtin_amdgcn_mov_dpp(__builtin_bit_cast(int, v), CTRL, 0xf, 0xf, true)); }
__device__ __forceinline__ float red16(float v) {
    v += dppmov<0xB1>(v); v += dppmov<0x4E>(v); v += dppmov<0x141>(v); v += dppmov<0x140>(v); return v;
}
__device__ __forceinline__ int rw_tau(int p) { return ((p & 3) << 2) | (p >> 2); }
__device__ __forceinline__ void red16x2(float& a, float& b) {
    a += dppmov<0xB1>(a); b += dppmov<0xB1>(b); asm("" : "+v"(a), "+v"(b));
    a += dppmov<0x4E>(a); b += dppmov<0x4E>(b); asm("" : "+v"(a), "+v"(b));
    a += dppmov<0x141>(a); b += dppmov<0x141>(b); asm("" : "+v"(a), "+v"(b));
    a += dppmov<0x140>(a); b += dppmov<0x140>(b);
}
__device__ __forceinline__ void phase_rwkv(Frame& F, const bf16* Rb, const bf16* Kb, const bf16* Vb, const bf16* Gb, const bf16* LWb, const bf16* Ab,
                                           const float* k_k, const float* k_a, const float* r_k, const float* gn_w, const float* gn_b, bf16* out) {
    const int lane = F.lane, sq = F.wave >> 2, wq = F.wave & 3, tid4 = wq * 64 + lane;
    const int pt = tid4 >> 4, pq = tid4 & 15;
    const int l15 = lane & 15, g = lane >> 4, q4 = l15 >> 2, p4 = lane & 3;
    LAS unsigned char* base = F.lds + sq * RW_SEQ_BYTES;
    constexpr int NB = SEQ / RW_T;
    for (int s0 = 2 * F.vcu; s0 < BATCH * 32; s0 += 2 * F.G) {
        const int seq = s0 + sq, b = seq >> 5, hd = seq & 31;
        const size_t rowbase = (size_t)b * SEQ; const int cb = hd * 64 + 4 * pq;
        const f32x4 kkc = *(const f32x4*)(k_k + cb), kac = *(const f32x4*)(k_a + cb), rkc = *(const f32x4*)(r_k + cb), gwc = *(const f32x4*)(gn_w + cb), gbc = *(const f32x4*)(gn_b + cb);
        f32x4 st[4]; bf16x8 sb[2];
#pragma unroll
        for (int kb = 0; kb < 4; ++kb) st[kb] = (f32x4){0.f, 0.f, 0.f, 0.f};
        sb[0] = (bf16x8){0, 0, 0, 0, 0, 0, 0, 0}; sb[1] = sb[0];
        __syncthreads();
        u32x2 pr_r, pr_k, pr_v, pr_a, pg_g = {0u, 0u};
        unsigned short pw0, pw1, pw2, pw3;
        const size_t wofs = (size_t)hd * 64 + lane;
#define RW_LWLOAD(blk) do { const bf16* p_ = LWb + (rowbase + (size_t)(blk) * RW_T + 4 * wq) * DM + wofs; pw0 = p_[0]; pw1 = p_[DM]; pw2 = p_[2 * DM]; pw3 = p_[3 * DM]; } while (0)
#define RW_LWSCAN(stage) do { LAS float* q_ = (LAS float*)(base + RW_OFF_LWS + (stage) * 4096) + (4 * wq) * 64 + lane; const float c0_ = bf2f(pw0), c1_ = c0_ + bf2f(pw1), c2_ = c1_ + bf2f(pw2), c3_ = c2_ + bf2f(pw3); \
            q_[0] = c0_; q_[64] = c1_; q_[128] = c2_; q_[192] = c3_; } while (0)
        { const size_t o = (rowbase + pt) * DM + cb; pr_r = *(const GAS u32x2*)(Rb + o); pr_k = *(const GAS u32x2*)(Kb + o); pr_v = *(const GAS u32x2*)(Vb + o); pr_a = *(const GAS u32x2*)(Ab + o); }
        RW_LWLOAD(0);
        RW_LWSCAN(0);
        __syncthreads();
        for (int it = 0; it < NB + 3; ++it) {
            if (it < NB) {
                LAS unsigned char* OPS = base + RW_OFF_OPS + (it % 3) * RW_OPS;
                LAS unsigned char* VV = base + RW_OFF_VV + (it & 3) * RW_MAT;
                const f32x4 r = {bflo(pr_r.x), bfhi(pr_r.x), bflo(pr_r.y), bfhi(pr_r.y)}, k = {bflo(pr_k.x), bfhi(pr_k.x), bflo(pr_k.y), bfhi(pr_k.y)};
                const f32x4 a = {bflo(pr_a.x), bfhi(pr_a.x), bflo(pr_a.y), bfhi(pr_a.y)};
                const LAS float* lws = (const LAS float*)(base + RW_OFF_LWS + (it & 1) * 4096) + 4 * pq;
                f32x4 tot = {0.f, 0.f, 0.f, 0.f};
                for (int w2 = 0; w2 < wq; ++w2) tot += *(const LAS f32x4*)(lws + (4 * w2 + 3) * 64);
                const f32x4 cum = tot + *(const LAS f32x4*)(lws + pt * 64);
                f32x4 cprev = tot; if (pt & 3) cprev += *(const LAS f32x4*)(lws + (pt - 1) * 64);
                const f32x4 Pp = {__builtin_amdgcn_exp2f(cprev.x), __builtin_amdgcn_exp2f(cprev.y), __builtin_amdgcn_exp2f(cprev.z), __builtin_amdgcn_exp2f(cprev.w)};
                const f32x4 P = {__builtin_amdgcn_exp2f(cum.x), __builtin_amdgcn_exp2f(cum.y), __builtin_amdgcn_exp2f(cum.z), __builtin_amdgcn_exp2f(cum.w)};
                const f32x4 iP = {__builtin_amdgcn_exp2f(-cum.x), __builtin_amdgcn_exp2f(-cum.y), __builtin_amdgcn_exp2f(-cum.z), __builtin_amdgcn_exp2f(-cum.w)};
                const f32x4 kkv = k * kkc;
                const f32x4 kp = k * (1.0f + (a - 1.0f) * kac);
                const f32x4 rk = r * kp * rkc;
                float ss = (kkv.x * kkv.x + kkv.y * kkv.y) + (kkv.z * kkv.z + kkv.w * kkv.w), bon = (rk.x + rk.y) + (rk.z + rk.w);
                red16x2(ss, bon);
                const f32x4 kkn = kkv * __builtin_amdgcn_rcpf(fmaxf(__builtin_amdgcn_sqrtf(ss), 1e-12f));
                const f32x4 al = Pp * kkn, nb = -(kkn * a) * iP, ka = kp * iP, rh = P * r;
                const int mo = rw_tau(pt) * RW_MS + pq * 8;
                u32x2 w2;
                w2.x = pkbf(al.x, al.y); w2.y = pkbf(al.z, al.w); *(LAS u32x2*)(OPS + RW_O_AL + mo) = w2;
                w2.x = pkbf(nb.x, nb.y); w2.y = pkbf(nb.z, nb.w); *(LAS u32x2*)(OPS + RW_O_NB + mo) = w2;
                w2.x = pkbf(ka.x, ka.y); w2.y = pkbf(ka.z, ka.w); *(LAS u32x2*)(OPS + RW_O_KA + mo) = w2;
                w2.x = pkbf(rh.x, rh.y); w2.y = pkbf(rh.z, rh.w); *(LAS u32x2*)(OPS + RW_O_RH + mo) = w2;
                *(LAS u32x2*)(VV + mo) = pr_v;
                if (pt == 15) *(LAS f32x4*)(OPS + RW_O_PL + pq * 16) = P;
                if (pq == 0) *(LAS float*)(base + RW_OFF_BON + (it & 3) * 64 + pt * 4) = bon;
            }
            if (it + 1 < NB) { const size_t o = (rowbase + (it + 1) * RW_T + pt) * DM + cb; pr_r = *(const GAS u32x2*)(Rb + o); pr_k = *(const GAS u32x2*)(Kb + o); pr_v = *(const GAS u32x2*)(Vb + o); pr_a = *(const GAS u32x2*)(Ab + o); RW_LWLOAD(it + 1); }
            if (it >= 3) pg_g = *(const GAS u32x2*)(Gb + (rowbase + (it - 3) * RW_T + pt) * DM + cb);
            if (it >= 1 && it <= NB) {
                const int bi = it - 1;
                const LAS unsigned char* OPS = base + RW_OFF_OPS + (bi % 3) * RW_OPS;
                LAS unsigned char* GR = base + RW_OFF_GR + (bi & 1) * RW_GRS;
                const LAS unsigned char* X = OPS + ((wq & 1) ? RW_O_KA : RW_O_NB) + l15 * RW_MS + g * 16;
                const LAS unsigned char* Yt = OPS + ((wq & 2) ? RW_O_RH : RW_O_AL) + l15 * RW_MS + g * 16;
                f32x4 acc = {0.f, 0.f, 0.f, 0.f};
#pragma unroll
                for (int m = 0; m < 2; ++m) acc = __builtin_amdgcn_mfma_f32_16x16x32_bf16(*(const LAS bf16x8*)(X + m * 64), *(const LAS bf16x8*)(Yt + m * 64), acc, 0, 0, 0);
                const int tt = rw_tau(l15);
#pragma unroll
                for (int r = 0; r < 4; ++r) { const int ts = 4 * r + g; const bool keep = (wq & 2) ? (ts <= tt) : (ts < tt); acc[r] = keep ? acc[r] : 0.f; }
                if (wq == 0) {
                    LAS float* GT = (LAS float*)GR;
#pragma unroll
                    for (int r = 0; r < 4; ++r) GT[tt * 16 + 4 * r + g] = acc[r];
                    const int t = l15, B = g;
                    const f32x4 g4 = *(const LAS f32x4*)(GT + t * 16 + 4 * B);
                    const f32x4 r1 = *(const LAS f32x4*)(GT + (4 * B + 1) * 16 + 4 * B), r2 = *(const LAS f32x4*)(GT + (4 * B + 2) * 16 + 4 * B), r3 = *(const LAS f32x4*)(GT + (4 * B + 3) * 16 + 4 * B);
                    const float N10 = r1.x, N21 = r2.y, N32 = r3.z, N20 = fmaf(r2.y, N10, r2.x), N31 = fmaf(r3.z, N21, r3.y), N30 = fmaf(r3.z, N20, fmaf(r3.y, N10, r3.x));
                    const int i = t - 4 * B;
                    f32x4 E;
                    if (i >= 4) { E.x = fmaf(g4.w, N30, fmaf(g4.z, N20, fmaf(g4.y, N10, g4.x))); E.y = fmaf(g4.w, N31, fmaf(g4.z, N21, g4.y)); E.z = fmaf(g4.w, N32, g4.z); E.w = g4.w; }
                    else { E.x = i == 1 ? N10 : i == 2 ? N20 : i == 3 ? N30 : 0.f; E.y = i == 2 ? N21 : i == 3 ? N31 : 0.f; E.z = i == 3 ? N32 : 0.f; E.w = 0.f; }
                    *(LAS f32x4*)(GR + 2560 + B * 256 + rw_tau(t) * 16) = E;
                }
                else { u32x2 w2; w2.x = pkbf(acc.x, acc.y); w2.y = pkbf(acc.z, acc.w); *(LAS u32x2*)(GR + 1024 + (wq - 1) * 512 + l15 * 32 + g * 8) = w2; }
            }
            if (it >= 2 && it <= NB + 1) {
                const int bi = it - 2;
                const LAS unsigned char* OPS = base + RW_OFF_OPS + (bi % 3) * RW_OPS;
                const LAS unsigned char* VV = base + RW_OFF_VV + (bi & 3) * RW_MAT;
                const LAS unsigned char* GR = base + RW_OFF_GR + (bi & 1) * RW_GRS;
                LAS float* YB = (LAS float*)(base + RW_OFF_YB + (bi & 1) * 4096);
                const v4i16_t vq = ldtr(VV + (4 * g + q4) * RW_MS + (16 * wq + 4 * p4) * 2);
                const v4i16_t zq0 = {0, 0, 0, 0};
                f32x4 racc = {0.f, 0.f, 0.f, 0.f};
#pragma unroll
                for (int m = 0; m < 2; ++m) { const LAS unsigned char* ap = OPS + RW_O_AL + l15 * RW_MS + m * 64 + g * 8;
                    const u32x2 lo = *(const LAS u32x2*)ap, hh = *(const LAS u32x2*)(ap + 32); const u32x4 aw = {lo.x, lo.y, hh.x, hh.y};
                    racc = __builtin_amdgcn_mfma_f32_16x16x32_bf16(__builtin_bit_cast(bf16x8, aw), sb[m], racc, 0, 0, 0); }
                { const v4i16_t b1 = *(const LAS v4i16_t*)(GR + 1024 + 0 * 512 + l15 * 32 + g * 8);
                  racc = __builtin_amdgcn_mfma_f32_16x16x32_bf16(mk8(zq0, b1), mk8(zq0, vq), racc, 0, 0, 0); }
#pragma unroll
                for (int B = 0; B < 4; ++B) { const float e = *(const LAS float*)(GR + 2560 + B * 256 + l15 * 16 + g * 4);
                    racc = __builtin_amdgcn_mfma_f32_16x16x4f32(e, racc[B], racc, 0, 0, 0); }
                u32x2 zw; zw.x = pkbf(racc[0], racc[1]); zw.y = pkbf(racc[2], racc[3]);
                const bf16x8 zv = mk8(__builtin_bit_cast(v4i16_t, zw), vq);
                f32x4 yacc = {0.f, 0.f, 0.f, 0.f};
#pragma unroll
                for (int m = 0; m < 2; ++m) { const LAS unsigned char* ap = OPS + RW_O_RH + l15 * RW_MS + m * 64 + g * 8;
                    const u32x2 lo = *(const LAS u32x2*)ap, hh = *(const LAS u32x2*)(ap + 32); const u32x4 aw = {lo.x, lo.y, hh.x, hh.y};
                    yacc = __builtin_amdgcn_mfma_f32_16x16x32_bf16(__builtin_bit_cast(bf16x8, aw), sb[m], yacc, 0, 0, 0); }
                { const v4i16_t a2 = *(const LAS v4i16_t*)(GR + 1024 + 1 * 512 + l15 * 32 + g * 8), b2 = *(const LAS v4i16_t*)(GR + 1024 + 2 * 512 + l15 * 32 + g * 8);
                  yacc = __builtin_amdgcn_mfma_f32_16x16x32_bf16(mk8(a2, b2), zv, yacc, 0, 0, 0); }
#pragma unroll
                for (int r = 0; r < 4; ++r) YB[(4 * r + g) * 64 + 16 * wq + l15] = yacc[r];
                const LAS unsigned char* ua = OPS + RW_O_NB + (4 * g + q4) * RW_MS + 4 * p4 * 2;
#pragma unroll
                for (int kb = 0; kb < 4; ++kb) {
                    const v4i16_t lo = ldtr(ua + kb * 32), hh = ldtr(ua + (RW_O_KA - RW_O_NB) + kb * 32);
                    const f32x4 d = __builtin_amdgcn_mfma_f32_16x16x32_bf16(mk8(lo, hh), zv, st[kb], 0, 0, 0);
                    st[kb] = d * *(const LAS f32x4*)(OPS + RW_O_PL + (16 * kb + 4 * g) * 4);
                }
#pragma unroll
                for (int m = 0; m < 2; ++m) sb[m] = pack8(st[2 * m][0], st[2 * m][1], st[2 * m][2], st[2 * m][3], st[2 * m + 1][0], st[2 * m + 1][1], st[2 * m + 1][2], st[2 * m + 1][3]);
            }
            if (it >= 3) {
                const int bi = it - 3;
                const LAS float* YB = (const LAS float*)(base + RW_OFF_YB + (bi & 1) * 4096);
                const u32x2 vw = *(const LAS u32x2*)(base + RW_OFF_VV + (bi & 3) * RW_MAT + rw_tau(pt) * RW_MS + pq * 8);
                const f32x4 v = {bflo(vw.x), bfhi(vw.x), bflo(vw.y), bfhi(vw.y)};
                const float bon = *(const LAS float*)(base + RW_OFF_BON + (bi & 3) * 64 + pt * 4);
                const size_t o = (rowbase + bi * RW_T + pt) * DM + cb;
                const u32x2 gg = pg_g;
                const f32x4 y = *(const LAS f32x4*)(YB + pt * 64 + 4 * pq);
                float s1 = (y.x + y.y) + (y.z + y.w), s2 = (y.x * y.x + y.y * y.y) + (y.z * y.z + y.w * y.w);
                red16x2(s1, s2);
                const float mu = s1 * (1.0f / 64.0f);
                const f32x4 d = y - mu;
                const float var = fmaxf(s2 * (1.0f / 64.0f) - mu * mu, 0.f);
                const f32x4 oo = d * __builtin_amdgcn_rsqf(var + GN_EPS) * gwc + gbc + bon * v;
                u32x2 w; w.x = pkbf(oo.x * siluf(bflo(gg.x)), oo.y * siluf(bfhi(gg.x))); w.y = pkbf(oo.z * siluf(bflo(gg.y)), oo.w * siluf(bfhi(gg.y)));
                *(GAS u32x2*)(out + o) = w;
            }
            if (it + 1 < NB) RW_LWSCAN((it + 1) & 1);
            __syncthreads();
        }
    }
#undef RW_LWSCAN
#undef RW_LWLOAD
}

typedef float f32x4v __attribute__((ext_vector_type(4)));
typedef float f32x2v __attribute__((ext_vector_type(2)));
__device__ __forceinline__ int sw_off(int row, int chunk) { return row * 256 + ((chunk ^ (row & 15)) << 4); }
constexpr int ML_QS = 0, ML_KS = 32768, ML_VS = 65536, ML_SW = 98304;
constexpr int ML_GA2 = MISC_OFF + 256, ML_GM2 = ML_GA2 + 512, ML_GBL = ML_GM2 + 512, ML_DEN = ML_GBL + 512, ML_NQ = ML_DEN + 512, ML_NV = ML_NQ + 512, ML_WSV = ML_NV + 512, ML_SC = ML_WSV + 512;
static_assert(ML_SC + 64 <= LDS_BYTES, "mlstm LDS");
constexpr int ML_SSQ = MISC_OFF + 4096, ML_RSTD = MISC_OFF + 6144;
static_assert(ML_SC + 64 <= ML_SSQ && ML_RSTD + 512 <= LDS_BYTES, "mlstm LDS (fused head norm)");
__device__ __forceinline__ void phase_mlstm(Frame& F, const bf16* proj, const float* GXp, const float* b_i, const float* b_f, bf16* hs, const float* h_gain, bf16* out, float* xch, unsigned* flags) {
    const int lane0 = F.lane, wave = F.wave;
    LAS unsigned char* L = F.lds;
#define ML_LANES() int lane = lane0; asm volatile("" : "+v"(lane)); const int tid = wave * 64 + lane, l15 = lane & 15, g = lane >> 4, q4 = l15 >> 2, p4 = lane & 3; (void)tid; (void)q4; (void)p4; (void)l15; (void)g
    LAS float* GA2 = (LAS float*)(L + ML_GA2); LAS float* GM2 = (LAS float*)(L + ML_GM2); LAS float* GBL = (LAS float*)(L + ML_GBL); LAS float* DEN = (LAS float*)(L + ML_DEN);
    LAS float* NQ = (LAS float*)(L + ML_NQ); LAS float* NV = (LAS float*)(L + ML_NV); LAS float* WSV = (LAS float*)(L + ML_WSV); LAS float* SC = (LAS float*)(L + ML_SC);
    constexpr float LOG2SC = -3.5f;
    LAS float* SSQ = (LAS float*)(L + ML_SSQ); LAS float* RSTD = (LAS float*)(L + ML_RSTD);
    for (int item = F.vcu; item < BATCH * 8 * 2; item += F.G) {
        const int b = item >> 4, h = (item >> 1) & 7, vh = item & 1;
        const size_t rowbase = (size_t)b * SEQ;
        const float bi = b_i[h], bfv = b_f[h];
        f32x4v st[8], nst;
#pragma unroll
        for (int kb = 0; kb < 8; ++kb) st[kb] = (f32x4v){0.f, 0.f, 0.f, 0.f};
        nst = (f32x4v){0.f, 0.f, 0.f, 0.f};
        __syncthreads();
        { ML_LANES(); if (tid < 128) NV[tid] = 0.f;
          if (tid == 0) { SC[0] = 0.f; SC[1] = 0.f; } }
        { ML_LANES(); SSQ[tid] = 0.f; }
        float* const xmine = xch + (size_t)item * 2048; const float* const xpart = xch + (size_t)(item ^ 1) * 2048;
        unsigned* const fmine = flags + item * 64; unsigned* const fpart = flags + (item ^ 1) * 64;
        u32x4 fh[4], fo[4], fg[4];
#define ML_FIN_LOAD(cf) do { ML_LANES(); const size_t r0_ = rowbase + (size_t)(cf) * 128; \
            _Pragma("unroll") for (int i = 0; i < 4; ++i) { const int idx = tid + 512 * i, row = idx >> 4, col = h * 256 + vh * 128 + (idx & 15) * 8; \
                fh[i] = *(const GAS u32x4*)(hs + (r0_ + row) * 2048 + col); fo[i] = *(const GAS u32x4*)(proj + (r0_ + row) * P2 + 4096 + col); fg[i] = *(const GAS u32x4*)(proj + (r0_ + row) * P2 + 6144 + col); } } while (0)
#define ML_FIN_DO(cf) do { ML_LANES(); const size_t r0_ = rowbase + (size_t)(cf) * 128; \
            _Pragma("unroll") for (int i = 0; i < 4; ++i) { const int idx = tid + 512 * i, row = idx >> 4, col = h * 256 + vh * 128 + (idx & 15) * 8; \
                const float rs_ = RSTD[row]; const f32x4 g0_ = *(const f32x4*)(h_gain + col), g1_ = *(const f32x4*)(h_gain + col + 4); u32x4 y_; \
                y_.x = pkbf(bflo(fh[i].x) * rs_ * g0_.x * sigmf(bflo(fo[i].x)) * siluf(bflo(fg[i].x)), bfhi(fh[i].x) * rs_ * g0_.y * sigmf(bfhi(fo[i].x)) * siluf(bfhi(fg[i].x))); \
                y_.y = pkbf(bflo(fh[i].y) * rs_ * g0_.z * sigmf(bflo(fo[i].y)) * siluf(bflo(fg[i].y)), bfhi(fh[i].y) * rs_ * g0_.w * sigmf(bfhi(fo[i].y)) * siluf(bfhi(fg[i].y))); \
                y_.z = pkbf(bflo(fh[i].z) * rs_ * g1_.x * sigmf(bflo(fo[i].z)) * siluf(bflo(fg[i].z)), bfhi(fh[i].z) * rs_ * g1_.y * sigmf(bfhi(fo[i].z)) * siluf(bfhi(fg[i].z))); \
                y_.w = pkbf(bflo(fh[i].w) * rs_ * g1_.z * sigmf(bflo(fo[i].w)) * siluf(bflo(fg[i].w)), bfhi(fh[i].w) * rs_ * g1_.w * sigmf(bfhi(fo[i].w)) * siluf(bfhi(fg[i].w))); \
                *(GAS u32x4*)(out + (r0_ + row) * 2048 + col) = y_; } } while (0)
#define ML_PUBLISH(cp) do { ML_LANES(); const f32x2v v_ = *(const LAS f32x2v*)(SSQ + ((cp) & 3) * 128 + 2 * lane); \
            __hip_atomic_store(xmine + (cp) * 128 + 2 * lane, v_.x, __ATOMIC_RELAXED, __HIP_MEMORY_SCOPE_AGENT); __hip_atomic_store(xmine + (cp) * 128 + 2 * lane + 1, v_.y, __ATOMIC_RELAXED, __HIP_MEMORY_SCOPE_AGENT); \
            asm volatile("s_waitcnt vmcnt(0)" ::: "memory"); \
            if (lane == 0) __hip_atomic_store(fmine, (unsigned)((cp) + 1), __ATOMIC_RELAXED, __HIP_MEMORY_SCOPE_AGENT); } while (0)
#define ML_RSTD(cf) do { ML_LANES(); int spins_ = 0; \
            while (__hip_atomic_load(fpart, __ATOMIC_RELAXED, __HIP_MEMORY_SCOPE_AGENT) < (unsigned)((cf) + 1) && ++spins_ < (1 << 22)) __builtin_amdgcn_s_sleep(2); \
            asm volatile("" ::: "memory"); \
            const float p0_ = __hip_atomic_load(xpart + (cf) * 128 + 2 * lane, __ATOMIC_RELAXED, __HIP_MEMORY_SCOPE_AGENT), p1_ = __hip_atomic_load(xpart + (cf) * 128 + 2 * lane + 1, __ATOMIC_RELAXED, __HIP_MEMORY_SCOPE_AGENT); \
            const f32x2v m_ = *(const LAS f32x2v*)(SSQ + ((cf) & 3) * 128 + 2 * lane); \
            RSTD[2 * lane] = __builtin_amdgcn_rsqf((m_.x + p0_) * (1.0f / 256.0f) + RMS_EPS); RSTD[2 * lane + 1] = __builtin_amdgcn_rsqf((m_.y + p1_) * (1.0f / 256.0f) + RMS_EPS); } while (0)
        u32x4 pfq[4], pfk[4], pfv[4];
#define ML_PREFETCH(cc) do { ML_LANES(); const bf16* qg_ = proj + (rowbase + (size_t)(cc) * 128) * P2 + h * 128; const bf16* vg_ = qg_ + 2048 + h * 128 + vh * 128; \
            _Pragma("unroll") for (int i = 0; i < 4; ++i) { const int idx = tid + 512 * i, row = idx >> 4, ch = idx & 15; \
                pfq[i] = *(const GAS u32x4*)(qg_ + (size_t)row * P2 + ch * 8); pfk[i] = *(const GAS u32x4*)(qg_ + (size_t)row * P2 + 1024 + ch * 8); pfv[i] = *(const GAS u32x4*)(vg_ + (size_t)row * P2 + ch * 8); } } while (0)
        ML_PREFETCH(0);
        float gpi0 = 0.f, gpi1 = 0.f, gpf0 = 0.f, gpf1 = 0.f;
        if (wave == 0) { ML_LANES(); const size_t rn = rowbase + 2 * lane; gpi0 = GXp[rn * 32 + h]; gpi1 = GXp[(rn + 1) * 32 + h]; gpf0 = GXp[rn * 32 + 8 + h]; gpf1 = GXp[(rn + 1) * 32 + 8 + h]; }
        for (int c = 0; c < 16; ++c) {
            const int par = c & 1;
            const size_t row0 = rowbase + (size_t)c * 128;
            {
                ML_LANES();
#pragma unroll
                for (int i = 0; i < 4; ++i) { const int idx = tid + 512 * i, row = idx >> 4, ch = idx & 15;
                    const int o = sw_off(row, ch);
                    *(LAS u32x4*)(L + ML_QS + o) = pfq[i]; *(LAS u32x4*)(L + ML_KS + o) = pfk[i]; *(LAS u32x4*)(L + ML_VS + o) = pfv[i]; }
            }
            if (c >= 2) ML_FIN_LOAD(c - 2);
            if (wave == 0) {
                ML_LANES();
                const int t0 = 2 * lane;
                const float i0 = gpi0 + bi, i1 = gpi1 + bi;
                const float f0 = logsigf(gpf0 + bfv), f1 = logsigf(gpf1 + bfv);
                if (c + 1 < 16) { const size_t rn = row0 + 128 + t0; gpi0 = GXp[rn * 32 + h]; gpi1 = GXp[(rn + 1) * 32 + h]; gpf0 = GXp[rn * 32 + 8 + h]; gpf1 = GXp[(rn + 1) * 32 + 8 + h]; }
                const float pr = f0 + f1; float incl = pr;
#pragma unroll
                for (int o = 1; o < 64; o <<= 1) { const float y = __shfl_up(incl, o); if (lane >= o) incl += y; }
                const float excl = incl - pr, b0 = excl + f0, b1 = excl + pr;
                const float a0 = i0 - b0, a1 = i1 - b1;
                float im = fmaxf(a0, a1);
#pragma unroll
                for (int o = 1; o < 64; o <<= 1) { const float y = __shfl_up(im, o); if (lane >= o) im = fmaxf(im, y); }
                float exm = __shfl_up(im, 1); if (lane == 0) exm = -INFINITY;
                const float mprev = SC[par];
                const float M0 = fmaxf(mprev, fmaxf(exm, a0)), M1 = fmaxf(mprev, im);
                const float M127 = __shfl(M1, 63), g127 = __shfl(b1, 63);
                GA2[t0] = a0 * LOG2E; GA2[t0 + 1] = a1 * LOG2E; GM2[t0] = M0 * LOG2E; GM2[t0 + 1] = M1 * LOG2E;
                GBL[t0] = (b0 + M0) * LOG2E; GBL[t0 + 1] = (b1 + M1) * LOG2E; DEN[t0] = 0.f; DEN[t0 + 1] = 0.f;
                WSV[t0] = __builtin_amdgcn_exp2f((a0 - M127) * LOG2E); WSV[t0 + 1] = __builtin_amdgcn_exp2f((a1 - M127) * LOG2E);
                if (lane == 0) { SC[par ^ 1] = g127 + M127; SC[2] = M127 * LOG2E; }
            }
            else if (wave == 1) { if (c >= 1) ML_PUBLISH(c - 1); { ML_LANES(); *(LAS f32x2v*)(SSQ + ((c + 1) & 3) * 128 + 2 * lane) = (f32x2v){0.f, 0.f}; } }
            else if (wave == 2) { if (c >= 2) ML_RSTD(c - 2); }
            __syncthreads();
            const float m2 = SC[par] * LOG2E, M2_127 = SC[2];
            {
            ML_LANES();
            for (int idx = wave; idx < 40; idx += 8) {
                int tb, bs; if (idx < 2) { tb = 0; bs = 0; } else if (idx < 4) { tb = 1; bs = 2; } else if (idx < 8) { tb = 2; bs = 4; } else if (idx < 12) { tb = 3; bs = 8; }
                else if (idx < 18) { tb = 4; bs = 12; } else if (idx < 24) { tb = 5; bs = 18; } else if (idx < 32) { tb = 6; bs = 24; } else { tb = 7; bs = 32; }
                const int sb = idx - bs;
                f32x4v acc = (f32x4v){0.f, 0.f, 0.f, 0.f};
                const int srow = 16 * sb + l15, trow = 16 * tb + l15;
#pragma unroll
                for (int ks = 0; ks < 4; ++ks) {
                    const bf16x8 af = *(const LAS bf16x8*)(L + ML_KS + sw_off(srow, 4 * ks + g)), bfr = *(const LAS bf16x8*)(L + ML_QS + sw_off(trow, 4 * ks + g));
                    acc = __builtin_amdgcn_mfma_f32_16x16x32_bf16(af, bfr, acc, 0, 0, 0); }
                const float M2t = GM2[trow]; const f32x4v a2 = *(const LAS f32x4v*)(GA2 + 16 * sb + 4 * g);
                float val[4];
#pragma unroll
                for (int r = 0; r < 4; ++r) { const int s = 16 * sb + 4 * g + r; const float w = (s <= trow) ? __builtin_amdgcn_exp2f(a2[r] - M2t + LOG2SC) : 0.f; val[r] = acc[r] * w; }
                float d = (val[0] + val[1]) + (val[2] + val[3]); d += __shfl_xor(d, 16); d += __shfl_xor(d, 32);
                if (g == 0) __hip_atomic_fetch_add(DEN + trow, d, __ATOMIC_RELAXED, __HIP_MEMORY_SCOPE_WORKGROUP);
                u32x2 pk; pk.x = pkbf(val[0], val[1]); pk.y = pkbf(val[2], val[3]);
                *(LAS u32x2*)(L + ML_SW + sw_off(trow, 2 * sb + (g >> 1)) + (g & 1) * 8) = pk;
            }
            {
                const int trow = 16 * wave + l15; float s = 0.f;
#pragma unroll
                for (int i = 0; i < 4; ++i) { const u32x4 qv = *(const LAS u32x4*)(L + ML_QS + sw_off(trow, 4 * g + i));
                    const f32x4v n0 = *(const LAS f32x4v*)(NV + 32 * g + 8 * i), n1 = *(const LAS f32x4v*)(NV + 32 * g + 8 * i + 4);
                    s += bflo(qv.x) * n0.x + bfhi(qv.x) * n0.y + bflo(qv.y) * n0.z + bfhi(qv.y) * n0.w + bflo(qv.z) * n1.x + bfhi(qv.z) * n1.y + bflo(qv.w) * n1.z + bfhi(qv.w) * n1.w; }
                s += __shfl_xor(s, 16); s += __shfl_xor(s, 32);
                if (g == 0) NQ[trow] = s;
            }
            }
            if (c >= 2) ML_FIN_DO(c - 2);
            __syncthreads();
            f32x4v num[8];
            {
                ML_LANES();
                bf16x8 cf[4];
#pragma unroll
                for (int kp = 0; kp < 4; ++kp) cf[kp] = pack8(st[2 * kp][0], st[2 * kp][1], st[2 * kp][2], st[2 * kp][3], st[2 * kp + 1][0], st[2 * kp + 1][1], st[2 * kp + 1][2], st[2 * kp + 1][3]);
#pragma unroll
                for (int tb = 0; tb < 8; ++tb) {
                    const int trow = 16 * tb + l15; f32x4v acc = (f32x4v){0.f, 0.f, 0.f, 0.f};
#pragma unroll
                    for (int kp = 0; kp < 4; ++kp) {
                        const u32x2 lo = *(const LAS u32x2*)(L + ML_QS + sw_off(trow, 4 * kp + (g >> 1)) + (g & 1) * 8), hh = *(const LAS u32x2*)(L + ML_QS + sw_off(trow, 4 * kp + 2 + (g >> 1)) + (g & 1) * 8);
                        const u32x4 bw = {lo.x, lo.y, hh.x, hh.y};
                        acc = __builtin_amdgcn_mfma_f32_16x16x32_bf16(cf[kp], __builtin_bit_cast(bf16x8, bw), acc, 0, 0, 0); }
                    const float wi = __builtin_amdgcn_exp2f(m2 - GM2[trow] + LOG2SC);
                    num[tb] = acc * wi;
                    asm volatile("" ::: "memory");
                }
            }
            bf16x8 vfr[4];
            {
            ML_LANES();
#pragma unroll
            for (int sc = 0; sc < 4; ++sc) {
                const int rA = 32 * sc + 8 * g + q4, rB = rA + 4;
                const v4i16_t lo = ldtr(L + ML_VS + sw_off(rA, 2 * wave + (p4 >> 1)) + (p4 & 1) * 8), hh = ldtr(L + ML_VS + sw_off(rB, 2 * wave + (p4 >> 1)) + (p4 & 1) * 8);
                vfr[sc] = mk8(lo, hh);
#pragma unroll
                for (int tb = 0; tb < 8; ++tb) if (tb >= 2 * sc) {
                    const int trow = 16 * tb + l15;
                    const bf16x8 bfr = *(const LAS bf16x8*)(L + ML_SW + sw_off(trow, 4 * sc + g));
                    num[tb] = __builtin_amdgcn_mfma_f32_16x16x32_bf16(vfr[sc], bfr, num[tb], 0, 0, 0); }
                asm volatile("" ::: "memory");
            }
            float hsq[8];
#pragma unroll
            for (int tb = 0; tb < 8; ++tb) {
                const int trow = 16 * tb + l15;
                const float den = __builtin_amdgcn_exp2f(m2 - GM2[trow] + LOG2SC) * NQ[trow] + DEN[trow];
                const float rd = 1.0f / fmaxf(fabsf(den), __builtin_amdgcn_exp2f(-GBL[trow]));
                const f32x4v hv = num[tb] * rd; u32x2 hw; hw.x = pkbf(hv.x, hv.y); hw.y = pkbf(hv.z, hv.w);
                *(GAS u32x2*)(hs + (row0 + trow) * 2048 + h * 256 + vh * 128 + 16 * wave + 4 * g) = hw;
                hsq[tb] = (hv.x * hv.x + hv.y * hv.y) + (hv.z * hv.z + hv.w * hv.w);
            }
#pragma unroll
            for (int tb = 0; tb < 8; ++tb) hsq[tb] += __shfl_xor(hsq[tb], 16);
#pragma unroll
            for (int tb = 0; tb < 8; ++tb) hsq[tb] += __shfl_xor(hsq[tb], 32);
            if (g == 0) {
#pragma unroll
                for (int tb = 0; tb < 8; ++tb) __hip_atomic_fetch_add(SSQ + (c & 3) * 128 + 16 * tb + l15, hsq[tb], __ATOMIC_RELAXED, __HIP_MEMORY_SCOPE_WORKGROUP);
            }
            }
            if (c + 1 < 16) ML_PREFETCH(c + 1);
            {
                ML_LANES();
                const float cs = __builtin_amdgcn_exp2f(m2 - M2_127);
#pragma unroll
                for (int sc = 0; sc < 4; ++sc) {
                    const f32x4v wa = *(const LAS f32x4v*)(WSV + 32 * sc + 8 * g), wb = *(const LAS f32x4v*)(WSV + 32 * sc + 8 * g + 4);
                    const u32x4 vw = __builtin_bit_cast(u32x4, vfr[sc]);
                    vfr[sc] = pack8(bflo(vw.x) * wa.x, bfhi(vw.x) * wa.y, bflo(vw.y) * wa.z, bfhi(vw.y) * wa.w, bflo(vw.z) * wb.x, bfhi(vw.z) * wb.y, bflo(vw.w) * wb.z, bfhi(vw.w) * wb.w);
                }
#pragma unroll
                for (int kb = 0; kb < 8; ++kb) {
                    f32x4v acc = st[kb] * cs;
#pragma unroll
                    for (int sc = 0; sc < 4; ++sc) {
                        const int rA = 32 * sc + 8 * g + q4, rB = rA + 4;
                        const v4i16_t lo = ldtr(L + ML_KS + sw_off(rA, 2 * kb + (p4 >> 1)) + (p4 & 1) * 8), hh = ldtr(L + ML_KS + sw_off(rB, 2 * kb + (p4 >> 1)) + (p4 & 1) * 8);
                        acc = __builtin_amdgcn_mfma_f32_16x16x32_bf16(mk8(lo, hh), vfr[sc], acc, 0, 0, 0);
                    }
                    st[kb] = acc;
                    asm volatile("" ::: "memory");
                }
                f32x4v nacc = nst * cs;
#pragma unroll
                for (int sc = 0; sc < 4; ++sc) {
                    const int rA = 32 * sc + 8 * g + q4, rB = rA + 4;
                    const v4i16_t lo = ldtr(L + ML_KS + sw_off(rA, 2 * wave + (p4 >> 1)) + (p4 & 1) * 8), hh = ldtr(L + ML_KS + sw_off(rB, 2 * wave + (p4 >> 1)) + (p4 & 1) * 8);
                    const f32x4v wa = *(const LAS f32x4v*)(WSV + 32 * sc + 8 * g), wb = *(const LAS f32x4v*)(WSV + 32 * sc + 8 * g + 4);
                    nacc = __builtin_amdgcn_mfma_f32_16x16x32_bf16(mk8(lo, hh), pack8(wa.x, wa.y, wa.z, wa.w, wb.x, wb.y, wb.z, wb.w), nacc, 0, 0, 0);
                }
                nst = nacc;
                if (l15 == 0) *(LAS f32x4v*)(NV + 16 * wave + 4 * g) = nst;
            }
            __syncthreads();
        }
        if (wave == 1) ML_PUBLISH(15); else if (wave == 2) ML_RSTD(14);
        ML_FIN_LOAD(14);
        __syncthreads();
        ML_FIN_DO(14);
        __syncthreads();
        if (wave == 2) ML_RSTD(15);
        ML_FIN_LOAD(15);
        __syncthreads();
        ML_FIN_DO(15);
    }
}
#undef ML_FIN_LOAD
#undef ML_FIN_DO
#undef ML_PUBLISH
#undef ML_RSTD
#undef ML_PREFETCH
#undef ML_LANES
__device__ __forceinline__ void phase_mlstm_post(Frame& F, const bf16* hs, const bf16* proj, const float* h_gain, bf16* out) {
    const int gw = F.vcu * NWAVES + F.wave, NGW = F.G * NWAVES;
    for (int m = gw; m < MROWS; m += NGW) {
        const GAS u32x2* xr = (const GAS u32x2*)(hs + (size_t)m * DM) + F.lane;
        const bf16* pr = proj + (size_t)m * P2;
        GAS unsigned long long* o8 = (GAS unsigned long long*)(out + (size_t)m * DM) + F.lane;
        u32x2 vw[8], ov[8], gv[8]; float ss[8];
#pragma unroll
        for (int j = 0; j < 8; ++j) { const int c = (F.lane + 64 * j) * 4; vw[j] = xr[64 * j]; ov[j] = *(const GAS u32x2*)(pr + 4096 + c); gv[j] = *(const GAS u32x2*)(pr + 6144 + c); }
#pragma unroll
        for (int j = 0; j < 8; ++j) { const float a = bflo(vw[j].x), b = bfhi(vw[j].x), c = bflo(vw[j].y), e = bfhi(vw[j].y); ss[j] = (a * a + b * b) + (c * c + e * e); }
#pragma unroll
        for (int o = 1; o < 64; o <<= 1)
#pragma unroll
            for (int j = 0; j < 8; ++j) ss[j] += __shfl_xor(ss[j], o);
#pragma unroll
        for (int j = 0; j < 8; ++j) {
            const float rstd = 1.0f / sqrtf(ss[j] * (1.0f / 256.0f) + RMS_EPS);
            const int c = (F.lane + 64 * j) * 4;
            const f32x4 hg = *(const f32x4*)(h_gain + c);
            const float y0 = bflo(vw[j].x) * rstd * hg.x * sigmf(bflo(ov[j].x)) * siluf(bflo(gv[j].x)), y1 = bfhi(vw[j].x) * rstd * hg.y * sigmf(bfhi(ov[j].x)) * siluf(bfhi(gv[j].x));
            const float y2 = bflo(vw[j].y) * rstd * hg.z * sigmf(bflo(ov[j].y)) * siluf(bflo(gv[j].y)), y3 = bfhi(vw[j].y) * rstd * hg.w * sigmf(bfhi(ov[j].y)) * siluf(bfhi(gv[j].y));
            o8[64 * j] = (unsigned long long)pkbf(y0, y1) | ((unsigned long long)pkbf(y2, y3) << 32);
        }
    }
}

constexpr int FX_KS = 0, FX_VS = 9216, FX_FB = 9216 + 8192, FX_BUF = 9216 + 8192 + 256;
__device__ __forceinline__ u32x4 fox_knorm(u32x4 kv, f32x4 g0, f32x4 g1) {
    float e[8] = {bflo(kv.x), bfhi(kv.x), bflo(kv.y), bfhi(kv.y), bflo(kv.z), bfhi(kv.z), bflo(kv.w), bfhi(kv.w)}; float ss = 0.f;
#pragma unroll
    for (int i = 0; i < 8; ++i) ss += e[i] * e[i];
    ss += __builtin_bit_cast(float, __builtin_amdgcn_mov_dpp(__builtin_bit_cast(int, ss), 0xB1, 0xf, 0xf, true));
    ss += __builtin_bit_cast(float, __builtin_amdgcn_mov_dpp(__builtin_bit_cast(int, ss), 0x4E, 0xf, 0xf, true));
    ss += __builtin_bit_cast(float, __builtin_amdgcn_mov_dpp(__builtin_bit_cast(int, ss), 0x141, 0xf, 0xf, true));
    const float r = __builtin_amdgcn_rsqf(ss * (1.0f / 64.0f) + RMS_EPS);
    u32x4 o; o.x = pkbf(e[0] * r * g0.x, e[1] * r * g0.y); o.y = pkbf(e[2] * r * g0.z, e[3] * r * g0.w); o.z = pkbf(e[4] * r * g1.x, e[5] * r * g1.y); o.w = pkbf(e[6] * r * g1.z, e[7] * r * g1.w); return o;
}
constexpr int FX_FL = 2 * FX_BUF;
__device__ __forceinline__ void phase_fox_attn(Frame& F, const bf16* proj, const float* GXp, const float* b_f, const float* q_gain, const float* k_gain, bf16* og, unsigned* qctr) {
    const int lane = F.lane, r32 = lane & 31, hi = lane >> 5, wave = F.wave, tid = F.tid;
    const int g16 = lane >> 4, q4 = (lane & 15) >> 2, p4 = lane & 3;
    LAS unsigned char* L = F.lds;
    const int srow = tid >> 3, sch = tid & 7;
    LAS float* KG = (LAS float*)(L + FX_FL + 8192 + 32768 + 256);
    if (tid < 64) KG[tid] = k_gain[tid];
#define kg0 (*(const LAS f32x4*)(KG + sch * 8))
#define kg1 (*(const LAS f32x4*)(KG + sch * 8 + 4))
    float gqm = fabsf(q_gain[lane]), gkm = fabsf(k_gain[lane]);
#pragma unroll
    for (int o = 1; o < 64; o <<= 1) { gqm = fmaxf(gqm, __shfl_xor(gqm, o)); gkm = fmaxf(gkm, __shfl_xor(gkm, o)); }
    const float QKB = 64.0f * gqm * gkm * (0.125f * LOG2E) * 1.03f;
    LAS unsigned* DN = (LAS unsigned*)(L + FX_FL + 8192 + 32768);
    LAS unsigned* QW = DN + 16;
    if (wave == 0 && lane < 32) { const float mine = b_f[lane]; int rank = 0;
        for (int o = 0; o < 32; ++o) { const float other = b_f[o]; rank += (other > mine || (other == mine && o < lane)) ? 1 : 0; }
        QW[1 + rank] = (unsigned)lane; }
    const int lane_o = lane;
    for (;;) {
        int lane = lane_o; asm volatile("" : "+v"(lane));
        const int r32 = lane & 31, hi = lane >> 5, tid = wave * 64 + lane, g16 = lane >> 4, q4 = (lane & 15) >> 2, p4 = lane & 3, srow = tid >> 3, sch = tid & 7;
        __syncthreads();
        if (tid == 0) QW[0] = __hip_atomic_fetch_add(qctr, 1u, __ATOMIC_RELAXED, __HIP_MEMORY_SCOPE_AGENT);
        __syncthreads();
        const unsigned unit = QW[0];
        if (unit >= (unsigned)(BATCH * 32)) break;
        const int h = (int)QW[1 + (unit >> 4)], b = (int)(unit & 15u), bh = b * 32 + h; (void)bh;
        const size_t rowbase = (size_t)b * SEQ;
        const LAS float* Fp = (const LAS float*)(L + FX_FL);
        if (wave == 0) {
            const float bf = b_f[h];
            const float* gp = GXp + (rowbase + lane * 32) * 32 + h;
            float acc[32]; float run = 0.f;
#pragma unroll
            for (int i = 0; i < 32; ++i) { run += logsigf(gp[i * 32] + bf); acc[i] = run; }
            float incl = run;
            int ln = lane; asm volatile("" : "+v"(ln));
#pragma unroll
            for (int o = 1; o < 64; o <<= 1) { const float y = __builtin_bit_cast(float, __builtin_amdgcn_ds_bpermute((ln - o) << 2, __builtin_bit_cast(int, incl))); if (ln >= o) incl += y; }
            const float excl = incl - run;
            LAS float* op = (LAS float*)(L + FX_FL) + lane * 32;
#pragma unroll
            for (int i = 0; i < 32; i += 4) *(LAS f32x4*)(op + i) = (f32x4){(acc[i] + excl) * LOG2E, (acc[i + 1] + excl) * LOG2E, (acc[i + 2] + excl) * LOG2E, (acc[i + 3] + excl) * LOG2E};
        }
        __syncthreads();
        const bf16* kbase = proj + rowbase * P3 + 2048 + h * 64 + sch * 8;
        u32x4 nq[4], nkv, nvv;
#define FX_PRELOAD(qbn) do { const size_t qr_ = rowbase + (qbn) * 256 + wave * 32 + r32; \
            _Pragma("unroll") for (int s4 = 0; s4 < 4; ++s4) nq[s4] = *(const GAS u32x4*)(proj + qr_ * P3 + h * 64 + s4 * 16 + hi * 8); \
            const size_t kr_ = (size_t)((4 * ((qbn) + 1) - 1) * 64 + srow) * P3; nkv = *(const GAS u32x4*)(kbase + kr_); nvv = *(const GAS u32x4*)(kbase + kr_ + 2048); } while (0)
        FX_PRELOAD(7);
        for (int qb = 7; qb >= 0; --qb) {
            const int q0 = qb * 256, NT = 4 * (qb + 1);
            bf16x8 qfr[4];
            {
                u32x4 qraw[4]; float ss = 0.f;
#pragma unroll
                for (int s4 = 0; s4 < 4; ++s4) { qraw[s4] = nq[s4];
#pragma unroll
                    for (int i = 0; i < 4; ++i) { const float a = bflo(qraw[s4][i]), c = bfhi(qraw[s4][i]); ss += a * a + c * c; } }
                ss += __shfl_xor(ss, 32);
                const float qsc = (0.125f * LOG2E) * __builtin_amdgcn_rsqf(ss * (1.0f / 64.0f) + RMS_EPS);
#pragma unroll
                for (int s4 = 0; s4 < 4; ++s4) { const f32x4 g0 = *(const f32x4*)(q_gain + s4 * 16 + hi * 8), g1 = *(const f32x4*)(q_gain + s4 * 16 + hi * 8 + 4);
                    qfr[s4] = pack8(bflo(qraw[s4].x) * qsc * g0.x, bfhi(qraw[s4].x) * qsc * g0.y, bflo(qraw[s4].y) * qsc * g0.z, bfhi(qraw[s4].y) * qsc * g0.w,
                                    bflo(qraw[s4].z) * qsc * g1.x, bfhi(qraw[s4].z) * qsc * g1.y, bflo(qraw[s4].w) * qsc * g1.z, bfhi(qraw[s4].w) * qsc * g1.w); }
            }
            const float Fref = Fp[q0];
            const int qpos = q0 + wave * 32 + r32;
            float mrun = -1e30f, lsum = 0.f;
            f32x16 O[2];
#pragma unroll
            for (int r = 0; r < 16; ++r) { O[0][r] = 0.f; O[1][r] = 0.f; }
            __syncthreads();
            {
                const u32x4 kv = nkv, vv = nvv;
                *(LAS u32x4*)(L + FX_KS + srow * 144 + sch * 16) = fox_knorm(kv, kg0, kg1);
                *(LAS u32x4*)(L + FX_VS + (sch >> 2) * 4096 + srow * 64 + (sch & 3) * 16) = vv;
                if (tid < 64) *(LAS float*)(L + FX_FB + tid * 4) = Fref - Fp[(NT - 1) * 64 + tid];
            }
            __syncthreads();
            bool wdone = false;
            u32x4 kvA = {0u, 0u, 0u, 0u}, vvA = {0u, 0u, 0u, 0u}, kvB = {0u, 0u, 0u, 0u}, vvB = {0u, 0u, 0u, 0u};
            { const size_t kr = (size_t)((NT - 2) * 64 + srow) * P3; kvA = *(const GAS u32x4*)(kbase + kr); vvA = *(const GAS u32x4*)(kbase + kr + 2048); }
            auto step = [&](const int tt, const u32x4& kvS, const u32x4& vvS, u32x4& kvL, u32x4& vvL) -> bool {
                const int t = NT - 1 - tt;
                LAS unsigned char* cur = L + (tt & 1) * FX_BUF; LAS unsigned char* nxt = L + ((tt + 1) & 1) * FX_BUF;
                if (tt + 2 < NT) { const size_t kr = (size_t)((t - 2) * 64 + srow) * P3; kvL = *(const GAS u32x4*)(kbase + kr); vvL = *(const GAS u32x4*)(kbase + kr + 2048); }
                const int k0 = t * 64;
                if (k0 <= q0 + wave * 32 + 31 && !wdone) {
                    f32x16 S[2];
                    const bool diag = (k0 + 63 > q0 + wave * 32);
                    {
                        bf16x8 kf[2][4];
#pragma unroll
                        for (int kb = 0; kb < 2; ++kb) { const LAS unsigned char* kp = cur + FX_KS + (32 * kb + r32) * 144 + hi * 16;
#pragma unroll
                            for (int s4 = 0; s4 < 4; ++s4) kf[kb][s4] = *(const LAS bf16x8*)(kp + s4 * 32); }
#pragma unroll
                        for (int kb = 0; kb < 2; ++kb)
#pragma unroll
                            for (int g4 = 0; g4 < 4; ++g4) { const f32x4 fbv = *(const LAS f32x4*)(cur + FX_FB + (32 * kb + 8 * g4 + 4 * hi) * 4);
                                S[kb][4 * g4 + 0] = fbv.x; S[kb][4 * g4 + 1] = fbv.y; S[kb][4 * g4 + 2] = fbv.z; S[kb][4 * g4 + 3] = fbv.w; }
                        __builtin_amdgcn_sched_barrier(0);
#pragma unroll
                        for (int s4 = 0; s4 < 4; ++s4) { S[0] = __builtin_amdgcn_mfma_f32_32x32x16_bf16(kf[0][s4], qfr[s4], S[0], 0, 0, 0); S[1] = __builtin_amdgcn_mfma_f32_32x32x16_bf16(kf[1][s4], qfr[s4], S[1], 0, 0, 0); }
                        __builtin_amdgcn_sched_barrier(0);
                        if (diag) {
#pragma unroll
                            for (int kb = 0; kb < 2; ++kb)
#pragma unroll
                                for (int r = 0; r < 16; ++r) { const int kpos = k0 + 32 * kb + crow(r, hi); S[kb][r] = (kpos <= qpos) ? S[kb][r] : -INFINITY; } }
                    }
                    float mx = fmaxf(S[0][0], S[1][0]);
#pragma unroll
                    for (int r = 1; r < 16; ++r) mx = fmaxf(mx, fmaxf(S[0][r], S[1][r]));
                    mx = fmaxf(mx, __shfl_xor(mx, 32));
                    if (__any(mx > mrun)) {
                        mx = fmaxf(mx, mrun);
                        const float alpha = __builtin_amdgcn_exp2f(mrun - mx);
                        mrun = mx; lsum *= alpha;
#pragma unroll
                        for (int r = 0; r < 16; ++r) { O[0][r] *= alpha; O[1][r] *= alpha; }
                    }
                    float ps = 0.f;
#pragma unroll
                    for (int r = 0; r < 16; ++r) { const float p0 = __builtin_amdgcn_exp2f(S[0][r] - mrun), p1 = __builtin_amdgcn_exp2f(S[1][r] - mrun); S[0][r] = p0; S[1][r] = p1; ps += p0 + p1; }
                    lsum += ps;
#pragma unroll
                    for (int kb = 0; kb < 2; ++kb)
#pragma unroll
                        for (int s2 = 0; s2 < 2; ++s2) {
                            const bf16x8 pf = pack8(S[kb][8 * s2 + 0], S[kb][8 * s2 + 1], S[kb][8 * s2 + 2], S[kb][8 * s2 + 3], S[kb][8 * s2 + 4], S[kb][8 * s2 + 5], S[kb][8 * s2 + 6], S[kb][8 * s2 + 7]);
#pragma unroll
                            for (int db = 0; db < 2; ++db) {
                                const LAS unsigned char* va = cur + FX_VS + db * 4096 + (32 * kb + 16 * s2 + 4 * (g16 >> 1) + q4) * 64 + (g16 & 1) * 32 + p4 * 8;
                                const v4i16_t lo = ldtr(va), hh = ldtr(va + 512);
                                O[db] = __builtin_amdgcn_mfma_f32_32x32x16_bf16(mk8(lo, hh), pf, O[db], 0, 0, 0);
                            }
                        }
                }
                if (tt + 1 < NT) {
                    *(LAS u32x4*)(nxt + FX_KS + srow * 144 + sch * 16) = fox_knorm(kvS, kg0, kg1);
                    *(LAS u32x4*)(nxt + FX_VS + (sch >> 2) * 4096 + srow * 64 + (sch & 3) * 16) = vvS;
                    if (tid < 64) *(LAS float*)(nxt + FX_FB + tid * 4) = Fref - Fp[(t - 1) * 64 + tid];
                    const float nb = Fref - Fp[(t - 1) * 64 + 63];
                    wdone = wdone || __all(nb + QKB <= mrun - 40.0f);
                    if (lane == 0) DN[(tt & 1) * 8 + wave] = wdone ? 1u : 0u;
                }
                __syncthreads();
                if (tt + 1 < NT) { const u32x4 d0 = *(const LAS u32x4*)(DN + (tt & 1) * 8), d1 = *(const LAS u32x4*)(DN + (tt & 1) * 8 + 4);
                    if ((d0.x & d0.y & d0.z & d0.w & d1.x & d1.y & d1.z & d1.w) != 0u) return true; }
                return false;
            };
            for (int tt = 0; tt < NT; tt += 2) {
                if (step(tt, kvA, vvA, kvB, vvB)) break;
                if (step(tt + 1, kvB, vvB, kvA, vvA)) break;
            }
            lsum += __shfl_xor(lsum, 32);
            const float rl = 1.0f / lsum;
            FX_PRELOAD(qb > 0 ? qb - 1 : 0);
            { const size_t row0 = rowbase + q0 + wave * 32;
              attn_epilogue(O, rl, proj + row0 * P3 + 6144 + h * 64, P3, og + row0 * 2048 + h * 64, L + FX_FL + 8192 + wave * 4096, lane); }
        }
#undef FX_PRELOAD
    }
#undef kg0
#undef kg1
}

#ifndef MK_SINGLE
#define MK_SINGLE 1
#endif
#ifndef MK_LAYERS
#define MK_LAYERS 4
#endif
#ifndef MK_DUP
#define MK_DUP 0
#endif
#ifndef MK_AMP
#define MK_AMP 1.0f
#endif
enum { I_X = 0, I_REL, I_SWA_NORM, I_SWA_WIN, I_SWA_QG, I_SWA_KG, I_SWA_SINK, I_SWA_WOUT,
       I_RW_NORM, I_RW_MIX, I_RW_WIN, I_RW_W0, I_RW_WL1, I_RW_WL2, I_RW_A0, I_RW_AL1, I_RW_AL2, I_RW_KK, I_RW_KA, I_RW_RK, I_RW_GNW, I_RW_GNB, I_RW_WOUT,
       I_ML_NORM, I_ML_WIN, I_ML_BI, I_ML_BF, I_ML_HG, I_ML_WOUT,
       I_FX_NORM, I_FX_WIN, I_FX_BF, I_FX_QG, I_FX_KG, I_FX_WOUT, N_IN };
struct Args { const float* in[N_IN]; float* out; unsigned char* ws; int ph_lo, ph_hi; };
constexpr int NPH_L0 = 4;
constexpr int NPH_L1 = 6;
constexpr int NPH_L2 = 4;
constexpr int NPH_L3 = 4;
constexpr int NPH = (MK_LAYERS >= 1 ? NPH_L0 : 0) + (MK_LAYERS >= 2 ? NPH_L1 : 0) + (MK_LAYERS >= 3 ? NPH_L2 : 0) + (MK_LAYERS >= 4 ? NPH_L3 : 0);

__global__ void __launch_bounds__(NWAVES * 64, 2) fwd(Args args) {
    extern __shared__ __attribute__((aligned(16))) unsigned char lds_raw[];
    Frame F;
    F.lds = (LAS unsigned char*)lds_raw;
    F.tid = threadIdx.x; F.lane = F.tid & 63; F.wave = __builtin_amdgcn_readfirstlane(F.tid >> 6);
    F.G = gridDim.x; { const int bx = blockIdx.x; F.vcu = (F.G % 8 == 0) ? (bx % 8) * (F.G / 8) + bx / 8 : bx; }
    F.cvi = F.vcu; F.cvn = F.G;
    unsigned char* ws = args.ws;
    gu32* ctl = (gu32*)(ws + WS_CTL);
    if (F.tid < 16) ((LAS unsigned*)(F.lds + MISC_OFF))[F.tid] = 0u;
    __syncthreads();
    const int lo = args.ph_lo, hi = args.ph_hi;
    XcdBarrier bar; bar.bar = (unsigned*)(ctl + CW_BAR); bar.x = 0; bar.st = nullptr;
    if (hi - lo > 1) bar = xcd_barrier_post((unsigned*)(ctl + CW_BAR), (volatile LAS unsigned*)(F.lds + MISC_OFF + 32));
#define IN(k) (lo <= (k) && (k) < hi)
#define SEAM(k) do { if (IN(k) && IN((k) + 1)) xcd_barrier(bar, F.wave); F.lane = fresh_lane(); F.tid = F.wave * 64 + F.lane; } while (0)
    bf16* const WB = (bf16*)(ws + WS_W); bf16* const WB3 = (bf16*)(ws + WS_W3);
    bf16* const S0 = (bf16*)(ws + WS_SLOT(0)); bf16* const S1 = (bf16*)(ws + WS_SLOT(1)); bf16* const S2 = (bf16*)(ws + WS_SLOT(2)); bf16* const S3 = (bf16*)(ws + WS_SLOT(3));
    bf16* const S4 = (bf16*)(ws + WS_SLOT(4)); bf16* const S5 = (bf16*)(ws + WS_SLOT(5)); bf16* const S6 = (bf16*)(ws + WS_SLOT(6));
    bf16* const L1B = (bf16*)(ws + WS_L1); float* const GX = (float*)(ws + WS_GX); float* const FB = (float*)(ws + WS_F);
    const float* const x_in = args.in[I_X]; float* const xo = args.out; bf16* const xb = (bf16*)args.out;
    int ph = 0;

    if (IN(ph)) {
        convert_matrix(F, args.in[I_SWA_WIN], 4608, 0, 2048, 4608, WB + W0_IN, 0);
        convert_matrix(F, args.in[I_SWA_WOUT], 2048, 0, 2048, 2048, WB + W0_OUT, 0);
        for (int rep = 0; rep < ((MK_DUP & 32) ? 2 : 1); ++rep) phase_norm<false>(F, x_in, args.in[I_SWA_NORM], S0);
    } SEAM(ph); ++ph;
    if (IN(ph)) {
        pg8::Gemm g{S0, WB + W0_IN, MROWS, 4608, 2048}; pg8::StaticOrder S; S.init(MROWS, 4608, F.G, (int)blockIdx.x);
        pg8::EpiStore E{S1, P0, 18, nullptr};
        for (int rep = 0; rep < ((MK_DUP & 16) ? 2 : 1); ++rep) pg8::gemm_phase<pg8::EpiStore, pg8::StaticOrder, false, true>(F.lds, g, S, E, F.wave);
    } SEAM(ph); ++ph;
    if (IN(ph)) { for (int rep = 0; rep < ((MK_DUP & 1) ? 2 : 1); ++rep) phase_swa(F, S1, args.in[I_SWA_QG], args.in[I_SWA_KG], args.in[I_SWA_SINK], args.in[I_REL], S0); } SEAM(ph); ++ph;
    if (IN(ph)) {
        pg8::Gemm g{S0, WB + W0_OUT, MROWS, 2048, 2048}; pg8::StaticOrder S; S.init(MROWS, 2048, F.G, (int)blockIdx.x);
        pg8::EpiResidX<false, true> E{x_in, xb, 2048};
        pg8::gemm_phase<pg8::EpiResidX<false, true>, pg8::StaticOrder, false, true>(F.lds, g, S, E, F.wave);
    } SEAM(ph); ++ph;

#if MK_LAYERS >= 2
    {
    const float* mix = args.in[I_RW_MIX];
    if (IN(ph)) {
        for (int c = 0; c < 4; ++c) convert_matrix(F, args.in[I_RW_WIN] + (size_t)c * 2048 * 2048, 2048, 0, 2048, 2048, WB + W1_IN + (size_t)c * 2048 * 2048, 0);
        convert_matrix(F, args.in[I_RW_WL1], 96, 0, 2048, 96, WB + W1_LA, 0);   zero_rows(F, WB + W1_LA, 2048, 96, 256);
        convert_matrix(F, args.in[I_RW_AL1], 96, 0, 2048, 96, WB + W1_LB, 128); zero_rows(F, WB + W1_LB, 2048, 0, 128); zero_rows(F, WB + W1_LB, 2048, 224, 256);
        convert_lora2(F, args.in[I_RW_WL2], args.in[I_RW_AL2], WB + W1_L2);
        convert_matrix(F, args.in[I_RW_WOUT], 2048, 0, 2048, 2048, WB + W1_OUT, 0);
        __syncthreads();
        phase_mix6(F, xb, args.in[I_RW_NORM], mix, S0, S1, S2, S3, S4, S5);
    } SEAM(ph); ++ph;
    if (IN(ph)) {
        { pg8::Gemm g{S4, WB + W1_LA, MROWS, 256, 2048}; pg8::StaticOrder S; S.init(MROWS, 256, F.G, (int)blockIdx.x); pg8::EpiLora1<0> E{L1B};
          pg8::gemm_phase<pg8::EpiLora1<0>, pg8::StaticOrder, false, true>(F.lds, g, S, E, F.wave); }
        { pg8::Gemm g{S5, WB + W1_LB, MROWS, 256, 2048}; pg8::StaticOrder S; S.init(MROWS, 256, F.G, (int)((blockIdx.x + F.G / 2) % F.G)); pg8::EpiLora1<1> E{L1B};
          pg8::gemm_phase<pg8::EpiLora1<1>, pg8::StaticOrder, false, true>(F.lds, g, S, E, F.wave); }
    } SEAM(ph); ++ph;
    if (IN(ph)) {
        { pg8::Gemm g{S0, WB + W1_IN, MROWS, 2048, 2048}; pg8::StaticOrder S; S.init(MROWS, 2048, F.G, (int)blockIdx.x); pg8::EpiStore E{S6, 2048, 8, nullptr};
          pg8::gemm_phase<pg8::EpiStore, pg8::StaticOrder, false, true>(F.lds, g, S, E, F.wave); }
        { pg8::Gemm g{S1, WB + W1_IN + (size_t)2048 * 2048, MROWS, 2048, 2048}; pg8::StaticOrder S; S.init(MROWS, 2048, F.G, (int)blockIdx.x); pg8::EpiStore E{S4, 2048, 8, nullptr};
          pg8::gemm_phase<pg8::EpiStore, pg8::StaticOrder, false, true>(F.lds, g, S, E, F.wave); }
        { pg8::Gemm g{S2, WB + W1_IN + (size_t)2 * 2048 * 2048, MROWS, 2048, 2048}; pg8::StaticOrder S; S.init(MROWS, 2048, F.G, (int)blockIdx.x); pg8::EpiStore E{S5, 2048, 8, nullptr};
          pg8::gemm_phase<pg8::EpiStore, pg8::StaticOrder, false, true>(F.lds, g, S, E, F.wave); }
    } SEAM(ph); ++ph;
    if (IN(ph)) {
        { pg8::Gemm g{L1B, WB + W1_L2, MROWS, 4096, 256}; pg8::StaticOrder S; S.init(MROWS, 4096, F.G, (int)blockIdx.x);
          pg8::EpiLora2 E{S0, S1, args.in[I_RW_W0], args.in[I_RW_A0]};
          pg8::gemm_phase<pg8::EpiLora2, pg8::StaticOrder, false, true>(F.lds, g, S, E, F.wave); }
        { pg8::Gemm g{S3, WB + W1_IN + (size_t)3 * 2048 * 2048, MROWS, 2048, 2048}; pg8::StaticOrder S; S.init(MROWS, 2048, F.G, (int)blockIdx.x); pg8::EpiStore E{S2, 2048, 8, nullptr};
          pg8::gemm_phase<pg8::EpiStore, pg8::StaticOrder, false, true>(F.lds, g, S, E, F.wave); }
    } SEAM(ph); ++ph;
    if (IN(ph)) { for (int rep = 0; rep < ((MK_DUP & 2) ? 2 : 1); ++rep) phase_rwkv(F, S6, S4, S5, S2, S0, S1, args.in[I_RW_KK], args.in[I_RW_KA], args.in[I_RW_RK], args.in[I_RW_GNW], args.in[I_RW_GNB], S3); } SEAM(ph); ++ph;
    if (IN(ph)) {
        pg8::Gemm g{S3, WB + W1_OUT, MROWS, 2048, 2048}; pg8::StaticOrder S; S.init(MROWS, 2048, F.G, (int)blockIdx.x);
        pg8::EpiResidX<true, true> E{xb, xb, 2048};
        pg8::gemm_phase<pg8::EpiResidX<true, true>, pg8::StaticOrder, false, true>(F.lds, g, S, E, F.wave);
    } SEAM(ph); ++ph;
    }
#endif

#if MK_LAYERS >= 3
    if (IN(ph)) {
        convert_matrix(F, args.in[I_ML_WIN], 8208, 0, 2048, 8192, WB + W2_IN, 0);
        convert_cols_small(F, args.in[I_ML_WIN], 8208, 8192, 2048, 16, WB + W2_IN, 8192); zero_rows(F, WB + W2_IN, 2048, 8208, 8448);
        convert_matrix(F, args.in[I_ML_WOUT], 2048, 0, 2048, 2048, WB + W2_OUT, 0);
        phase_norm<true>(F, xb, args.in[I_ML_NORM], S0);
    } SEAM(ph); ++ph;
    if (IN(ph)) {
        pg8::Gemm g{S0, WB + W2_IN, MROWS, 8448, 2048}; pg8::StaticOrder S; S.init(MROWS, 8448, F.G, (int)blockIdx.x);
        pg8::EpiStore E{S1, P2, 32, GX};
        pg8::gemm_phase<pg8::EpiStore, pg8::StaticOrder, false, true>(F.lds, g, S, E, F.wave);
        {
            const int rem = (int)(((size_t)(MROWS / 256) * (8448 / 256)) % (size_t)F.G), bx = (int)blockIdx.x;
            if (rem == 0 || bx >= rem) {
                F.lane = fresh_lane(); F.tid = F.wave * 64 + F.lane;
                F.cvi = rem == 0 ? bx : bx - rem; F.cvn = rem == 0 ? F.G : F.G - rem;
                convert_matrix(F, args.in[I_FX_WIN], 8224, 0, 2048, 8192, WB3 + W2_IN, 0);
                convert_cols_small(F, args.in[I_FX_WIN], 8224, 8192, 2048, 32, WB3 + W2_IN, 8192); zero_rows(F, WB3 + W2_IN, 2048, 8224, 8448);
                convert_matrix(F, args.in[I_FX_WOUT], 2048, 0, 2048, 2048, WB3 + W2_OUT, 0);
                F.cvi = F.vcu; F.cvn = F.G;
            }
        }
    } SEAM(ph); ++ph;
    if (IN(ph)) { phase_mlstm(F, S1, GX, args.in[I_ML_BI], args.in[I_ML_BF], S5, args.in[I_ML_HG], S0, FB, (unsigned*)(ctl + CW_MLF)); } SEAM(ph); ++ph;
    if (IN(ph)) {
        pg8::Gemm g{S0, WB + W2_OUT, MROWS, 2048, 2048}; pg8::StaticOrder S; S.init(MROWS, 2048, F.G, (int)blockIdx.x);
        pg8::EpiResidX<true, true> E{xb, S5, 2048};
        pg8::gemm_phase<pg8::EpiResidX<true, true>, pg8::StaticOrder, false, true>(F.lds, g, S, E, F.wave);
    } SEAM(ph); ++ph;
#endif

#if MK_LAYERS >= 4
    if (IN(ph)) {
#if MK_LAYERS < 3
#error "L3's weights are converted inside L2's projection phase"
#endif
        phase_norm<true>(F, S5, args.in[I_FX_NORM], S0);
    } SEAM(ph); ++ph;
    if (IN(ph)) {
        pg8::Gemm g{S0, WB3 + W2_IN, MROWS, 8448, 2048}; pg8::StaticOrder S; S.init(MROWS, 8448, F.G, (int)blockIdx.x);
        pg8::EpiStore E{S1, P3, 32, GX};
        pg8::gemm_phase<pg8::EpiStore, pg8::StaticOrder, false, true>(F.lds, g, S, E, F.wave);
    } SEAM(ph); ++ph;
    if (IN(ph)) { for (int rep = 0; rep < ((MK_DUP & 8) ? 2 : 1); ++rep) phase_fox_attn(F, S1, GX, args.in[I_FX_BF], args.in[I_FX_QG], args.in[I_FX_KG], S0, (unsigned*)(ctl + CW_QUEUE) + rep * 64); } SEAM(ph); ++ph;
    if (IN(ph)) {
        pg8::Gemm g{S0, WB3 + W2_OUT, MROWS, 2048, 2048}; pg8::StaticOrder S; S.init(MROWS, 2048, F.G, (int)blockIdx.x);
        pg8::EpiResidX<true, false> E{S5, xo, 2048};
        pg8::gemm_phase<pg8::EpiResidX<true, false>, pg8::StaticOrder, false, true>(F.lds, g, S, E, F.wave);
    } SEAM(ph); ++ph;
#endif
#undef IN
#undef SEAM
}

extern "C" void kernel_launch(void* const* d_in, const int* in_sizes, int n_in, void* d_out, int out_size, void* d_ws, size_t ws_size, hipStream_t stream) {
    static int grid = 0;
    if (grid == 0) {
        if (n_in != N_IN || out_size != MROWS * DM || ws_size < WS_END) { fprintf(stderr, "kernel_launch: unexpected shapes (n_in %d out %d ws %zu)\n", n_in, out_size, ws_size); grid = -1; return; }
        int dev = 0, cus = 0, per_cu = 0;
        if (hipGetDevice(&dev) != hipSuccess || hipDeviceGetAttribute(&cus, hipDeviceAttributeMultiprocessorCount, dev) != hipSuccess) { grid = -1; return; }
        if (hipFuncSetAttribute((const void*)fwd, hipFuncAttributeMaxDynamicSharedMemorySize, LDS_BYTES) != hipSuccess) { grid = -1; return; }
        if (hipOccupancyMaxActiveBlocksPerMultiprocessor(&per_cu, (const void*)fwd, NWAVES * 64, LDS_BYTES) != hipSuccess || per_cu < 1) per_cu = 1;
        (void)hipGetLastError();
        grid = cus & ~1;
    }
    if (grid < 0) return;
    (void)hipMemsetAsync((char*)d_ws + WS_CTL, 0, CTL_ZERO_BYTES, stream);
    Args a{};
    for (int i = 0; i < N_IN; ++i) a.in[i] = (const float*)d_in[i];
    a.out = (float*)d_out; a.ws = (unsigned char*)d_ws;
#if MK_SINGLE
    a.ph_lo = 0; a.ph_hi = NPH;
    hipLaunchKernelGGL(fwd, dim3(grid), dim3(NWAVES * 64), LDS_BYTES, stream, a);
#else
    for (int p = 0; p < NPH; ++p) { a.ph_lo = p; a.ph_hi = p + 1; hipLaunchKernelGGL(fwd, dim3(grid), dim3(NWAVES * 64), LDS_BYTES, stream, a); }
#endif
}
```
